# Optimizing an MI355X kernel written in HIP

```python
import jax, jax.numpy as jnp
from jax import lax
import numpy as np

D_MODEL = 2048
BATCH = 8
SEQ = 2048
DEPTH = 2

HEAD_DIM = 128
ATTN_WIDTH = D_MODEL // 2
N_Q_HEADS = ATTN_WIDTH // HEAD_DIM
N_KV_HEADS = max(1, N_Q_HEADS // 4)
GQA_GROUP = N_Q_HEADS // N_KV_HEADS
KV_WIDTH = N_KV_HEADS * HEAD_DIM
WINDOW = 128
BLOCK = 128
GMLP_WIDTH = D_MODEL - ATTN_WIDTH
GMLP_HEAD_DIM = 128
N_GMLP_HEADS = GMLP_WIDTH // GMLP_HEAD_DIM
CHUNK = 128
IN_WIDTH = ATTN_WIDTH + 2 * KV_WIDTH + 2 * GMLP_WIDTH
D_FF = 5632
CONV_WIDTH = 3
ROPE_THETA = 10000.0
EPS = 1e-6
MASK_VALUE = -1e30

kernel_name = "hybrid_window_gqa_sgu_convffn_encoder"


def rms_norm(x, g):
    xf = x.astype(jnp.float32)
    y = xf * lax.rsqrt(jnp.mean(xf * xf, axis=-1, keepdims=True) + EPS)
    return (y * g.astype(jnp.float32)).astype(x.dtype)


def layer_norm(x, g, b):
    xf = x.astype(jnp.float32)
    mu = jnp.mean(xf, axis=-1, keepdims=True)
    xc = xf - mu
    y = xc * lax.rsqrt(jnp.mean(xc * xc, axis=-1, keepdims=True) + EPS)
    return (y * g.astype(jnp.float32) + b.astype(jnp.float32)).astype(x.dtype)


def rope_tables(seq):
    inv_freq = ROPE_THETA ** (-jnp.arange(0, HEAD_DIM, 2, dtype=jnp.float32) / HEAD_DIM)
    ang = jnp.arange(seq, dtype=jnp.float32)[:, None] * inv_freq[None, :]
    return jnp.cos(ang), jnp.sin(ang)


def apply_rope(x, cos, sin):
    xf = x.astype(jnp.float32)
    x1, x2 = jnp.split(xf, 2, axis=-1)
    c = cos[None, :, None, :]
    s = sin[None, :, None, :]
    return jnp.concatenate([x1 * c - x2 * s, x2 * c + x1 * s], axis=-1).astype(x.dtype)


def banded_window_attention(q, k, v, sink):
    B, S, _, D = q.shape
    nb = S // BLOCK
    qb = q.reshape(B, nb, BLOCK, N_KV_HEADS, GQA_GROUP, D)

    def band(t):
        tp = jnp.pad(t, ((0, 0), (BLOCK, BLOCK), (0, 0), (0, 0)))
        tp = tp.reshape(B, nb + 2, BLOCK, N_KV_HEADS, D)
        return jnp.concatenate([tp[:, :-2], tp[:, 1:-1], tp[:, 2:]], axis=2)

    kb, vb = band(k), band(v)
    s = jnp.einsum('bnqhgd,bnkhd->bnhgqk', qb, kb).astype(jnp.float32) * (D ** -0.5)
    blk = jnp.arange(nb)[:, None, None]
    q_pos = blk * BLOCK + jnp.arange(BLOCK)[None, :, None]
    k_pos = blk * BLOCK - BLOCK + jnp.arange(3 * BLOCK)[None, None, :]
    valid = (jnp.abs(k_pos - q_pos) <= WINDOW) & (k_pos >= 0) & (k_pos < S)
    s = jnp.where(valid[None, :, None, None], s, MASK_VALUE)
    sk = sink.astype(jnp.float32).reshape(N_KV_HEADS, GQA_GROUP)[None, None, :, :, None, None]
    m = jnp.maximum(jnp.max(s, axis=-1, keepdims=True), sk)
    p = jnp.exp(s - m)
    probs = p / (jnp.sum(p, axis=-1, keepdims=True) + jnp.exp(sk - m))
    out = jnp.einsum('bnhgqk,bnkhd->bnqhgd', probs.astype(v.dtype), vb)
    return out.reshape(B, S, N_Q_HEADS * D)


def chunked_spatial_gating(u, v, ln_g, ln_b, w_s, b_s):
    B, S, _ = u.shape
    nc = S // CHUNK
    vn = layer_norm(v, ln_g, ln_b).reshape(B, nc, CHUNK, N_GMLP_HEADS, GMLP_HEAD_DIM)
    f = jnp.einsum('hpq,bcqhd->bcphd', w_s, vn) + b_s.T[None, None, :, :, None]
    return u * f.reshape(B, S, GMLP_WIDTH)


def depthwise_conv_centred(h, w, b):
    S = h.shape[1]
    half = CONV_WIDTH // 2
    hp = jnp.pad(h, ((0, 0), (half, half), (0, 0)))
    out = b
    for t in range(CONV_WIDTH):
        out = out + hp[:, t:t + S] * w[t]
    return out


def conv_gated_ffn(h, w_up, conv_w, conv_b, w_down):
    a = depthwise_conv_centred(h @ w_up, conv_w, conv_b)
    g, u = jnp.split(a, 2, axis=-1)
    return (jax.nn.silu(g) * u) @ w_down


def setup_inputs(seed: int = 0) -> dict:
    key = jax.random.key(seed)
    ks = jax.random.split(key, 20)
    f32 = jnp.float32
    nrm = lambda k, shape, scale: jax.random.normal(k, shape, f32) * scale
    res_scale = (2.0 * DEPTH) ** -0.5
    return {
        "x": jax.random.normal(ks[0], (BATCH, SEQ, D_MODEL), f32),
        "norm1_g": 1.0 + nrm(ks[1], (DEPTH, D_MODEL), 0.02),
        "w_in": nrm(ks[2], (DEPTH, D_MODEL, IN_WIDTH), D_MODEL ** -0.5),
        "q_norm_g": 1.0 + nrm(ks[3], (DEPTH, HEAD_DIM), 0.02),
        "k_norm_g": 1.0 + nrm(ks[4], (DEPTH, HEAD_DIM), 0.02),
        "sink": nrm(ks[5], (DEPTH, N_Q_HEADS), 0.5),
        "sgu_ln_g": 1.0 + nrm(ks[6], (DEPTH, GMLP_WIDTH), 0.02),
        "sgu_ln_b": nrm(ks[7], (DEPTH, GMLP_WIDTH), 0.02),
        "w_s": nrm(ks[8], (DEPTH, N_GMLP_HEADS, CHUNK, CHUNK), 0.5 * CHUNK ** -0.5),
        "b_s": 1.0 + nrm(ks[9], (DEPTH, N_GMLP_HEADS, CHUNK), 0.02),
        "attn_out_g": 1.0 + nrm(ks[10], (DEPTH, ATTN_WIDTH), 0.02),
        "sgu_out_g": 1.0 + nrm(ks[11], (DEPTH, GMLP_WIDTH), 0.02),
        "w_o": nrm(ks[12], (DEPTH, D_MODEL, D_MODEL), D_MODEL ** -0.5 * res_scale),
        "norm2_g": 1.0 + nrm(ks[13], (DEPTH, D_MODEL), 0.02),
        "w_up": nrm(ks[14], (DEPTH, D_MODEL, 2 * D_FF), D_MODEL ** -0.5),
        "conv_w": nrm(ks[15], (DEPTH, CONV_WIDTH, 2 * D_FF), CONV_WIDTH ** -0.5),
        "conv_b": nrm(ks[16], (DEPTH, 2 * D_FF), 0.01),
        "w_down": nrm(ks[17], (DEPTH, D_FF, D_MODEL), D_FF ** -0.5 * res_scale),
    }


def reference(x, norm1_g, w_in, q_norm_g, k_norm_g, sink, sgu_ln_g, sgu_ln_b, w_s, b_s,
              attn_out_g, sgu_out_g, w_o, norm2_g, w_up, conv_w, conv_b, w_down):
    B, S, _ = x.shape
    cos, sin = rope_tables(S)
    splits = [ATTN_WIDTH, ATTN_WIDTH + KV_WIDTH, ATTN_WIDTH + 2 * KV_WIDTH,
              ATTN_WIDTH + 2 * KV_WIDTH + GMLP_WIDTH]
    for l in range(DEPTH):
        h = rms_norm(x, norm1_g[l])
        q, k, v, gu, gv = jnp.split(h @ w_in[l], splits, axis=-1)
        q = apply_rope(rms_norm(q.reshape(B, S, N_Q_HEADS, HEAD_DIM), q_norm_g[l]), cos, sin)
        k = apply_rope(rms_norm(k.reshape(B, S, N_KV_HEADS, HEAD_DIM), k_norm_g[l]), cos, sin)
        v = v.reshape(B, S, N_KV_HEADS, HEAD_DIM)
        attn = banded_window_attention(q, k, v, sink[l])
        sgu = chunked_spatial_gating(jax.nn.gelu(gu), jax.nn.gelu(gv),
                                     sgu_ln_g[l], sgu_ln_b[l], w_s[l], b_s[l])
        mixed = jnp.concatenate([rms_norm(attn, attn_out_g[l]), rms_norm(sgu, sgu_out_g[l])], axis=-1)
        x = x + mixed @ w_o[l]
        x = x + conv_gated_ffn(rms_norm(x, norm2_g[l]), w_up[l], conv_w[l], conv_b[l], w_down[l])
    return x
```

```cpp
#include <hip/hip_runtime.h>
#include <hip/hip_cooperative_groups.h>
#include <cstdio>
#include <cstdint>
namespace cg = cooperative_groups;

#define LAS __attribute__((address_space(3)))
typedef unsigned short bf16_t;
typedef short bf16x8 __attribute__((ext_vector_type(8)));
typedef short s16x4 __attribute__((ext_vector_type(4)));
typedef float f32x4 __attribute__((ext_vector_type(4)));
typedef float f32x2 __attribute__((ext_vector_type(2)));
typedef float f32x16 __attribute__((ext_vector_type(16)));
typedef unsigned u32x4 __attribute__((ext_vector_type(4)));
typedef unsigned u32x2 __attribute__((ext_vector_type(2)));
typedef __bf16 bf16x2_t __attribute__((ext_vector_type(2)));

constexpr int T = 16384, SEQ = 2048, DM = 2048, NIN = 3584, DFF = 5632, NUP = 11264, DEPTH = 2;
constexpr float EPS = 1e-6f;
constexpr float LOG2E = 1.4426950408889634f;

constexpr size_t SZ_WIN = (size_t)NIN * DM * 2, SZ_WO = (size_t)DM * DM * 2, SZ_WUP = (size_t)NUP * DM * 2, SZ_WDN = (size_t)DM * DFF * 2;
constexpr size_t OFF_WIN = 0;
constexpr size_t OFF_WO = OFF_WIN + DEPTH * SZ_WIN;
constexpr size_t OFF_WUP = OFF_WO + DEPTH * SZ_WO;
constexpr size_t OFF_WDN = OFF_WUP + DEPTH * SZ_WUP;
constexpr size_t OFF_WS = OFF_WDN + DEPTH * SZ_WDN;
constexpr size_t OFF_COS = OFF_WS + (size_t)DEPTH * 8 * 128 * 128 * 2;
constexpr size_t OFF_SIN = OFF_COS + (size_t)SEQ * 64 * 4;
constexpr size_t OFF_XB = OFF_SIN + (size_t)SEQ * 64 * 4;
constexpr size_t OFF_XSS = OFF_XB + (size_t)T * DM * 2;
constexpr size_t OFF_Q = OFF_XSS + (size_t)T * 32 * 4;
constexpr size_t OFF_K = OFF_Q + (size_t)T * 1024 * 2;
constexpr size_t OFF_V = OFF_K + (size_t)T * 256 * 2;
constexpr size_t OFF_GU = OFF_V + (size_t)T * 256 * 2;
constexpr size_t OFF_GV = OFF_GU + (size_t)T * 1024 * 2;
constexpr size_t OFF_MIX = OFF_GV + (size_t)T * 1024 * 2;
constexpr size_t OFF_QSS = OFF_MIX + (size_t)T * DM * 2;
constexpr size_t OFF_KSS = OFF_QSS + (size_t)T * 32 * 4;
constexpr size_t OFF_GVS = OFF_KSS + (size_t)T * 8 * 4;
constexpr size_t OFF_ACT = OFF_GVS + (size_t)T * 32 * 4;
constexpr size_t OFF_HALO = OFF_ACT + (size_t)T * DFF * 2;
constexpr size_t WS_END = OFF_HALO + (size_t)(T / 64 * 4) * NUP * 2;

constexpr int LDS_BYTES = 147456;

__device__ __forceinline__ unsigned cvt_pk_bf16(float lo, float hi) { f32x2 v = {lo, hi}; bf16x2_t b = __builtin_convertvector(v, bf16x2_t); return __builtin_bit_cast(unsigned, b); }
__device__ __forceinline__ float bf_lo(unsigned u) { return __uint_as_float(u << 16); }
__device__ __forceinline__ float bf_hi(unsigned u) { return __uint_as_float(u & 0xffff0000u); }
__device__ __forceinline__ float gelu_tanh(float x) {
    const float u = 0.7978845608028654f * (x + 0.044715f * x * x * x);
    const float e = __builtin_amdgcn_exp2f(-2.0f * LOG2E * u);
    return x * __builtin_amdgcn_rcpf(1.0f + e);
}
__device__ __forceinline__ float silu_f(float x) { const float e = __builtin_amdgcn_exp2f(-LOG2E * x); return x * __builtin_amdgcn_rcpf(1.0f + e); }
__device__ __forceinline__ float dot4(f32x4 a) { return (a.x * a.x + a.y * a.y) + (a.z * a.z + a.w * a.w); }
__device__ __forceinline__ float sum4(f32x4 a) { return (a.x + a.y) + (a.z + a.w); }
__device__ __forceinline__ int crow(int r, int hi) { return (r & 3) + 8 * (r >> 2) + 4 * hi; }
__device__ __forceinline__ float wave_sum(float v) {
#pragma unroll
    for (int o = 1; o < 64; o <<= 1) v += __shfl_xor(v, o);
    return v;
}

__device__ __forceinline__ float dpp_prev(float v) { return __int_as_float(__builtin_amdgcn_update_dpp(0, __float_as_int(v), 0x121, 0xF, 0xF, false)); }
__device__ __forceinline__ float dpp_next(float v) { return __int_as_float(__builtin_amdgcn_update_dpp(0, __float_as_int(v), 0x12F, 0xF, 0xF, false)); }

namespace pg8 {
constexpr int BM = 256, BK = 64, HALF = 128, HTB = HALF * BK * 2, STAGE_BYTES = 8 * HTB, NXCD = 8, WGM = 8;
__host__ __device__ __forceinline__ int lds_byte(int r, int c) { const int st = (r >> 4) * 2 + (c >> 5), rr = r & 15, cc = c & 31, ob = rr * 64 + cc * 2; return st * 1024 + (ob ^ (((ob >> 9) & 1) << 5)); }
__host__ __device__ __forceinline__ void stage_rc(int b, int& R, int& C) { const int st = b / 1024, sb = b % 1024, swz = sb ^ (((sb >> 9) & 1) << 5); R = (st >> 1) * 16 + swz / 64; C = (st & 1) * 32 + (swz % 64) / 2; }
__host__ __device__ __forceinline__ int perm32(int rho) { const int n = rho >> 4, i = rho & 15; return 8 * (i >> 2) + 4 * n + (i & 3); }
struct Unit { int pm, pn; };
struct Gemm { const bf16_t* A; const bf16_t* Bt; int M, N, K; };
struct StaticOrder {
    int nM, nN, nwg, G, c;
    __host__ __device__ void init(int M, int N, int G_, int c_) { nM = M / BM; nN = N / BM; nwg = nM * nN; G = G_; c = c_; }
    __host__ __device__ bool next(int i, Unit& u) const {
        const long L = (long)i * G + c; if (L >= nwg) return false;
        int wgid = (int)L; { const int q = nwg / NXCD, r = nwg % NXCD, xcd = wgid % NXCD, off = wgid / NXCD; wgid = (xcd < r ? xcd * (q + 1) : r * (q + 1) + (xcd - r) * q) + off; }
        const int nig = WGM * nN, gid = wgid / nig, fm = gid * WGM, gsz = (nM - fm) < WGM ? (nM - fm) : WGM;
        u.pm = fm + ((wgid % nig) % gsz); u.pn = (wgid % nig) / gsz; return true;
    }
};

template <class Epi, class Sched>
__device__ __forceinline__ void gemm_phase(LAS unsigned char* lds, const Gemm g, const Sched& S, const Epi& E) {
    int tid = threadIdx.x; asm volatile("" : "+v"(tid));
    const int wid = __builtin_amdgcn_readfirstlane(tid >> 6), lane = tid & 63, wr = wid >> 2, wc = wid & 3, fr = lane & 15, fq = lane >> 4;
    const int K = g.K, nt = K / BK;
    unsigned voffA[2], voffB[2];
#pragma unroll
    for (int i = 0; i < 2; ++i) { int R, C; stage_rc(tid * 16 + i * 8192, R, C); const int Rb = (R & ~31) + perm32(R & 31);
        voffA[i] = (unsigned)(R * K + C) * 2u; voffB[i] = (unsigned)(Rb * K + C) * 2u; }
    const size_t kstep = (size_t)(BK * 2);
    const size_t hstep = (size_t)HALF * K * 2;
    const size_t tstep = 2 * hstep;
    const unsigned ldsw = (unsigned)wid * 1024u;
    const int aoff = lds_byte(wr * 64 + fr, fq * 8), boff = lds_byte(wc * 32 + fr, fq * 8);
#define PG8_SA(b, h) (((b) * 2 + (h)) * HTB)
#define PG8_SB(b, h) ((4 + (b) * 2 + (h)) * HTB)
#define PG8_STAGE(bufoff, gbase, voff) do { _Pragma("unroll") for (int _i = 0; _i < 2; ++_i) \
        __builtin_amdgcn_global_load_lds((const unsigned*)((const char*)(gbase) + (voff)[_i]), (LAS unsigned*)(lds + (bufoff) + ldsw + _i * 8192), 16, 0, 0); } while (0)
#define PG8_LDA(dst, b, h) do { _Pragma("unroll") for (int m = 0; m < 4; ++m) _Pragma("unroll") for (int k = 0; k < 2; ++k) dst[m][k] = *(const LAS bf16x8*)(lds + PG8_SA(b, h) + aoff + m * 2048 + k * 1024); } while (0)
#define PG8_LDB(dst, b, h) do { _Pragma("unroll") for (int n = 0; n < 2; ++n) _Pragma("unroll") for (int k = 0; k < 2; ++k) dst[n][k] = *(const LAS bf16x8*)(lds + PG8_SB(b, h) + boff + n * 2048 + k * 1024); } while (0)
#define PG8_MMA(ai, bj, At, Bt) do { __builtin_amdgcn_s_setprio(1); _Pragma("unroll") for (int m = 0; m < 4; ++m) _Pragma("unroll") for (int n = 0; n < 2; ++n) _Pragma("unroll") for (int k = 0; k < 2; ++k) \
        acc[ai][bj][m][n] = __builtin_amdgcn_mfma_f32_16x16x32_bf16(Bt[n][k], At[m][k], acc[ai][bj][m][n], 0, 0, 0); __builtin_amdgcn_s_setprio(0); } while (0)
#define PG8_WAIT_V(n) asm volatile("s_waitcnt vmcnt(" #n ")" ::: "memory")
#define PG8_WAIT_L(n) asm volatile("s_waitcnt lgkmcnt(" #n ")" ::: "memory")
#define PG8_BAR __builtin_amdgcn_s_barrier()
#define PG8_SCHED __builtin_amdgcn_sched_barrier(0)
    Unit cur, nxt; int ui = 0;
    if (!S.next(0, cur)) return;
    f32x4 acc[2][2][4][2];
#pragma unroll
    for (int a = 0; a < 2; ++a)
#pragma unroll
        for (int b = 0; b < 2; ++b)
#pragma unroll
            for (int m = 0; m < 4; ++m)
#pragma unroll
                for (int n = 0; n < 2; ++n) acc[a][b][m][n] = (f32x4){0.f, 0.f, 0.f, 0.f};
    bf16x8 At[4][2], B0[2][2], B1[2][2];
    const char* cA = (const char*)g.A + (size_t)cur.pm * tstep; const char* cB = (const char*)g.Bt + (size_t)cur.pn * tstep;
    PG8_STAGE(PG8_SB(0, 0), cB, voffB); PG8_STAGE(PG8_SB(0, 1), cB + hstep, voffB); PG8_STAGE(PG8_SA(0, 0), cA, voffA); PG8_STAGE(PG8_SA(0, 1), cA + hstep, voffA);
    if (wr == 1) PG8_BAR;
    PG8_WAIT_V(2); PG8_BAR;
    PG8_STAGE(PG8_SB(1, 0), cB + kstep, voffB); PG8_STAGE(PG8_SA(1, 0), cA + kstep, voffA); PG8_STAGE(PG8_SB(1, 1), cB + hstep + kstep, voffB);
    PG8_WAIT_V(6); PG8_BAR;
    for (;;) {
        const bool has_next = S.next(ui + 1, nxt);
        const char* nA = has_next ? (const char*)g.A + (size_t)nxt.pm * tstep : cA; const char* nB = has_next ? (const char*)g.Bt + (size_t)nxt.pn * tstep : cB;
        for (int t = 0; t < nt; t += 2) {
            const bool last = (t == nt - 2);
            const char* a1 = cA + (size_t)(t + 1) * kstep;
            const char* a2 = last ? nA : cA + (size_t)(t + 2) * kstep; const char* b2 = last ? nB : cB + (size_t)(t + 2) * kstep;
            const char* a3 = a2 + kstep; const char* b3 = b2 + kstep;
            PG8_LDB(B0, 0, 0); PG8_LDB(B1, 0, 1); PG8_SCHED; PG8_LDA(At, 0, 0); PG8_STAGE(PG8_SA(1, 1), a1 + hstep, voffA);
            PG8_WAIT_V(8); PG8_WAIT_L(0); PG8_BAR; PG8_MMA(0, 0, At, B0); PG8_MMA(0, 1, At, B1); PG8_BAR; PG8_SCHED;
            PG8_LDA(At, 0, 1); PG8_STAGE(PG8_SB(0, 0), b2, voffB); PG8_STAGE(PG8_SB(0, 1), b2 + hstep, voffB); PG8_STAGE(PG8_SA(0, 0), a2, voffA);
            PG8_WAIT_V(8); PG8_WAIT_L(0); PG8_BAR; PG8_MMA(1, 0, At, B0); PG8_MMA(1, 1, At, B1); PG8_BAR; PG8_SCHED;
            PG8_LDB(B0, 1, 0); PG8_LDB(B1, 1, 1); PG8_SCHED; PG8_LDA(At, 1, 0); PG8_STAGE(PG8_SA(0, 1), a2 + hstep, voffA);
            PG8_WAIT_V(8); PG8_WAIT_L(0); PG8_BAR; PG8_MMA(0, 0, At, B0); PG8_MMA(0, 1, At, B1); PG8_BAR; PG8_SCHED;
            PG8_LDA(At, 1, 1); PG8_STAGE(PG8_SB(1, 0), b3, voffB); PG8_STAGE(PG8_SB(1, 1), b3 + hstep, voffB); PG8_STAGE(PG8_SA(1, 0), a3, voffA);
            PG8_WAIT_V(8); PG8_WAIT_L(0); PG8_BAR; PG8_MMA(1, 0, At, B0); PG8_MMA(1, 1, At, B1); PG8_BAR; PG8_SCHED;
        }
        if (wr == 0) PG8_BAR;
        E(acc, cur, wr, wc, fr, fq);
        if (!has_next) break;
#pragma unroll
        for (int a = 0; a < 2; ++a)
#pragma unroll
            for (int b = 0; b < 2; ++b)
#pragma unroll
                for (int m = 0; m < 4; ++m)
#pragma unroll
                    for (int n = 0; n < 2; ++n) acc[a][b][m][n] = (f32x4){0.f, 0.f, 0.f, 0.f};
        cur = nxt; cA = nA; cB = nB; ++ui;
        if (wr == 1) PG8_BAR;
    }
    PG8_WAIT_V(0);
    PG8_BAR;
#undef PG8_SA
#undef PG8_SB
#undef PG8_STAGE
#undef PG8_LDA
#undef PG8_LDB
#undef PG8_MMA
#undef PG8_WAIT_V
#undef PG8_WAIT_L
#undef PG8_BAR
#undef PG8_SCHED
}
}
using pg8::Unit;

__device__ __forceinline__ void row_rstd(const float* xss, int row0, int fq, float (&r)[2][4]) {
#pragma unroll
    for (int ai = 0; ai < 2; ++ai)
#pragma unroll
        for (int m = 0; m < 4; ++m) {
            const f32x4* p = (const f32x4*)(xss + (size_t)(row0 + 128 * ai + 16 * m) * 32 + 8 * fq);
            const f32x4 a = p[0], b = p[1];
            float s = sum4(a) + sum4(b);
            s += __shfl_xor(s, 16); s += __shfl_xor(s, 32);
            r[ai][m] = rsqrtf(s * (1.0f / DM) + EPS);
            if (m & 1) asm volatile("" ::: "memory");
        }
}

struct EpiIn {
    const float* xss; const float* qg; const float* kg; const float* cosT; const float* sinT;
    bf16_t *Q, *K, *V, *GU, *GV; float *qss, *kss, *gvs;
    __device__ __forceinline__ void operator()(const f32x4 (&acc)[2][2][4][2], const Unit& u, int wr, int wc, int fr, int fq) const {
        asm volatile("" : "+v"(fr), "+v"(fq));
        const int row0 = u.pm * 256 + wr * 64 + fr;
        float rr[2][4]; row_rstd(xss, row0, fq, rr);
        const int pn = u.pn;
        if (pn < 5) {
            const bool isq = pn < 4;
            const float* gn = isq ? qg : kg;
            const int gg = 4 * wc + fq;
            const f32x4 glo = *(const f32x4*)(gn + 4 * gg), ghi = *(const f32x4*)(gn + 64 + 4 * gg);
#pragma unroll
            for (int ai = 0; ai < 2; ++ai)
#pragma unroll
                for (int m = 0; m < 4; ++m) {
                    const int row = row0 + 128 * ai + 16 * m, pos = row & (SEQ - 1);
                    const f32x4 c = *(const f32x4*)(cosT + pos * 64 + 4 * gg), s = *(const f32x4*)(sinT + pos * 64 + 4 * gg);
                    const float r = rr[ai][m];
#pragma unroll
                    for (int bj = 0; bj < 2; ++bj) {
                        const f32x4 v0 = acc[ai][bj][m][0] * r, v1 = acc[ai][bj][m][1] * r;
                        float ss = dot4(v0) + dot4(v1);
                        ss += __shfl_xor(ss, 16); ss += __shfl_xor(ss, 32);
                        const int head = isq ? 2 * pn + bj : bj;
                        if (fq == 0) { if (isq) qss[((size_t)row * 8 + head) * 4 + wc] = ss; else kss[((size_t)row * 2 + head) * 4 + wc] = ss; }
                        const f32x4 y0 = v0 * glo, y1 = v1 * ghi;
                        const f32x4 lo = y0 * c - y1 * s, hi = y1 * c + y0 * s;
                        bf16_t* dst = (isq ? Q + (size_t)row * 1024 : K + (size_t)row * 256) + head * 128;
                        u32x2 wl, wh; wl.x = cvt_pk_bf16(lo.x, lo.y); wl.y = cvt_pk_bf16(lo.z, lo.w); wh.x = cvt_pk_bf16(hi.x, hi.y); wh.y = cvt_pk_bf16(hi.z, hi.w);
                        *(u32x2*)(dst + 4 * gg) = wl; *(u32x2*)(dst + 64 + 4 * gg) = wh;
                    }
                    asm volatile("" ::: "memory");
                }
        } else if (pn == 5) {
#pragma unroll
            for (int ai = 0; ai < 2; ++ai)
#pragma unroll
                for (int m = 0; m < 4; ++m) {
                    const int row = row0 + 128 * ai + 16 * m; const float r = rr[ai][m];
#pragma unroll
                    for (int bj = 0; bj < 2; ++bj) {
                        const f32x4 v0 = acc[ai][bj][m][0] * r, v1 = acc[ai][bj][m][1] * r;
                        u32x4 w; w.x = cvt_pk_bf16(v0.x, v0.y); w.y = cvt_pk_bf16(v0.z, v0.w); w.z = cvt_pk_bf16(v1.x, v1.y); w.w = cvt_pk_bf16(v1.z, v1.w);
                        *(u32x4*)(V + (size_t)row * 256 + bj * 128 + 32 * wc + 8 * fq) = w;
                    }
                }
        } else {
            const bool isgv = pn >= 10;
            const int ct = isgv ? pn - 10 : pn - 6;
            bf16_t* dstb = (isgv ? GV : GU) + ct * 256 + 32 * wc + 8 * fq;
#pragma unroll
            for (int ai = 0; ai < 2; ++ai)
#pragma unroll
                for (int m = 0; m < 4; ++m) {
                    const int row = row0 + 128 * ai + 16 * m; const float r = rr[ai][m];
                    float s1 = 0.f, s2 = 0.f;
#pragma unroll
                    for (int bj = 0; bj < 2; ++bj) {
                        f32x4 v0 = acc[ai][bj][m][0] * r, v1 = acc[ai][bj][m][1] * r;
                        v0.x = gelu_tanh(v0.x); v0.y = gelu_tanh(v0.y); v0.z = gelu_tanh(v0.z); v0.w = gelu_tanh(v0.w);
                        v1.x = gelu_tanh(v1.x); v1.y = gelu_tanh(v1.y); v1.z = gelu_tanh(v1.z); v1.w = gelu_tanh(v1.w);
                        s1 += sum4(v0) + sum4(v1); s2 += dot4(v0) + dot4(v1);
                        u32x4 w; w.x = cvt_pk_bf16(v0.x, v0.y); w.y = cvt_pk_bf16(v0.z, v0.w); w.z = cvt_pk_bf16(v1.x, v1.y); w.w = cvt_pk_bf16(v1.z, v1.w);
                        *(u32x4*)(dstb + (size_t)row * 1024 + bj * 128) = w;
                    }
                    if (isgv) {
                        s1 += __shfl_xor(s1, 16); s1 += __shfl_xor(s1, 32);
                        s2 += __shfl_xor(s2, 16); s2 += __shfl_xor(s2, 32);
                        if (fq == 0) *(f32x2*)(gvs + ((size_t)row * 16 + ct * 4 + wc) * 2) = (f32x2){s1, s2};
                    }
                    asm volatile("" ::: "memory");
                }
        }
    }
};

struct EpiRes {
    const float* base; float* out; bf16_t* xb; float* xss;
    __device__ __forceinline__ void operator()(const f32x4 (&acc)[2][2][4][2], const Unit& u, int wr, int wc, int fr, int fq) const {
        asm volatile("" : "+v"(fr), "+v"(fq));
        const int row0 = u.pm * 256 + wr * 64 + fr, col0 = u.pn * 256 + 32 * wc + 8 * fq;
#pragma unroll
        for (int ai = 0; ai < 2; ++ai)
#pragma unroll
            for (int m = 0; m < 4; ++m) {
                const int row = row0 + 128 * ai + 16 * m; float ss = 0.f;
#pragma unroll
                for (int bj = 0; bj < 2; ++bj) {
                    const size_t off = (size_t)row * DM + col0 + bj * 128;
                    const f32x4 b0 = *(const f32x4*)(base + off), b1 = *(const f32x4*)(base + off + 4);
                    const f32x4 o0 = b0 + acc[ai][bj][m][0], o1 = b1 + acc[ai][bj][m][1];
                    *(f32x4*)(out + off) = o0; *(f32x4*)(out + off + 4) = o1;
                    u32x4 w; w.x = cvt_pk_bf16(o0.x, o0.y); w.y = cvt_pk_bf16(o0.z, o0.w); w.z = cvt_pk_bf16(o1.x, o1.y); w.w = cvt_pk_bf16(o1.z, o1.w);
                    *(u32x4*)(xb + off) = w;
                    ss += dot4(o0) + dot4(o1);
                }
                ss += __shfl_xor(ss, 16); ss += __shfl_xor(ss, 32);
                if (fq == 0) xss[(size_t)row * 32 + u.pn * 4 + wc] = ss;
                asm volatile("" ::: "memory");
            }
    }
};

struct EpiUp {
    const float* xss; const float* cw; const float* cb; bf16_t* ACT; bf16_t* HALO;
    __device__ __forceinline__ void operator()(f32x4 (&acc)[2][2][4][2], const Unit& u, int wr, int wc, int fr, int fq) const {
        asm volatile("" : "+v"(fr), "+v"(fq));
        const int row0 = u.pm * 256 + wr * 64 + fr;
        float rr[2][4]; row_rstd(xss, row0, fq, rr);
        const int jg = u.pn * 128 + 32 * wc + 8 * fq;
#pragma unroll
        for (int ai = 0; ai < 2; ++ai)
#pragma unroll
            for (int m = 0; m < 4; ++m) {
                const float r = rr[ai][m];
#pragma unroll
                for (int bj = 0; bj < 2; ++bj) { acc[ai][bj][m][0] *= r; acc[ai][bj][m][1] *= r; }
                if (m == 0 || m == 3) {
                    const bool hal = (m == 0) ? (fr < 2) : (fr >= 14);
                    if (hal) {
                        const int row = row0 + 128 * ai + 16 * m;
                        const int hr = (row >> 6) * 4 + (m == 0 ? fr : fr - 12);
#pragma unroll
                        for (int bj = 0; bj < 2; ++bj) {
                            const f32x4 v0 = acc[ai][bj][m][0], v1 = acc[ai][bj][m][1];
                            u32x4 w; w.x = cvt_pk_bf16(v0.x, v0.y); w.y = cvt_pk_bf16(v0.z, v0.w); w.z = cvt_pk_bf16(v1.x, v1.y); w.w = cvt_pk_bf16(v1.z, v1.w);
                            *(u32x4*)(HALO + (size_t)hr * NUP + (bj ? DFF : 0) + jg) = w;
                        }
                    }
                }
            }
        __builtin_amdgcn_sched_barrier(0);
#pragma unroll
        for (int n = 0; n < 2; ++n) {
#pragma unroll
            for (int e = 0; e < 4; ++e) {
                float wv[2][4];
#pragma unroll
                for (int bj = 0; bj < 2; ++bj) {
                    const int col = (bj ? DFF : 0) + jg + 4 * n + e;
                    wv[bj][0] = cw[col]; wv[bj][1] = cw[NUP + col]; wv[bj][2] = cw[2 * NUP + col]; wv[bj][3] = cb[col];
                }
#pragma unroll
                for (int ai = 0; ai < 2; ++ai) {
                    float a[2][4];
#pragma unroll
                    for (int bj = 0; bj < 2; ++bj) {
                        float raw[4], P[4], N[4];
#pragma unroll
                        for (int m = 0; m < 4; ++m) raw[m] = acc[ai][bj][m][n][e];
                        asm volatile("" : "+v"(raw[0]), "+v"(raw[1]), "+v"(raw[2]), "+v"(raw[3]));
#pragma unroll
                        for (int m = 0; m < 4; ++m) { P[m] = dpp_prev(raw[m]); N[m] = dpp_next(raw[m]); }
#pragma unroll
                        for (int m = 0; m < 4; ++m) {
                            const float prev = fr > 0 ? P[m] : (m > 0 ? P[m > 0 ? m - 1 : 0] : 0.f);
                            const float next = fr < 15 ? N[m] : (m < 3 ? N[m < 3 ? m + 1 : 3] : 0.f);
                            a[bj][m] = wv[bj][3] + wv[bj][0] * prev + wv[bj][1] * raw[m] + wv[bj][2] * next;
                        }
                        asm volatile("" : "+v"(a[bj][0]), "+v"(a[bj][1]), "+v"(a[bj][2]), "+v"(a[bj][3]));
                    }
#pragma unroll
                    for (int m = 0; m < 4; ++m) acc[ai][0][m][n][e] = silu_f(a[0][m]) * a[1][m];
                }
                asm volatile("" ::: "memory");
            }
        }
#pragma unroll
        for (int ai = 0; ai < 2; ++ai)
#pragma unroll
            for (int m = 0; m < 4; ++m) {
                const int row = row0 + 128 * ai + 16 * m;
                const bool edge = (m == 0 && fr == 0) || (m == 3 && fr == 15);
                if (!edge) {
                    const f32x4 v0 = acc[ai][0][m][0], v1 = acc[ai][0][m][1];
                    u32x4 w; w.x = cvt_pk_bf16(v0.x, v0.y); w.y = cvt_pk_bf16(v0.z, v0.w); w.z = cvt_pk_bf16(v1.x, v1.y); w.w = cvt_pk_bf16(v1.z, v1.w);
                    *(u32x4*)(ACT + (size_t)row * DFF + jg) = w;
                }
            }
    }
};

struct Args { const float* in[18]; float* out; unsigned char* ws; };

__device__ __forceinline__ int cmap_in(int n) {
    if (n >= 1280) return n;
    const int head = n >> 7, c = n & 127, g = c >> 3, j = c & 7;
    return head * 128 + ((j < 4) ? 4 * g + j : 64 + 4 * g + (j - 4));
}
__device__ __forceinline__ int cmap_up(int n) { const int pn = n >> 8, c = n & 255; return (c < 128) ? 128 * pn + c : DFF + 128 * pn + (c - 128); }

template <int MODE>
__device__ __forceinline__ void transpose_item(const float* W, int K, int N, bf16_t* WT, const float* gk, LAS float* scr, int item, int lane) {
    const int nblk = N / 32, kb = item / nblk, nb = item % nblk, k0 = 64 * kb, n0 = 32 * nb;
    const int nn = n0 + (lane & 31);
    const int sc = MODE == 1 ? cmap_in(nn) : (MODE == 2 ? cmap_up(nn) : nn);
#pragma unroll 8
    for (int i = 0; i < 32; ++i) { const int kk = 2 * i + (lane >> 5); float v = W[(size_t)(k0 + kk) * N + sc]; if (gk) v *= gk[k0 + kk]; scr[kk * 33 + (lane & 31)] = v; }
    asm volatile("s_waitcnt lgkmcnt(0)" ::: "memory");
    const int c = lane & 7;
#pragma unroll
    for (int j = 0; j < 4; ++j) { const int n = (lane >> 3) + 8 * j; const LAS float* s = scr + (8 * c) * 33 + n;
        u32x4 o; o.x = cvt_pk_bf16(s[0 * 33], s[1 * 33]); o.y = cvt_pk_bf16(s[2 * 33], s[3 * 33]); o.z = cvt_pk_bf16(s[4 * 33], s[5 * 33]); o.w = cvt_pk_bf16(s[6 * 33], s[7 * 33]);
        *(u32x4*)(WT + (size_t)(n0 + n) * K + k0 + 8 * c) = o; }
    asm volatile("s_waitcnt lgkmcnt(0)" ::: "memory");
}

__device__ __forceinline__ void prologue(const Args& a, LAS unsigned char* lds, int G) {
    int tid = threadIdx.x; asm volatile("" : "+v"(tid));
    const int lane = tid & 63, wave = tid >> 6;
    LAS float* scr = (LAS float*)(lds + wave * 16384);
    const int gw = blockIdx.x * 8 + wave, NGW = G * 8;
    unsigned char* ws = a.ws;
    constexpr int I_IN = (DM / 64) * (NIN / 32), I_O = (DM / 64) * (DM / 32), I_UP = (DM / 64) * (NUP / 32), I_DN = (DFF / 64) * (DM / 32);
    constexpr int I_L = I_IN + I_O + I_UP + I_DN;
    for (int it = gw; it < DEPTH * I_L; it += NGW) {
        const int l = it / I_L; int r = it % I_L;
        if (r < I_IN) { transpose_item<1>(a.in[2] + (size_t)l * DM * NIN, DM, NIN, (bf16_t*)(ws + OFF_WIN + l * SZ_WIN), a.in[1] + l * DM, scr, r, lane); continue; } r -= I_IN;
        if (r < I_O) {
            const int kb = r / (DM / 32); const float* gk = (kb < 16) ? (a.in[10] + l * 1024) : (a.in[11] + l * 1024 - 1024);
            transpose_item<0>(a.in[12] + (size_t)l * DM * DM, DM, DM, (bf16_t*)(ws + OFF_WO + l * SZ_WO), gk, scr, r, lane); continue; } r -= I_O;
        if (r < I_UP) { transpose_item<2>(a.in[14] + (size_t)l * DM * NUP, DM, NUP, (bf16_t*)(ws + OFF_WUP + l * SZ_WUP), a.in[13] + l * DM, scr, r, lane); continue; } r -= I_UP;
        transpose_item<0>(a.in[17] + (size_t)l * DFF * DM, DFF, DM, (bf16_t*)(ws + OFF_WDN + l * SZ_WDN), nullptr, scr, r, lane);
    }
    {
        const float* x = a.in[0]; bf16_t* xb = (bf16_t*)(ws + OFF_XB); float* xss = (float*)(ws + OFF_XSS);
        for (int m = gw; m < T; m += NGW) {
            const f32x4* xr = (const f32x4*)(x + (size_t)m * DM) + lane; float s = 0.f;
            u32x2* o8 = (u32x2*)(xb + (size_t)m * DM) + lane;
#pragma unroll
            for (int j = 0; j < 8; ++j) { const f32x4 v = xr[64 * j]; s += dot4(v); u32x2 w; w.x = cvt_pk_bf16(v.x, v.y); w.y = cvt_pk_bf16(v.z, v.w); o8[64 * j] = w; }
            s = wave_sum(s);
            if (lane < 32) xss[(size_t)m * 32 + lane] = (lane == 0) ? s : 0.f;
        }
    }
    {
        float* cosT = (float*)(ws + OFF_COS); float* sinT = (float*)(ws + OFF_SIN);
        for (int i = blockIdx.x * 512 + tid; i < SEQ * 64; i += G * 512) {
            const int pos = i >> 6, k = i & 63;
            const float inv = (float)exp2(-(double)k * (13.287712379549449 / 64.0));
            const float ang = (float)pos * inv;
            double rev = (double)ang * 0.15915494309189535; rev -= rint(rev);
            const float fr = (float)rev;
            cosT[i] = __builtin_amdgcn_cosf(fr); sinT[i] = __builtin_amdgcn_sinf(fr);
        }
    }
    {
        const float* wsrc = a.in[8]; bf16_t* wd = (bf16_t*)(ws + OFF_WS);
        for (int i = blockIdx.x * 512 + tid; i < DEPTH * 8 * 128 * 128 / 4; i += G * 512) {
            const f32x4 v = *((const f32x4*)wsrc + i); u32x2 w; w.x = cvt_pk_bf16(v.x, v.y); w.y = cvt_pk_bf16(v.z, v.w); *((u32x2*)wd + i) = w;
        }
    }
}

__device__ __forceinline__ s16x4 vtr(const LAS unsigned char* p) { typedef short v4i16_t __attribute__((ext_vector_type(4))); return __builtin_bit_cast(s16x4, __builtin_amdgcn_ds_read_tr16_b64_v4i16((LAS v4i16_t*)p)); }
#define MFMA32(a, b, c) __builtin_amdgcn_mfma_f32_32x32x16_bf16((a), (b), (c), 0, 0, 0)

constexpr int AT_KROW = 272, AT_VROW = 288, AT_KSZ = 32 * AT_KROW, AT_VSZ = 32 * AT_VROW, AT_BUF = 2 * AT_KSZ + 2 * AT_VSZ;
constexpr int AT_RED = 2 * AT_BUF;

__device__ __forceinline__ void attn_unit(LAS unsigned char* lds, int unit, const float* sinkl, const bf16_t* Q, const bf16_t* K, const bf16_t* V, const float* qss, const float* kss, bf16_t* MIX) {
    int tid = threadIdx.x; asm volatile("" : "+v"(tid));
    const int lane = tid & 63, wid = __builtin_amdgcn_readfirstlane(tid >> 6), qi = lane & 31, hh = lane >> 5;
    const int b = unit >> 6, qb = unit & 63, q0 = qb * 32;
    const size_t rowbase = (size_t)b * SEQ;
    const int hq = wid, kvh = wid >> 2;
    const size_t qrow = rowbase + q0 + qi;
    bf16x8 qf[8];
    { const bf16_t* qp = Q + qrow * 1024 + hq * 128 + 8 * hh;
#pragma unroll
      for (int s = 0; s < 8; ++s) qf[s] = *(const bf16x8*)(qp + 16 * s); }
    const f32x4 qs = *(const f32x4*)(qss + (qrow * 8 + hq) * 4);
    const float rq = rsqrtf(sum4(qs) * (1.0f / 128.0f) + EPS);
    const float sc = rq * 0.08838834764831845f * LOG2E;
    const float sk = sinkl[hq] * LOG2E;
    float m_run = sk, l_run = (hh == 0) ? 1.f : 0.f;
    f32x16 o[4];
#pragma unroll
    for (int c = 0; c < 4; ++c)
#pragma unroll
        for (int i = 0; i < 16; ++i) o[c][i] = 0.f;
    int kb_lo = 0, kb_hi = 8;
    if (qb < 4) kb_lo = 4 - qb;
    if (qb > 59) kb_hi = 67 - qb;
    const int skey = tid >> 4, spart = tid & 15;
    u32x4 pk0, pk1, pv0, pv1; f32x4 ks0, ks1;
#define AT_LOAD(kb) do { const size_t r_ = rowbase + (size_t)(q0 - 128 + 32 * (kb) + skey); \
        pk0 = *(const u32x4*)(K + r_ * 256 + 8 * spart); pk1 = *(const u32x4*)(K + r_ * 256 + 128 + 8 * spart); \
        pv0 = *(const u32x4*)(V + r_ * 256 + 8 * spart); pv1 = *(const u32x4*)(V + r_ * 256 + 128 + 8 * spart); \
        ks0 = *(const f32x4*)(kss + r_ * 8); ks1 = *(const f32x4*)(kss + r_ * 8 + 4); } while (0)
#define AT_SCALE(p, r) do { u32x4 t_; \
        t_.x = cvt_pk_bf16(bf_lo(p.x) * r, bf_hi(p.x) * r); t_.y = cvt_pk_bf16(bf_lo(p.y) * r, bf_hi(p.y) * r); \
        t_.z = cvt_pk_bf16(bf_lo(p.z) * r, bf_hi(p.z) * r); t_.w = cvt_pk_bf16(bf_lo(p.w) * r, bf_hi(p.w) * r); p = t_; } while (0)
#define AT_WRITE(buf) do { const float r0_ = rsqrtf(sum4(ks0) * (1.0f / 128.0f) + EPS), r1_ = rsqrtf(sum4(ks1) * (1.0f / 128.0f) + EPS); \
        AT_SCALE(pk0, r0_); AT_SCALE(pk1, r1_); \
        LAS unsigned char* b_ = lds + (buf) * AT_BUF; \
        *(LAS u32x4*)(b_ + skey * AT_KROW + spart * 16) = pk0; *(LAS u32x4*)(b_ + AT_KSZ + skey * AT_KROW + spart * 16) = pk1; \
        *(LAS u32x4*)(b_ + 2 * AT_KSZ + skey * AT_VROW + spart * 16) = pv0; *(LAS u32x4*)(b_ + 2 * AT_KSZ + AT_VSZ + skey * AT_VROW + spart * 16) = pv1; } while (0)
    AT_LOAD(kb_lo); AT_WRITE(0);
    __syncthreads();
    int cur = 0;
    const int trq = (lane & 15) >> 2, trp = lane & 3, blk = (lane >> 4) & 1;
    for (int kb = kb_lo; kb <= kb_hi; ++kb) {
        if (kb < kb_hi) AT_LOAD(kb + 1);
        const LAS unsigned char* Kb = lds + cur * AT_BUF + kvh * AT_KSZ;
        const LAS unsigned char* Vb = lds + cur * AT_BUF + 2 * AT_KSZ + kvh * AT_VSZ;
        f32x16 st;
#pragma unroll
        for (int i = 0; i < 16; ++i) st[i] = 0.f;
#pragma unroll
        for (int s = 0; s < 8; ++s) { const bf16x8 kf = *(const LAS bf16x8*)(Kb + qi * AT_KROW + (16 * s + 8 * hh) * 2); st = MFMA32(kf, qf[s], st); }
        float tt[16];
#pragma unroll
        for (int i = 0; i < 16; ++i) tt[i] = st[i] * sc;
        if (kb == 0) {
#pragma unroll
            for (int i = 0; i < 16; ++i) if (crow(i, hh) < qi) tt[i] = -INFINITY;
        }
        if (kb == 8) {
#pragma unroll
            for (int i = 0; i < 16; ++i) if (crow(i, hh) > qi) tt[i] = -INFINITY;
        }
        float mx = tt[0];
#pragma unroll
        for (int i = 1; i < 16; ++i) mx = fmaxf(mx, tt[i]);
        mx = fmaxf(mx, __shfl_xor(mx, 32));
        const float m_new = fmaxf(m_run, mx);
        const float alpha = __builtin_amdgcn_exp2f(m_run - m_new);
        float ps = 0.f;
#pragma unroll
        for (int i = 0; i < 16; ++i) { tt[i] = __builtin_amdgcn_exp2f(tt[i] - m_new); ps += tt[i]; }
        l_run = l_run * alpha + ps; m_run = m_new;
#pragma unroll
        for (int c = 0; c < 4; ++c)
#pragma unroll
            for (int i = 0; i < 16; ++i) o[c][i] *= alpha;
#pragma unroll
        for (int s2 = 0; s2 < 2; ++s2) {
            u32x4 pw; pw.x = cvt_pk_bf16(tt[8 * s2 + 0], tt[8 * s2 + 1]); pw.y = cvt_pk_bf16(tt[8 * s2 + 2], tt[8 * s2 + 3]); pw.z = cvt_pk_bf16(tt[8 * s2 + 4], tt[8 * s2 + 5]); pw.w = cvt_pk_bf16(tt[8 * s2 + 6], tt[8 * s2 + 7]);
            const bf16x8 pb = __builtin_bit_cast(bf16x8, pw);
#pragma unroll
            for (int c = 0; c < 4; ++c) {
                const LAS unsigned char* vp = Vb + (16 * s2 + 4 * hh + trq) * AT_VROW + (32 * c + 16 * blk) * 2 + 8 * trp;
                const s16x4 lo = vtr(vp), hi = vtr(vp + 8 * AT_VROW);
                const bf16x8 vf = {lo[0], lo[1], lo[2], lo[3], hi[0], hi[1], hi[2], hi[3]};
                o[c] = MFMA32(vf, pb, o[c]);
            }
        }
        if (kb < kb_hi) AT_WRITE(cur ^ 1);
        __syncthreads();
        cur ^= 1;
    }
#undef AT_LOAD
#undef AT_SCALE
#undef AT_WRITE
    const float lt = l_run + __shfl_xor(l_run, 32);
    const float inv = 1.0f / lt;
    float ss = 0.f;
#pragma unroll
    for (int c = 0; c < 4; ++c)
#pragma unroll
        for (int i = 0; i < 16; ++i) { o[c][i] *= inv; ss += o[c][i] * o[c][i]; }
    ss += __shfl_xor(ss, 32);
    LAS float* red = (LAS float*)(lds + AT_RED);
    if (hh == 0) red[hq * 32 + qi] = ss;
    __syncthreads();
    float tot = 0.f;
#pragma unroll
    for (int h = 0; h < 8; ++h) tot += red[h * 32 + qi];
    const float ra = rsqrtf(tot * (1.0f / 1024.0f) + EPS);
    bf16_t* op = MIX + qrow * DM + hq * 128;
#pragma unroll
    for (int c = 0; c < 4; ++c)
#pragma unroll
        for (int g = 0; g < 4; ++g) {
            u32x2 w; w.x = cvt_pk_bf16(o[c][4 * g] * ra, o[c][4 * g + 1] * ra); w.y = cvt_pk_bf16(o[c][4 * g + 2] * ra, o[c][4 * g + 3] * ra);
            *(u32x2*)(op + 32 * c + 8 * g + 4 * hh) = w;
        }
    __syncthreads();
}

constexpr int SG_ROW = 288, SG_BUF = 128 * SG_ROW, SG_STAT = 2 * SG_BUF, SG_RED = SG_STAT + 128 * 8;
__device__ __forceinline__ void sgu_unit(LAS unsigned char* lds, int unit, const bf16_t* GU, const bf16_t* GV, const float* gvs, const float* lng, const float* lnb,
                                         const bf16_t* WS, const float* bs, bf16_t* MIX) {
    int tid = threadIdx.x; asm volatile("" : "+v"(tid));
    const int lane = tid & 63, wid = __builtin_amdgcn_readfirstlane(tid >> 6), pi = lane & 31, hh = lane >> 5;
    const int bc = unit >> 1, ph = unit & 1;
    const size_t rowbase = (size_t)bc * 128;
    LAS f32x2* stat = (LAS f32x2*)(lds + SG_STAT);
    if (tid < 128) {
        const f32x4* p = (const f32x4*)(gvs + (rowbase + tid) * 32);
        float s1 = 0.f, s2 = 0.f;
#pragma unroll
        for (int i = 0; i < 8; ++i) { const f32x4 v = p[i]; s1 += v.x + v.z; s2 += v.y + v.w; }
        const float mu = s1 * (1.0f / 1024.0f);
        const float var = s2 * (1.0f / 1024.0f) - mu * mu;
        stat[tid] = (f32x2){mu, rsqrtf(fmaxf(var, 0.f) + EPS)};
    }
    __syncthreads();
    const int psub = wid & 1, dsub = wid >> 1;
    const int spart = tid & 15;
    const int prow = ph * 64 + psub * 32 + pi;
    const int trq = (lane & 15) >> 2, trp = lane & 3, blk = (lane >> 4) & 1;
    f32x16 acc[8];
#pragma unroll
    for (int h = 0; h < 8; ++h) {
#pragma unroll
        for (int i = 0; i < 16; ++i) acc[h][i] = 0.f;
        LAS unsigned char* buf = lds + (h & 1) * SG_BUF;
        const f32x4 g0 = *(const f32x4*)(lng + h * 128 + 8 * spart), g1 = *(const f32x4*)(lng + h * 128 + 8 * spart + 4);
        const f32x4 b0 = *(const f32x4*)(lnb + h * 128 + 8 * spart), b1 = *(const f32x4*)(lnb + h * 128 + 8 * spart + 4);
#pragma unroll
        for (int i = 0; i < 4; ++i) {
            const int q = (tid >> 4) + 32 * i;
            const u32x4 v = *(const u32x4*)(GV + (rowbase + q) * 1024 + h * 128 + 8 * spart);
            const f32x2 st = stat[q];
            u32x4 w;
            w.x = cvt_pk_bf16((bf_lo(v.x) - st.x) * st.y * g0.x + b0.x, (bf_hi(v.x) - st.x) * st.y * g0.y + b0.y);
            w.y = cvt_pk_bf16((bf_lo(v.y) - st.x) * st.y * g0.z + b0.z, (bf_hi(v.y) - st.x) * st.y * g0.w + b0.w);
            w.z = cvt_pk_bf16((bf_lo(v.z) - st.x) * st.y * g1.x + b1.x, (bf_hi(v.z) - st.x) * st.y * g1.y + b1.y);
            w.w = cvt_pk_bf16((bf_lo(v.w) - st.x) * st.y * g1.z + b1.z, (bf_hi(v.w) - st.x) * st.y * g1.w + b1.w);
            *(LAS u32x4*)(buf + q * SG_ROW + spart * 16) = w;
        }
        __syncthreads();
        const bf16_t* wp = WS + ((size_t)h * 128 + prow) * 128 + 8 * hh;
#pragma unroll
        for (int s = 0; s < 8; ++s) {
            const bf16x8 wf = *(const bf16x8*)(wp + 16 * s);
            const LAS unsigned char* vp = buf + (16 * s + 8 * hh + trq) * SG_ROW + (32 * dsub + 16 * blk) * 2 + 8 * trp;
            const s16x4 lo = vtr(vp), hi = vtr(vp + 4 * SG_ROW);
            const bf16x8 vf = {lo[0], lo[1], lo[2], lo[3], hi[0], hi[1], hi[2], hi[3]};
            acc[h] = MFMA32(vf, wf, acc[h]);
        }
    }
    const size_t orow = rowbase + prow;
    float ss = 0.f;
#pragma unroll
    for (int h = 0; h < 8; ++h) {
        const float bb = bs[h * 128 + prow];
#pragma unroll
        for (int g = 0; g < 4; ++g) {
            const u32x2 gu = *(const u32x2*)(GU + orow * 1024 + h * 128 + 32 * dsub + 8 * g + 4 * hh);
            acc[h][4 * g + 0] = bf_lo(gu.x) * (acc[h][4 * g + 0] + bb); acc[h][4 * g + 1] = bf_hi(gu.x) * (acc[h][4 * g + 1] + bb);
            acc[h][4 * g + 2] = bf_lo(gu.y) * (acc[h][4 * g + 2] + bb); acc[h][4 * g + 3] = bf_hi(gu.y) * (acc[h][4 * g + 3] + bb);
        }
#pragma unroll
        for (int i = 0; i < 16; ++i) ss += acc[h][i] * acc[h][i];
    }
    ss += __shfl_xor(ss, 32);
    LAS float* red = (LAS float*)(lds + SG_RED);
    if (hh == 0) red[dsub * 64 + psub * 32 + pi] = ss;
    __syncthreads();
    const float tot = (red[psub * 32 + pi] + red[64 + psub * 32 + pi]) + (red[128 + psub * 32 + pi] + red[192 + psub * 32 + pi]);
    const float rs = rsqrtf(tot * (1.0f / 1024.0f) + EPS);
    bf16_t* op = MIX + orow * DM + 1024 + 32 * dsub;
#pragma unroll
    for (int h = 0; h < 8; ++h)
#pragma unroll
        for (int g = 0; g < 4; ++g) {
            u32x2 w; w.x = cvt_pk_bf16(acc[h][4 * g] * rs, acc[h][4 * g + 1] * rs); w.y = cvt_pk_bf16(acc[h][4 * g + 2] * rs, acc[h][4 * g + 3] * rs);
            *(u32x2*)(op + h * 128 + 8 * g + 4 * hh) = w;
        }
    __syncthreads();
}

__device__ __forceinline__ void fixup_phase(const bf16_t* HALO, const float* cw, const float* cb, bf16_t* ACT, int G) {
    constexpr int CH = DFF / 8;
    const int total = (T / 64) * 2 * CH;
    int tid = threadIdx.x; asm volatile("" : "+v"(tid));
    for (int it = blockIdx.x * 512 + tid; it < total; it += G * 512) {
        const int ch = it % CH, br = it / CH, sl = br >> 1, side = br & 1;
        const int row = sl * 64 + (side ? 63 : 0), pos = row & (SEQ - 1);
        const int j = ch * 8;
        const bf16_t* hc = HALO + (size_t)(4 * sl + (side ? 3 : 0)) * NUP;
        const bf16_t* hp = side ? HALO + (size_t)(4 * sl + 2) * NUP : (pos == 0 ? nullptr : HALO + (size_t)(4 * (sl - 1) + 3) * NUP);
        const bf16_t* hn = side ? (pos == SEQ - 1 ? nullptr : HALO + (size_t)(4 * (sl + 1)) * NUP) : HALO + (size_t)(4 * sl + 1) * NUP;
        float a[2][8];
#pragma unroll
        for (int gu = 0; gu < 2; ++gu) {
            const int col = gu * DFF + j;
            const u32x4 z = {0u, 0u, 0u, 0u};
            const u32x4 vc = *(const u32x4*)(hc + col), vp = hp ? *(const u32x4*)(hp + col) : z, vn = hn ? *(const u32x4*)(hn + col) : z;
#pragma unroll
            for (int e = 0; e < 4; ++e) {
                const int c0 = col + 2 * e;
                a[gu][2 * e] = cb[c0] + cw[c0] * bf_lo(vp[e]) + cw[NUP + c0] * bf_lo(vc[e]) + cw[2 * NUP + c0] * bf_lo(vn[e]);
                a[gu][2 * e + 1] = cb[c0 + 1] + cw[c0 + 1] * bf_hi(vp[e]) + cw[NUP + c0 + 1] * bf_hi(vc[e]) + cw[2 * NUP + c0 + 1] * bf_hi(vn[e]);
            }
        }
        u32x4 w;
        w.x = cvt_pk_bf16(silu_f(a[0][0]) * a[1][0], silu_f(a[0][1]) * a[1][1]); w.y = cvt_pk_bf16(silu_f(a[0][2]) * a[1][2], silu_f(a[0][3]) * a[1][3]);
        w.z = cvt_pk_bf16(silu_f(a[0][4]) * a[1][4], silu_f(a[0][5]) * a[1][5]); w.w = cvt_pk_bf16(silu_f(a[0][6]) * a[1][6], silu_f(a[0][7]) * a[1][7]);
        *(u32x4*)(ACT + (size_t)row * DFF + j) = w;
    }
}

typedef const __attribute__((address_space(4))) Args* ArgsP;
#define FRESH_ARGS() ArgsP ap = (ArgsP)__builtin_amdgcn_kernarg_segment_ptr(); asm volatile("" : "+s"(ap)); unsigned char* ws = ap->ws; const int G = gridDim.x, bx = blockIdx.x
__global__ void __launch_bounds__(512, 2) fwd_megakernel(Args a_unused) {
    extern __shared__ __attribute__((aligned(16))) unsigned char lds_raw[];
    LAS unsigned char* lds = (LAS unsigned char*)lds_raw;
    cg::grid_group grid = cg::this_grid();
    {
        FRESH_ARGS();
        Args a;
#pragma unroll
        for (int i = 0; i < 18; ++i) a.in[i] = ap->in[i];
        a.out = ap->out; a.ws = ws;
        prologue(a, lds, G);
    }
    grid.sync();

    for (int l = 0; l < DEPTH; ++l) {
        {
            FRESH_ARGS();
            pg8::Gemm g{(const bf16_t*)(ws + OFF_XB), (const bf16_t*)(ws + OFF_WIN + l * SZ_WIN), T, NIN, DM}; pg8::StaticOrder S; S.init(T, NIN, G, bx);
            EpiIn E{(const float*)(ws + OFF_XSS), ap->in[3] + l * 128, ap->in[4] + l * 128, (const float*)(ws + OFF_COS), (const float*)(ws + OFF_SIN),
                    (bf16_t*)(ws + OFF_Q), (bf16_t*)(ws + OFF_K), (bf16_t*)(ws + OFF_V), (bf16_t*)(ws + OFF_GU), (bf16_t*)(ws + OFF_GV),
                    (float*)(ws + OFF_QSS), (float*)(ws + OFF_KSS), (float*)(ws + OFF_GVS)};
            pg8::gemm_phase(lds, g, S, E);
        }
        grid.sync();
        {
            FRESH_ARGS();
            for (int u = bx; u < 512; u += G) attn_unit(lds, u, ap->in[5] + l * 8, (const bf16_t*)(ws + OFF_Q), (const bf16_t*)(ws + OFF_K), (const bf16_t*)(ws + OFF_V),
                                                        (const float*)(ws + OFF_QSS), (const float*)(ws + OFF_KSS), (bf16_t*)(ws + OFF_MIX));
        }
        {
            FRESH_ARGS();
            for (int u = bx; u < 256; u += G) sgu_unit(lds, u, (const bf16_t*)(ws + OFF_GU), (const bf16_t*)(ws + OFF_GV), (const float*)(ws + OFF_GVS), ap->in[6] + l * 1024, ap->in[7] + l * 1024,
                                                       (const bf16_t*)(ws + OFF_WS) + (size_t)l * 8 * 128 * 128, ap->in[9] + l * 1024, (bf16_t*)(ws + OFF_MIX));
        }
        grid.sync();
        {
            FRESH_ARGS();
            pg8::Gemm g{(const bf16_t*)(ws + OFF_MIX), (const bf16_t*)(ws + OFF_WO + l * SZ_WO), T, DM, DM}; pg8::StaticOrder S; S.init(T, DM, G, bx);
            EpiRes E{l == 0 ? ap->in[0] : ap->out, ap->out, (bf16_t*)(ws + OFF_XB), (float*)(ws + OFF_XSS)};
            pg8::gemm_phase(lds, g, S, E);
        }
        grid.sync();
        {
            FRESH_ARGS();
            pg8::Gemm g{(const bf16_t*)(ws + OFF_XB), (const bf16_t*)(ws + OFF_WUP + l * SZ_WUP), T, NUP, DM}; pg8::StaticOrder S; S.init(T, NUP, G, bx);
            EpiUp E{(const float*)(ws + OFF_XSS), ap->in[15] + (size_t)l * 3 * NUP, ap->in[16] + (size_t)l * NUP, (bf16_t*)(ws + OFF_ACT), (bf16_t*)(ws + OFF_HALO)};
            pg8::gemm_phase(lds, g, S, E);
        }
        grid.sync();
        {
            FRESH_ARGS();
            fixup_phase((const bf16_t*)(ws + OFF_HALO), ap->in[15] + (size_t)l * 3 * NUP, ap->in[16] + (size_t)l * NUP, (bf16_t*)(ws + OFF_ACT), G);
        }
        grid.sync();
        {
            FRESH_ARGS();
            pg8::Gemm g{(const bf16_t*)(ws + OFF_ACT), (const bf16_t*)(ws + OFF_WDN + l * SZ_WDN), T, DM, DFF}; pg8::StaticOrder S; S.init(T, DM, G, bx);
            EpiRes E{ap->out, ap->out, (bf16_t*)(ws + OFF_XB), (float*)(ws + OFF_XSS)};
            pg8::gemm_phase(lds, g, S, E);
        }
        if (l + 1 < DEPTH) grid.sync();
    }
}

extern "C" void kernel_launch(void* const* d_in, const int* in_sizes, int n_in, void* d_out, int out_size, void* d_ws, size_t ws_size, hipStream_t stream) {
    static int grid = 0;
    if (grid == 0) {
        if (n_in != 18 || out_size != T * DM || ws_size < WS_END) { fprintf(stderr, "kernel_launch: unexpected problem (n_in %d, out %d, ws %zu < %zu)\n", n_in, out_size, ws_size, (size_t)WS_END); grid = -1; return; }
        int dev = 0, cus = 0, per_cu = 0;
        hipGetDevice(&dev);
        hipDeviceGetAttribute(&cus, hipDeviceAttributeMultiprocessorCount, dev);
        hipFuncSetAttribute((const void*)fwd_megakernel, hipFuncAttributeMaxDynamicSharedMemorySize, LDS_BYTES);
        hipOccupancyMaxActiveBlocksPerMultiprocessor(&per_cu, (const void*)fwd_megakernel, 512, LDS_BYTES);
        if (per_cu < 1) per_cu = 1;
        grid = cus * per_cu;
        (void)hipGetLastError();
    }
    if (grid < 0) return;
    Args a{};
    for (int i = 0; i < 18; ++i) a.in[i] = (const float*)d_in[i];
    a.out = (float*)d_out; a.ws = (unsigned char*)d_ws;
    void* args[] = {&a};
    hipError_t e = hipLaunchCooperativeKernel((const void*)fwd_megakernel, dim3(grid), dim3(512), args, LDS_BYTES, stream);
    if (e != hipSuccess) fprintf(stderr, "cooperative launch failed: %s (grid %d)\n", hipGetErrorString(e), grid);
}
```

```cpp
#include <hip/hip_runtime.h>
#include <hip/hip_cooperative_groups.h>
#include <cstdio>
#include <cstdint>
namespace cg = cooperative_groups;

#define LAS __attribute__((address_space(3)))
typedef unsigned short bf16_t;
typedef short bf16x8 __attribute__((ext_vector_type(8)));
typedef short s16x4 __attribute__((ext_vector_type(4)));
typedef float f32x4 __attribute__((ext_vector_type(4)));
typedef float f32x2 __attribute__((ext_vector_type(2)));
typedef float f32x16 __attribute__((ext_vector_type(16)));
typedef unsigned u32x4 __attribute__((ext_vector_type(4)));
typedef unsigned u32x2 __attribute__((ext_vector_type(2)));
typedef __bf16 bf16x2_t __attribute__((ext_vector_type(2)));

constexpr int T = 16384, SEQ = 2048, DM = 2048, NIN = 3584, DFF = 5632, NUP = 11264, DEPTH = 2;
constexpr float EPS = 1e-6f;
constexpr float LOG2E = 1.4426950408889634f;

constexpr size_t SZ_WIN = (size_t)NIN * DM * 2, SZ_WO = (size_t)DM * DM * 2, SZ_WUP = (size_t)NUP * DM * 2, SZ_WDN = (size_t)DM * DFF * 2;
constexpr size_t OFF_WIN = 0;
constexpr size_t OFF_WO = OFF_WIN + DEPTH * SZ_WIN;
constexpr size_t OFF_WUP = OFF_WO + DEPTH * SZ_WO;
constexpr size_t OFF_WDN = OFF_WUP + DEPTH * SZ_WUP;
constexpr size_t OFF_WS = OFF_WDN + DEPTH * SZ_WDN;
constexpr size_t OFF_COS = OFF_WS + (size_t)DEPTH * 8 * 128 * 128 * 2;
constexpr size_t OFF_SIN = OFF_COS + (size_t)SEQ * 64 * 4;
constexpr size_t OFF_XB = OFF_SIN + (size_t)SEQ * 64 * 4;
constexpr size_t OFF_XSS = OFF_XB + (size_t)T * DM * 2;
constexpr size_t OFF_Q = OFF_XSS + (size_t)T * 32 * 4;
constexpr size_t OFF_K = OFF_Q + (size_t)T * 1024 * 2;
constexpr size_t OFF_V = OFF_K + (size_t)T * 256 * 2;
constexpr size_t OFF_GU = OFF_V + (size_t)T * 256 * 2;
constexpr size_t OFF_GV = OFF_GU + (size_t)T * 1024 * 2;
constexpr size_t OFF_MIX = OFF_GV + (size_t)T * 1024 * 2;
constexpr size_t OFF_QSS = OFF_MIX + (size_t)T * DM * 2;
constexpr size_t OFF_KSS = OFF_QSS + (size_t)T * 32 * 4;
constexpr size_t OFF_GVS = OFF_KSS + (size_t)T * 8 * 4;
constexpr size_t OFF_ACT = OFF_GVS + (size_t)T * 32 * 4;
constexpr size_t OFF_HALO = OFF_ACT + (size_t)T * DFF * 2;
constexpr size_t OFF_CTL = OFF_HALO + (size_t)(T / 64 * 4) * NUP * 2;
constexpr size_t CTL_BYTES = 16384;
constexpr size_t WS_END = OFF_CTL + CTL_BYTES;

constexpr int LDS_BYTES = 147456;

__device__ __forceinline__ unsigned cvt_pk_bf16(float lo, float hi) { f32x2 v = {lo, hi}; bf16x2_t b = __builtin_convertvector(v, bf16x2_t); return __builtin_bit_cast(unsigned, b); }
__device__ __forceinline__ float bf_lo(unsigned u) { return __uint_as_float(u << 16); }
__device__ __forceinline__ float bf_hi(unsigned u) { return __uint_as_float(u & 0xffff0000u); }
__device__ __forceinline__ float gelu_tanh(float x) {
    const float u = 0.7978845608028654f * (x + 0.044715f * x * x * x);
    const float e = __builtin_amdgcn_exp2f(-2.0f * LOG2E * u);
    return x * __builtin_amdgcn_rcpf(1.0f + e);
}
__device__ __forceinline__ float silu_f(float x) { const float e = __builtin_amdgcn_exp2f(-LOG2E * x); return x * __builtin_amdgcn_rcpf(1.0f + e); }
__device__ __forceinline__ float dot4(f32x4 a) { return (a.x * a.x + a.y * a.y) + (a.z * a.z + a.w * a.w); }
__device__ __forceinline__ float sum4(f32x4 a) { return (a.x + a.y) + (a.z + a.w); }
__device__ __forceinline__ int crow(int r, int hi) { return (r & 3) + 8 * (r >> 2) + 4 * hi; }
__device__ __forceinline__ float wave_sum(float v) {
#pragma unroll
    for (int o = 1; o < 64; o <<= 1) v += __shfl_xor(v, o);
    return v;
}

__device__ __forceinline__ float dpp_prev(float v) { return __int_as_float(__builtin_amdgcn_update_dpp(0, __float_as_int(v), 0x121, 0xF, 0xF, false)); }
__device__ __forceinline__ float dpp_next(float v) { return __int_as_float(__builtin_amdgcn_update_dpp(0, __float_as_int(v), 0x12F, 0xF, 0xF, false)); }

__device__ __forceinline__ int lane_id_fresh() { int l; asm volatile("v_mbcnt_lo_u32_b32 %0, -1, 0\n\tv_mbcnt_hi_u32_b32 %0, -1, %0" : "=v"(l)); return l; }
__device__ __forceinline__ int fresh_tid(int wv) { return wv * 64 + lane_id_fresh(); }

namespace pg8 {
constexpr int BM = 256, BK = 64, HALF = 128, HTB = HALF * BK * 2, STAGE_BYTES = 8 * HTB, NXCD = 8, WGM = 8;
__host__ __device__ __forceinline__ int lds_byte(int r, int c) { const int st = (r >> 4) * 2 + (c >> 5), rr = r & 15, cc = c & 31, ob = rr * 64 + cc * 2; return st * 1024 + (ob ^ (((ob >> 9) & 1) << 5)); }
__host__ __device__ __forceinline__ void stage_rc(int b, int& R, int& C) { const int st = b / 1024, sb = b % 1024, swz = sb ^ (((sb >> 9) & 1) << 5); R = (st >> 1) * 16 + swz / 64; C = (st & 1) * 32 + (swz % 64) / 2; }
__host__ __device__ __forceinline__ int perm32(int rho) { const int n = rho >> 4, i = rho & 15; return 8 * (i >> 2) + 4 * n + (i & 3); }
struct Unit { int pm, pn; };
struct Gemm { const bf16_t* A; const bf16_t* Bt; int M, N, K; };
struct StaticOrder {
    int nM, nN, nwg, G, c;
    __host__ __device__ void init(int M, int N, int G_, int c_) { nM = M / BM; nN = N / BM; nwg = nM * nN; G = G_; c = c_; }
    __host__ __device__ bool next(int i, Unit& u) const {
        const long L = (long)i * G + c; if (L >= nwg) return false;
        int wgid = (int)L; { const int q = nwg / NXCD, r = nwg % NXCD, xcd = wgid % NXCD, off = wgid / NXCD; wgid = (xcd < r ? xcd * (q + 1) : r * (q + 1) + (xcd - r) * q) + off; }
        const int nig = WGM * nN, gid = wgid / nig, fm = gid * WGM, gsz = (nM - fm) < WGM ? (nM - fm) : WGM;
        u.pm = fm + ((wgid % nig) % gsz); u.pn = (wgid % nig) / gsz; return true;
    }
};

template <class Epi, class Sched>
__device__ __forceinline__ void gemm_phase(LAS unsigned char* lds, const Gemm g, const Sched& S, const Epi& E, int wv) {
    const int tid = fresh_tid(wv);
    const int wid = __builtin_amdgcn_readfirstlane(tid >> 6), lane = tid & 63, wr = wid >> 2, wc = wid & 3, fr = lane & 15, fq = lane >> 4;
    const int K = g.K, nt = K / BK;
    unsigned voffA[2], voffB[2];
#pragma unroll
    for (int i = 0; i < 2; ++i) { int R, C; stage_rc(tid * 16 + i * 8192, R, C); const int Rb = (R & ~31) + perm32(R & 31);
        voffA[i] = (unsigned)(R * K + C) * 2u; voffB[i] = (unsigned)(Rb * K + C) * 2u; }
    const size_t kstep = (size_t)(BK * 2);
    const size_t hstep = (size_t)HALF * K * 2;
    const size_t tstep = 2 * hstep;
    const unsigned ldsw = (unsigned)wid * 1024u;
    const int aoff = lds_byte(wr * 64 + fr, fq * 8), boff = lds_byte(wc * 32 + fr, fq * 8);
#define PG8_SA(b, h) (((b) * 2 + (h)) * HTB)
#define PG8_SB(b, h) ((4 + (b) * 2 + (h)) * HTB)
#define PG8_STAGE(bufoff, gbase, voff) do { _Pragma("unroll") for (int _i = 0; _i < 2; ++_i) \
        __builtin_amdgcn_global_load_lds((const unsigned*)((const char*)(gbase) + (voff)[_i]), (LAS unsigned*)(lds + (bufoff) + ldsw + _i * 8192), 16, 0, 0); } while (0)
#define PG8_LDA(dst, b, h) do { _Pragma("unroll") for (int m = 0; m < 4; ++m) _Pragma("unroll") for (int k = 0; k < 2; ++k) dst[m][k] = *(const LAS bf16x8*)(lds + PG8_SA(b, h) + aoff + m * 2048 + k * 1024); } while (0)
#define PG8_LDB(dst, b, h) do { _Pragma("unroll") for (int n = 0; n < 2; ++n) _Pragma("unroll") for (int k = 0; k < 2; ++k) dst[n][k] = *(const LAS bf16x8*)(lds + PG8_SB(b, h) + boff + n * 2048 + k * 1024); } while (0)
#define PG8_MMA(ai, bj, At, Bt) do { __builtin_amdgcn_s_setprio(1); _Pragma("unroll") for (int m = 0; m < 4; ++m) _Pragma("unroll") for (int n = 0; n < 2; ++n) _Pragma("unroll") for (int k = 0; k < 2; ++k) \
        acc[ai][bj][m][n] = __builtin_amdgcn_mfma_f32_16x16x32_bf16(Bt[n][k], At[m][k], acc[ai][bj][m][n], 0, 0, 0); __builtin_amdgcn_s_setprio(0); } while (0)
#define PG8_WAIT_V(n) asm volatile("s_waitcnt vmcnt(" #n ")" ::: "memory")
#define PG8_WAIT_L(n) asm volatile("s_waitcnt lgkmcnt(" #n ")" ::: "memory")
#define PG8_BAR __builtin_amdgcn_s_barrier()
#define PG8_SCHED __builtin_amdgcn_sched_barrier(0)
    Unit cur, nxt; int ui = 0;
    if (!S.next(0, cur)) return;
    f32x4 acc[2][2][4][2];
#pragma unroll
    for (int a = 0; a < 2; ++a)
#pragma unroll
        for (int b = 0; b < 2; ++b)
#pragma unroll
            for (int m = 0; m < 4; ++m)
#pragma unroll
                for (int n = 0; n < 2; ++n) acc[a][b][m][n] = (f32x4){0.f, 0.f, 0.f, 0.f};
    bf16x8 At[4][2], B0[2][2], B1[2][2];
    const char* cA = (const char*)g.A + (size_t)cur.pm * tstep; const char* cB = (const char*)g.Bt + (size_t)cur.pn * tstep;
    PG8_STAGE(PG8_SB(0, 0), cB, voffB); PG8_STAGE(PG8_SB(0, 1), cB + hstep, voffB); PG8_STAGE(PG8_SA(0, 0), cA, voffA); PG8_STAGE(PG8_SA(0, 1), cA + hstep, voffA);
    if (wr == 1) PG8_BAR;
    PG8_WAIT_V(2); PG8_BAR;
    PG8_STAGE(PG8_SB(1, 0), cB + kstep, voffB); PG8_STAGE(PG8_SA(1, 0), cA + kstep, voffA); PG8_STAGE(PG8_SB(1, 1), cB + hstep + kstep, voffB);
    PG8_WAIT_V(6); PG8_BAR;
    for (;;) {
        const bool has_next = S.next(ui + 1, nxt);
        const char* nA = has_next ? (const char*)g.A + (size_t)nxt.pm * tstep : cA; const char* nB = has_next ? (const char*)g.Bt + (size_t)nxt.pn * tstep : cB;
        for (int t = 0; t < nt; t += 2) {
            const bool last = (t == nt - 2);
            const char* a1 = cA + (size_t)(t + 1) * kstep;
            const char* a2 = last ? nA : cA + (size_t)(t + 2) * kstep; const char* b2 = last ? nB : cB + (size_t)(t + 2) * kstep;
            const char* a3 = a2 + kstep; const char* b3 = b2 + kstep;
            PG8_LDB(B0, 0, 0); PG8_LDB(B1, 0, 1); PG8_SCHED; PG8_LDA(At, 0, 0); PG8_STAGE(PG8_SA(1, 1), a1 + hstep, voffA);
            PG8_WAIT_V(8); PG8_WAIT_L(0); PG8_BAR; PG8_MMA(0, 0, At, B0); PG8_MMA(0, 1, At, B1); PG8_BAR; PG8_SCHED;
            PG8_LDA(At, 0, 1); PG8_STAGE(PG8_SB(0, 0), b2, voffB); PG8_STAGE(PG8_SB(0, 1), b2 + hstep, voffB); PG8_STAGE(PG8_SA(0, 0), a2, voffA);
            PG8_WAIT_V(8); PG8_WAIT_L(0); PG8_BAR; PG8_MMA(1, 0, At, B0); PG8_MMA(1, 1, At, B1); PG8_BAR; PG8_SCHED;
            PG8_LDB(B0, 1, 0); PG8_LDB(B1, 1, 1); PG8_SCHED; PG8_LDA(At, 1, 0); PG8_STAGE(PG8_SA(0, 1), a2 + hstep, voffA);
            PG8_WAIT_V(8); PG8_WAIT_L(0); PG8_BAR; PG8_MMA(0, 0, At, B0); PG8_MMA(0, 1, At, B1); PG8_BAR; PG8_SCHED;
            PG8_LDA(At, 1, 1); PG8_STAGE(PG8_SB(1, 0), b3, voffB); PG8_STAGE(PG8_SB(1, 1), b3 + hstep, voffB); PG8_STAGE(PG8_SA(1, 0), a3, voffA);
            PG8_WAIT_V(8); PG8_WAIT_L(0); PG8_BAR; PG8_MMA(1, 0, At, B0); PG8_MMA(1, 1, At, B1); PG8_BAR; PG8_SCHED;
        }
        if (wr == 0) PG8_BAR;
        E(acc, cur, wr, wc, fr, fq);
        if (!has_next) break;
#pragma unroll
        for (int a = 0; a < 2; ++a)
#pragma unroll
            for (int b = 0; b < 2; ++b)
#pragma unroll
                for (int m = 0; m < 4; ++m)
#pragma unroll
                    for (int n = 0; n < 2; ++n) acc[a][b][m][n] = (f32x4){0.f, 0.f, 0.f, 0.f};
        cur = nxt; cA = nA; cB = nB; ++ui;
        if (wr == 1) PG8_BAR;
    }
    PG8_WAIT_V(0);
    PG8_BAR;
#undef PG8_SA
#undef PG8_SB
#undef PG8_STAGE
#undef PG8_LDA
#undef PG8_LDB
#undef PG8_MMA
#undef PG8_WAIT_V
#undef PG8_WAIT_L
#undef PG8_BAR
#undef PG8_SCHED
}
}
using pg8::Unit;

__device__ __forceinline__ void row_rstd(const float* xss, int row0, int fq, float (&r)[2][4]) {
#pragma unroll
    for (int ai = 0; ai < 2; ++ai)
#pragma unroll
        for (int m = 0; m < 4; ++m) {
            const f32x4* p = (const f32x4*)(xss + (size_t)(row0 + 128 * ai + 16 * m) * 32 + 8 * fq);
            const f32x4 a = p[0], b = p[1];
            float s = sum4(a) + sum4(b);
            s += __shfl_xor(s, 16); s += __shfl_xor(s, 32);
            r[ai][m] = rsqrtf(s * (1.0f / DM) + EPS);
            if (m & 1) asm volatile("" ::: "memory");
        }
}

struct EpiIn {
    const float* xss; const float* qg; const float* kg; const float* cosT; const float* sinT;
    bf16_t *Q, *K, *V, *GU, *GV; float *qss, *kss, *gvs;
    __device__ __forceinline__ void operator()(const f32x4 (&acc)[2][2][4][2], const Unit& u, int wr, int wc, int fr, int fq) const {
        asm volatile("" : "+v"(fr), "+v"(fq));
        const int row0 = u.pm * 256 + wr * 64 + fr;
        float rr[2][4]; row_rstd(xss, row0, fq, rr);
        const int pn = u.pn;
        if (pn < 5) {
            const bool isq = pn < 4;
            const float* gn = isq ? qg : kg;
            const int gg = 4 * wc + fq;
            const f32x4 glo = *(const f32x4*)(gn + 4 * gg), ghi = *(const f32x4*)(gn + 64 + 4 * gg);
#pragma unroll
            for (int ai = 0; ai < 2; ++ai)
#pragma unroll
                for (int m = 0; m < 4; ++m) {
                    const int row = row0 + 128 * ai + 16 * m, pos = row & (SEQ - 1);
                    const f32x4 c = *(const f32x4*)(cosT + pos * 64 + 4 * gg), s = *(const f32x4*)(sinT + pos * 64 + 4 * gg);
                    const float r = rr[ai][m];
#pragma unroll
                    for (int bj = 0; bj < 2; ++bj) {
                        const f32x4 v0 = acc[ai][bj][m][0] * r, v1 = acc[ai][bj][m][1] * r;
                        float ss = dot4(v0) + dot4(v1);
                        ss += __shfl_xor(ss, 16); ss += __shfl_xor(ss, 32);
                        const int head = isq ? 2 * pn + bj : bj;
                        if (fq == 0) { if (isq) qss[((size_t)row * 8 + head) * 4 + wc] = ss; else kss[((size_t)row * 2 + head) * 4 + wc] = ss; }
                        const f32x4 y0 = v0 * glo, y1 = v1 * ghi;
                        const f32x4 lo = y0 * c - y1 * s, hi = y1 * c + y0 * s;
                        bf16_t* dst = (isq ? Q + (size_t)row * 1024 : K + (size_t)row * 256) + head * 128;
                        u32x2 wl, wh; wl.x = cvt_pk_bf16(lo.x, lo.y); wl.y = cvt_pk_bf16(lo.z, lo.w); wh.x = cvt_pk_bf16(hi.x, hi.y); wh.y = cvt_pk_bf16(hi.z, hi.w);
                        *(u32x2*)(dst + 4 * gg) = wl; *(u32x2*)(dst + 64 + 4 * gg) = wh;
                    }
                    asm volatile("" ::: "memory");
                }
        } else if (pn == 5) {
#pragma unroll
            for (int ai = 0; ai < 2; ++ai)
#pragma unroll
                for (int m = 0; m < 4; ++m) {
                    const int row = row0 + 128 * ai + 16 * m; const float r = rr[ai][m];
#pragma unroll
                    for (int bj = 0; bj < 2; ++bj) {
                        const f32x4 v0 = acc[ai][bj][m][0] * r, v1 = acc[ai][bj][m][1] * r;
                        u32x4 w; w.x = cvt_pk_bf16(v0.x, v0.y); w.y = cvt_pk_bf16(v0.z, v0.w); w.z = cvt_pk_bf16(v1.x, v1.y); w.w = cvt_pk_bf16(v1.z, v1.w);
                        *(u32x4*)(V + (size_t)row * 256 + bj * 128 + 32 * wc + 8 * fq) = w;
                    }
                }
        } else {
            const bool isgv = pn >= 10;
            const int ct = isgv ? pn - 10 : pn - 6;
            bf16_t* dstb = (isgv ? GV : GU) + ct * 256 + 32 * wc + 8 * fq;
#pragma unroll
            for (int ai = 0; ai < 2; ++ai)
#pragma unroll
                for (int m = 0; m < 4; ++m) {
                    const int row = row0 + 128 * ai + 16 * m; const float r = rr[ai][m];
                    float s1 = 0.f, s2 = 0.f;
#pragma unroll
                    for (int bj = 0; bj < 2; ++bj) {
                        f32x4 v0 = acc[ai][bj][m][0] * r, v1 = acc[ai][bj][m][1] * r;
                        v0.x = gelu_tanh(v0.x); v0.y = gelu_tanh(v0.y); v0.z = gelu_tanh(v0.z); v0.w = gelu_tanh(v0.w);
                        v1.x = gelu_tanh(v1.x); v1.y = gelu_tanh(v1.y); v1.z = gelu_tanh(v1.z); v1.w = gelu_tanh(v1.w);
                        s1 += sum4(v0) + sum4(v1); s2 += dot4(v0) + dot4(v1);
                        u32x4 w; w.x = cvt_pk_bf16(v0.x, v0.y); w.y = cvt_pk_bf16(v0.z, v0.w); w.z = cvt_pk_bf16(v1.x, v1.y); w.w = cvt_pk_bf16(v1.z, v1.w);
                        *(u32x4*)(dstb + (size_t)row * 1024 + bj * 128) = w;
                    }
                    if (isgv) {
                        s1 += __shfl_xor(s1, 16); s1 += __shfl_xor(s1, 32);
                        s2 += __shfl_xor(s2, 16); s2 += __shfl_xor(s2, 32);
                        if (fq == 0) *(f32x2*)(gvs + ((size_t)row * 16 + ct * 4 + wc) * 2) = (f32x2){s1, s2};
                    }
                    asm volatile("" ::: "memory");
                }
        }
    }
};

struct EpiRes {
    const float* base; float* out; bf16_t* xb; float* xss;
    __device__ __forceinline__ void operator()(const f32x4 (&acc)[2][2][4][2], const Unit& u, int wr, int wc, int fr, int fq) const {
        asm volatile("" : "+v"(fr), "+v"(fq));
        const int row0 = u.pm * 256 + wr * 64 + fr, col0 = u.pn * 256 + 32 * wc + 8 * fq;
#pragma unroll
        for (int ai = 0; ai < 2; ++ai)
#pragma unroll
            for (int m = 0; m < 4; ++m) {
                const int row = row0 + 128 * ai + 16 * m; float ss = 0.f;
#pragma unroll
                for (int bj = 0; bj < 2; ++bj) {
                    const size_t off = (size_t)row * DM + col0 + bj * 128;
                    const f32x4 b0 = *(const f32x4*)(base + off), b1 = *(const f32x4*)(base + off + 4);
                    const f32x4 o0 = b0 + acc[ai][bj][m][0], o1 = b1 + acc[ai][bj][m][1];
                    *(f32x4*)(out + off) = o0; *(f32x4*)(out + off + 4) = o1;
                    u32x4 w; w.x = cvt_pk_bf16(o0.x, o0.y); w.y = cvt_pk_bf16(o0.z, o0.w); w.z = cvt_pk_bf16(o1.x, o1.y); w.w = cvt_pk_bf16(o1.z, o1.w);
                    *(u32x4*)(xb + off) = w;
                    ss += dot4(o0) + dot4(o1);
                }
                ss += __shfl_xor(ss, 16); ss += __shfl_xor(ss, 32);
                if (fq == 0) xss[(size_t)row * 32 + u.pn * 4 + wc] = ss;
                if (m == 3) asm volatile("" ::: "memory");
            }
    }
};

struct EpiUp {
    const float* xss; const float* cw; const float* cb; bf16_t* ACT; bf16_t* HALO;
    __device__ __forceinline__ void operator()(f32x4 (&acc)[2][2][4][2], const Unit& u, int wr, int wc, int fr, int fq) const {
        asm volatile("" : "+v"(fr), "+v"(fq));
        const int row0 = u.pm * 256 + wr * 64 + fr;
        float rr[2][4]; row_rstd(xss, row0, fq, rr);
        const int jg = u.pn * 128 + 32 * wc + 8 * fq;
#pragma unroll
        for (int ai = 0; ai < 2; ++ai)
#pragma unroll
            for (int m = 0; m < 4; ++m) {
                const float r = rr[ai][m];
#pragma unroll
                for (int bj = 0; bj < 2; ++bj) { acc[ai][bj][m][0] *= r; acc[ai][bj][m][1] *= r; }
                if (m == 0 || m == 3) {
                    const bool hal = (m == 0) ? (fr < 2) : (fr >= 14);
                    if (hal) {
                        const int row = row0 + 128 * ai + 16 * m;
                        const int hr = (row >> 6) * 4 + (m == 0 ? fr : fr - 12);
#pragma unroll
                        for (int bj = 0; bj < 2; ++bj) {
                            const f32x4 v0 = acc[ai][bj][m][0], v1 = acc[ai][bj][m][1];
                            u32x4 w; w.x = cvt_pk_bf16(v0.x, v0.y); w.y = cvt_pk_bf16(v0.z, v0.w); w.z = cvt_pk_bf16(v1.x, v1.y); w.w = cvt_pk_bf16(v1.z, v1.w);
                            *(u32x4*)(HALO + (size_t)hr * NUP + (bj ? DFF : 0) + jg) = w;
                        }
                    }
                }
            }
        __builtin_amdgcn_sched_barrier(0);
#pragma unroll
        for (int n = 0; n < 2; ++n) {
#pragma unroll
            for (int e = 0; e < 4; ++e) {
                float wv[2][4];
#pragma unroll
                for (int bj = 0; bj < 2; ++bj) {
                    const int col = (bj ? DFF : 0) + jg + 4 * n + e;
                    wv[bj][0] = cw[col]; wv[bj][1] = cw[NUP + col]; wv[bj][2] = cw[2 * NUP + col]; wv[bj][3] = cb[col];
                }
#pragma unroll
                for (int ai = 0; ai < 2; ++ai) {
                    float a[2][4];
#pragma unroll
                    for (int bj = 0; bj < 2; ++bj) {
                        float raw[4], P[4], N[4];
#pragma unroll
                        for (int m = 0; m < 4; ++m) raw[m] = acc[ai][bj][m][n][e];
                        asm volatile("" : "+v"(raw[0]), "+v"(raw[1]), "+v"(raw[2]), "+v"(raw[3]));
#pragma unroll
                        for (int m = 0; m < 4; ++m) { P[m] = dpp_prev(raw[m]); N[m] = dpp_next(raw[m]); }
#pragma unroll
                        for (int m = 0; m < 4; ++m) {
                            const float prev = fr > 0 ? P[m] : (m > 0 ? P[m > 0 ? m - 1 : 0] : 0.f);
                            const float next = fr < 15 ? N[m] : (m < 3 ? N[m < 3 ? m + 1 : 3] : 0.f);
                            a[bj][m] = wv[bj][3] + wv[bj][0] * prev + wv[bj][1] * raw[m] + wv[bj][2] * next;
                        }
                        asm volatile("" : "+v"(a[bj][0]), "+v"(a[bj][1]), "+v"(a[bj][2]), "+v"(a[bj][3]));
                    }
#pragma unroll
                    for (int m = 0; m < 4; ++m) acc[ai][0][m][n][e] = silu_f(a[0][m]) * a[1][m];
                }
                asm volatile("" ::: "memory");
            }
        }
#pragma unroll
        for (int ai = 0; ai < 2; ++ai)
#pragma unroll
            for (int m = 0; m < 4; ++m) {
                const int row = row0 + 128 * ai + 16 * m;
                const bool edge = (m == 0 && fr == 0) || (m == 3 && fr == 15);
                if (!edge) {
                    const f32x4 v0 = acc[ai][0][m][0], v1 = acc[ai][0][m][1];
                    u32x4 w; w.x = cvt_pk_bf16(v0.x, v0.y); w.y = cvt_pk_bf16(v0.z, v0.w); w.z = cvt_pk_bf16(v1.x, v1.y); w.w = cvt_pk_bf16(v1.z, v1.w);
                    *(u32x4*)(ACT + (size_t)row * DFF + jg) = w;
                }
            }
    }
};

struct Args { const float* in[18]; float* out; unsigned char* ws; };

__device__ __forceinline__ int cmap_in(int n) {
    if (n >= 1280) return n;
    const int head = n >> 7, c = n & 127, g = c >> 3, j = c & 7;
    return head * 128 + ((j < 4) ? 4 * g + j : 64 + 4 * g + (j - 4));
}
__device__ __forceinline__ int cmap_up(int n) { const int pn = n >> 8, c = n & 255; return (c < 128) ? 128 * pn + c : DFF + 128 * pn + (c - 128); }

template <int MODE>
__device__ __forceinline__ void transpose_item(const float* W, int K, int N, bf16_t* WT, const float* gk, LAS float* scr, int item, int lane) {
    const int nblk = N / 64, kb = item / nblk, nb = item % nblk, k0 = 64 * kb, n0 = 64 * nb;
    const int c4 = lane & 15, r4 = lane >> 4;
    const int nn = n0 + 4 * c4;
    const int sc = MODE == 1 ? cmap_in(nn) : (MODE == 2 ? cmap_up(nn) : nn);
    f32x4 v[16];
    const float* src = W + (size_t)(k0 + r4) * N + sc;
#pragma unroll
    for (int i = 0; i < 16; ++i) v[i] = *(const f32x4*)(src + (size_t)(4 * i) * N);
    if (gk) {
#pragma unroll
        for (int i = 0; i < 16; ++i) v[i] *= gk[k0 + 4 * i + r4];
    }
#pragma unroll
    for (int i = 0; i < 16; ++i) { LAS float* d = scr + (4 * i + r4) * 65 + 4 * c4; d[0] = v[i].x; d[1] = v[i].y; d[2] = v[i].z; d[3] = v[i].w; }
    asm volatile("s_waitcnt lgkmcnt(0)" ::: "memory");
    const int c = lane & 7;
#pragma unroll
    for (int j = 0; j < 8; ++j) { const int n = (lane >> 3) + 8 * j; const LAS float* p = scr + (8 * c) * 65 + n;
        u32x4 o; o.x = cvt_pk_bf16(p[0 * 65], p[1 * 65]); o.y = cvt_pk_bf16(p[2 * 65], p[3 * 65]); o.z = cvt_pk_bf16(p[4 * 65], p[5 * 65]); o.w = cvt_pk_bf16(p[6 * 65], p[7 * 65]);
        *(u32x4*)(WT + (size_t)(n0 + n) * K + k0 + 8 * c) = o; }
    asm volatile("s_waitcnt lgkmcnt(0)" ::: "memory");
}

__device__ __forceinline__ void prologue(const Args& a, LAS unsigned char* lds, int G, int wv) {
    const int tid = fresh_tid(wv);
    const int lane = tid & 63, wave = tid >> 6;
    LAS float* scr = (LAS float*)(lds + wave * 16640);
    const int gw = blockIdx.x * 8 + wave, NGW = G * 8;
    unsigned char* ws = a.ws;
    constexpr int I_IN = (DM / 64) * (NIN / 64), I_O = (DM / 64) * (DM / 64), I_UP = (DM / 64) * (NUP / 64), I_DN = (DFF / 64) * (DM / 64);
    constexpr int I_L = I_IN + I_O + I_UP + I_DN;
    for (int it = gw; it < DEPTH * I_L; it += NGW) {
        const int l = it / I_L; int r = it % I_L;
        if (r < I_IN) { transpose_item<1>(a.in[2] + (size_t)l * DM * NIN, DM, NIN, (bf16_t*)(ws + OFF_WIN + l * SZ_WIN), a.in[1] + l * DM, scr, r, lane); continue; } r -= I_IN;
        if (r < I_O) {
            const int kb = r / (DM / 64); const float* gk = (kb < 16) ? (a.in[10] + l * 1024) : (a.in[11] + l * 1024 - 1024);
            transpose_item<0>(a.in[12] + (size_t)l * DM * DM, DM, DM, (bf16_t*)(ws + OFF_WO + l * SZ_WO), gk, scr, r, lane); continue; } r -= I_O;
        if (r < I_UP) { transpose_item<2>(a.in[14] + (size_t)l * DM * NUP, DM, NUP, (bf16_t*)(ws + OFF_WUP + l * SZ_WUP), a.in[13] + l * DM, scr, r, lane); continue; } r -= I_UP;
        transpose_item<0>(a.in[17] + (size_t)l * DFF * DM, DFF, DM, (bf16_t*)(ws + OFF_WDN + l * SZ_WDN), nullptr, scr, r, lane);
    }
    {
        const float* x = a.in[0]; bf16_t* xb = (bf16_t*)(ws + OFF_XB); float* xss = (float*)(ws + OFF_XSS);
        for (int m = gw; m < T; m += 2 * NGW) {
            const int m2 = m + NGW;
            const bool has2 = m2 < T;
            const f32x4* xr = (const f32x4*)(x + (size_t)m * DM) + lane; const f32x4* xr2 = (const f32x4*)(x + (size_t)(has2 ? m2 : m) * DM) + lane;
            f32x4 va[8], vb[8];
#pragma unroll
            for (int j = 0; j < 8; ++j) { va[j] = xr[64 * j]; vb[j] = xr2[64 * j]; }
            float s = 0.f, s2 = 0.f;
            u32x2* o8 = (u32x2*)(xb + (size_t)m * DM) + lane; u32x2* o82 = (u32x2*)(xb + (size_t)(has2 ? m2 : m) * DM) + lane;
#pragma unroll
            for (int j = 0; j < 8; ++j) { s += dot4(va[j]); s2 += dot4(vb[j]);
                u32x2 w; w.x = cvt_pk_bf16(va[j].x, va[j].y); w.y = cvt_pk_bf16(va[j].z, va[j].w); o8[64 * j] = w;
                u32x2 w2; w2.x = cvt_pk_bf16(vb[j].x, vb[j].y); w2.y = cvt_pk_bf16(vb[j].z, vb[j].w); if (has2) o82[64 * j] = w2; }
            s = wave_sum(s); s2 = wave_sum(s2);
            if (lane < 32) { xss[(size_t)m * 32 + lane] = (lane == 0) ? s : 0.f; if (has2) xss[(size_t)m2 * 32 + lane] = (lane == 0) ? s2 : 0.f; }
        }
    }
    {
        float* cosT = (float*)(ws + OFF_COS); float* sinT = (float*)(ws + OFF_SIN);
        for (int i = blockIdx.x * 512 + tid; i < SEQ * 64; i += G * 512) {
            const int pos = i >> 6, k = i & 63;
            const float inv = (float)exp2(-(double)k * (13.287712379549449 / 64.0));
            const float ang = (float)pos * inv;
            double rev = (double)ang * 0.15915494309189535; rev -= rint(rev);
            const float fr = (float)rev;
            cosT[i] = __builtin_amdgcn_cosf(fr); sinT[i] = __builtin_amdgcn_sinf(fr);
        }
    }
    {
        const float* wsrc = a.in[8]; bf16_t* wd = (bf16_t*)(ws + OFF_WS);
        for (int i = blockIdx.x * 512 + tid; i < DEPTH * 8 * 128 * 128 / 4; i += G * 512) {
            const f32x4 v = *((const f32x4*)wsrc + i); u32x2 w; w.x = cvt_pk_bf16(v.x, v.y); w.y = cvt_pk_bf16(v.z, v.w); *((u32x2*)wd + i) = w;
        }
    }
}

__device__ __forceinline__ s16x4 vtr(const LAS unsigned char* p) { typedef short v4i16_t __attribute__((ext_vector_type(4))); return __builtin_bit_cast(s16x4, __builtin_amdgcn_ds_read_tr16_b64_v4i16((LAS v4i16_t*)p)); }
#define MFMA32(a, b, c) __builtin_amdgcn_mfma_f32_32x32x16_bf16((a), (b), (c), 0, 0, 0)

constexpr int AT_KROW = 272, AT_VROW = 288, AT_KSZ = 32 * AT_KROW, AT_VSZ = 32 * AT_VROW, AT_BUF = 2 * AT_KSZ + 2 * AT_VSZ;
constexpr int AT_RED = 2 * AT_BUF;

__device__ __forceinline__ void attn_unit(LAS unsigned char* lds, int unit, const float* sinkl, const bf16_t* Q, const bf16_t* K, const bf16_t* V, const float* qss, const float* kss, bf16_t* MIX, int wv) {
    const int tid = fresh_tid(wv);
    const int lane = tid & 63, wid = __builtin_amdgcn_readfirstlane(tid >> 6), qi = lane & 31, hh = lane >> 5;
    const int b = unit >> 6, qb = unit & 63, q0 = qb * 32;
    const size_t rowbase = (size_t)b * SEQ;
    const int hq = wid, kvh = wid >> 2;
    const size_t qrow = rowbase + q0 + qi;
    bf16x8 qf[8];
    { const bf16_t* qp = Q + qrow * 1024 + hq * 128 + 8 * hh;
#pragma unroll
      for (int s = 0; s < 8; ++s) qf[s] = *(const bf16x8*)(qp + 16 * s); }
    const f32x4 qs = *(const f32x4*)(qss + (qrow * 8 + hq) * 4);
    const float rq = rsqrtf(sum4(qs) * (1.0f / 128.0f) + EPS);
    const float sc = rq * 0.08838834764831845f * LOG2E;
    const float sk = sinkl[hq] * LOG2E;
    float m_run = sk, l_run = (hh == 0) ? 1.f : 0.f;
    f32x16 o[4];
#pragma unroll
    for (int c = 0; c < 4; ++c)
#pragma unroll
        for (int i = 0; i < 16; ++i) o[c][i] = 0.f;
    int kb_lo = 0, kb_hi = 8;
    if (qb < 4) kb_lo = 4 - qb;
    if (qb > 59) kb_hi = 67 - qb;
    const int skey = tid >> 4, spart = tid & 15;
    u32x4 pk0, pk1, pv0, pv1; f32x4 ks0, ks1;
#define AT_LOAD(kb) do { const size_t r_ = rowbase + (size_t)(q0 - 128 + 32 * (kb) + skey); \
        pk0 = *(const u32x4*)(K + r_ * 256 + 8 * spart); pk1 = *(const u32x4*)(K + r_ * 256 + 128 + 8 * spart); \
        pv0 = *(const u32x4*)(V + r_ * 256 + 8 * spart); pv1 = *(const u32x4*)(V + r_ * 256 + 128 + 8 * spart); \
        ks0 = *(const f32x4*)(kss + r_ * 8); ks1 = *(const f32x4*)(kss + r_ * 8 + 4); } while (0)
#define AT_SCALE(p, r) do { u32x4 t_; \
        t_.x = cvt_pk_bf16(bf_lo(p.x) * r, bf_hi(p.x) * r); t_.y = cvt_pk_bf16(bf_lo(p.y) * r, bf_hi(p.y) * r); \
        t_.z = cvt_pk_bf16(bf_lo(p.z) * r, bf_hi(p.z) * r); t_.w = cvt_pk_bf16(bf_lo(p.w) * r, bf_hi(p.w) * r); p = t_; } while (0)
#define AT_WRITE(buf) do { const float r0_ = rsqrtf(sum4(ks0) * (1.0f / 128.0f) + EPS), r1_ = rsqrtf(sum4(ks1) * (1.0f / 128.0f) + EPS); \
        AT_SCALE(pk0, r0_); AT_SCALE(pk1, r1_); \
        LAS unsigned char* b_ = lds + (buf) * AT_BUF; \
        *(LAS u32x4*)(b_ + skey * AT_KROW + spart * 16) = pk0; *(LAS u32x4*)(b_ + AT_KSZ + skey * AT_KROW + spart * 16) = pk1; \
        *(LAS u32x4*)(b_ + 2 * AT_KSZ + skey * AT_VROW + spart * 16) = pv0; *(LAS u32x4*)(b_ + 2 * AT_KSZ + AT_VSZ + skey * AT_VROW + spart * 16) = pv1; } while (0)
    AT_LOAD(kb_lo); AT_WRITE(0);
    __syncthreads();
    int cur = 0;
    const int trq = (lane & 15) >> 2, trp = lane & 3, blk = (lane >> 4) & 1;
    for (int kb = kb_lo; kb <= kb_hi; ++kb) {
        if (kb < kb_hi) AT_LOAD(kb + 1);
        const LAS unsigned char* Kb = lds + cur * AT_BUF + kvh * AT_KSZ;
        const LAS unsigned char* Vb = lds + cur * AT_BUF + 2 * AT_KSZ + kvh * AT_VSZ;
        f32x16 st;
#pragma unroll
        for (int i = 0; i < 16; ++i) st[i] = 0.f;
#pragma unroll
        for (int s = 0; s < 8; ++s) { const bf16x8 kf = *(const LAS bf16x8*)(Kb + qi * AT_KROW + (16 * s + 8 * hh) * 2); st = MFMA32(kf, qf[s], st); }
        float tt[16];
#pragma unroll
        for (int i = 0; i < 16; ++i) tt[i] = st[i] * sc;
        if (kb == 0) {
#pragma unroll
            for (int i = 0; i < 16; ++i) if (crow(i, hh) < qi) tt[i] = -INFINITY;
        }
        if (kb == 8) {
#pragma unroll
            for (int i = 0; i < 16; ++i) if (crow(i, hh) > qi) tt[i] = -INFINITY;
        }
        float mx = tt[0];
#pragma unroll
        for (int i = 1; i < 16; ++i) mx = fmaxf(mx, tt[i]);
        mx = fmaxf(mx, __shfl_xor(mx, 32));
        const float m_new = fmaxf(m_run, mx);
        const float alpha = __builtin_amdgcn_exp2f(m_run - m_new);
        float ps = 0.f;
#pragma unroll
        for (int i = 0; i < 16; ++i) { tt[i] = __builtin_amdgcn_exp2f(tt[i] - m_new); ps += tt[i]; }
        l_run = l_run * alpha + ps; m_run = m_new;
#pragma unroll
        for (int c = 0; c < 4; ++c)
#pragma unroll
            for (int i = 0; i < 16; ++i) o[c][i] *= alpha;
#pragma unroll
        for (int s2 = 0; s2 < 2; ++s2) {
            u32x4 pw; pw.x = cvt_pk_bf16(tt[8 * s2 + 0], tt[8 * s2 + 1]); pw.y = cvt_pk_bf16(tt[8 * s2 + 2], tt[8 * s2 + 3]); pw.z = cvt_pk_bf16(tt[8 * s2 + 4], tt[8 * s2 + 5]); pw.w = cvt_pk_bf16(tt[8 * s2 + 6], tt[8 * s2 + 7]);
            const bf16x8 pb = __builtin_bit_cast(bf16x8, pw);
#pragma unroll
            for (int c = 0; c < 4; ++c) {
                const LAS unsigned char* vp = Vb + (16 * s2 + 4 * hh + trq) * AT_VROW + (32 * c + 16 * blk) * 2 + 8 * trp;
                const s16x4 lo = vtr(vp), hi = vtr(vp + 8 * AT_VROW);
                const bf16x8 vf = {lo[0], lo[1], lo[2], lo[3], hi[0], hi[1], hi[2], hi[3]};
                o[c] = MFMA32(vf, pb, o[c]);
            }
        }
        if (kb < kb_hi) AT_WRITE(cur ^ 1);
        __syncthreads();
        cur ^= 1;
    }
#undef AT_LOAD
#undef AT_SCALE
#undef AT_WRITE
    const float lt = l_run + __shfl_xor(l_run, 32);
    const float inv = 1.0f / lt;
    float ss = 0.f;
#pragma unroll
    for (int c = 0; c < 4; ++c)
#pragma unroll
        for (int i = 0; i < 16; ++i) { o[c][i] *= inv; ss += o[c][i] * o[c][i]; }
    ss += __shfl_xor(ss, 32);
    LAS float* red = (LAS float*)(lds + AT_RED);
    if (hh == 0) red[hq * 32 + qi] = ss;
    __syncthreads();
    float tot = 0.f;
#pragma unroll
    for (int h = 0; h < 8; ++h) tot += red[h * 32 + qi];
    const float ra = rsqrtf(tot * (1.0f / 1024.0f) + EPS);
    bf16_t* op = MIX + qrow * DM + hq * 128;
#pragma unroll
    for (int c = 0; c < 4; ++c)
#pragma unroll
        for (int g = 0; g < 4; ++g) {
            u32x2 w; w.x = cvt_pk_bf16(o[c][4 * g] * ra, o[c][4 * g + 1] * ra); w.y = cvt_pk_bf16(o[c][4 * g + 2] * ra, o[c][4 * g + 3] * ra);
            *(u32x2*)(op + 32 * c + 8 * g + 4 * hh) = w;
        }
    __syncthreads();
}

constexpr int SG_ROW = 288, SG_BUF = 128 * SG_ROW, SG_STAT = 2 * SG_BUF, SG_RED = SG_STAT + 128 * 8;
__device__ __forceinline__ void sgu_unit(LAS unsigned char* lds, int unit, const bf16_t* GU, const bf16_t* GV, const float* gvs, const float* lng, const float* lnb,
                                         const bf16_t* WS, const float* bs, bf16_t* MIX, int wv) {
    const int tid = fresh_tid(wv);
    const int lane = tid & 63, wid = __builtin_amdgcn_readfirstlane(tid >> 6), pi = lane & 31, hh = lane >> 5;
    const int bc = unit >> 1, ph = unit & 1;
    const size_t rowbase = (size_t)bc * 128;
    LAS f32x2* stat = (LAS f32x2*)(lds + SG_STAT);
    if (tid < 128) {
        const f32x4* p = (const f32x4*)(gvs + (rowbase + tid) * 32);
        float s1 = 0.f, s2 = 0.f;
#pragma unroll
        for (int i = 0; i < 8; ++i) { const f32x4 v = p[i]; s1 += v.x + v.z; s2 += v.y + v.w; }
        const float mu = s1 * (1.0f / 1024.0f);
        const float var = s2 * (1.0f / 1024.0f) - mu * mu;
        stat[tid] = (f32x2){mu, rsqrtf(fmaxf(var, 0.f) + EPS)};
    }
    __syncthreads();
    const int psub = wid & 1, dsub = wid >> 1;
    const int spart = tid & 15;
    const int prow = ph * 64 + psub * 32 + pi;
    const int trq = (lane & 15) >> 2, trp = lane & 3, blk = (lane >> 4) & 1;
    f32x16 acc[8];
#pragma unroll
    for (int h = 0; h < 8; ++h) {
#pragma unroll
        for (int i = 0; i < 16; ++i) acc[h][i] = 0.f;
        LAS unsigned char* buf = lds + (h & 1) * SG_BUF;
        const f32x4 g0 = *(const f32x4*)(lng + h * 128 + 8 * spart), g1 = *(const f32x4*)(lng + h * 128 + 8 * spart + 4);
        const f32x4 b0 = *(const f32x4*)(lnb + h * 128 + 8 * spart), b1 = *(const f32x4*)(lnb + h * 128 + 8 * spart + 4);
#pragma unroll
        for (int i = 0; i < 4; ++i) {
            const int q = (tid >> 4) + 32 * i;
            const u32x4 v = *(const u32x4*)(GV + (rowbase + q) * 1024 + h * 128 + 8 * spart);
            const f32x2 st = stat[q];
            u32x4 w;
            w.x = cvt_pk_bf16((bf_lo(v.x) - st.x) * st.y * g0.x + b0.x, (bf_hi(v.x) - st.x) * st.y * g0.y + b0.y);
            w.y = cvt_pk_bf16((bf_lo(v.y) - st.x) * st.y * g0.z + b0.z, (bf_hi(v.y) - st.x) * st.y * g0.w + b0.w);
            w.z = cvt_pk_bf16((bf_lo(v.z) - st.x) * st.y * g1.x + b1.x, (bf_hi(v.z) - st.x) * st.y * g1.y + b1.y);
            w.w = cvt_pk_bf16((bf_lo(v.w) - st.x) * st.y * g1.z + b1.z, (bf_hi(v.w) - st.x) * st.y * g1.w + b1.w);
            *(LAS u32x4*)(buf + q * SG_ROW + spart * 16) = w;
        }
        __syncthreads();
        const bf16_t* wp = WS + ((size_t)h * 128 + prow) * 128 + 8 * hh;
#pragma unroll
        for (int s = 0; s < 8; ++s) {
            const bf16x8 wf = *(const bf16x8*)(wp + 16 * s);
            const LAS unsigned char* vp = buf + (16 * s + 8 * hh + trq) * SG_ROW + (32 * dsub + 16 * blk) * 2 + 8 * trp;
            const s16x4 lo = vtr(vp), hi = vtr(vp + 4 * SG_ROW);
            const bf16x8 vf = {lo[0], lo[1], lo[2], lo[3], hi[0], hi[1], hi[2], hi[3]};
            acc[h] = MFMA32(vf, wf, acc[h]);
        }
    }
    const size_t orow = rowbase + prow;
    float ss = 0.f;
#pragma unroll
    for (int h = 0; h < 8; ++h) {
        const float bb = bs[h * 128 + prow];
#pragma unroll
        for (int g = 0; g < 4; ++g) {
            const u32x2 gu = *(const u32x2*)(GU + orow * 1024 + h * 128 + 32 * dsub + 8 * g + 4 * hh);
            acc[h][4 * g + 0] = bf_lo(gu.x) * (acc[h][4 * g + 0] + bb); acc[h][4 * g + 1] = bf_hi(gu.x) * (acc[h][4 * g + 1] + bb);
            acc[h][4 * g + 2] = bf_lo(gu.y) * (acc[h][4 * g + 2] + bb); acc[h][4 * g + 3] = bf_hi(gu.y) * (acc[h][4 * g + 3] + bb);
        }
#pragma unroll
        for (int i = 0; i < 16; ++i) ss += acc[h][i] * acc[h][i];
    }
    ss += __shfl_xor(ss, 32);
    LAS float* red = (LAS float*)(lds + SG_RED);
    if (hh == 0) red[dsub * 64 + psub * 32 + pi] = ss;
    __syncthreads();
    const float tot = (red[psub * 32 + pi] + red[64 + psub * 32 + pi]) + (red[128 + psub * 32 + pi] + red[192 + psub * 32 + pi]);
    const float rs = rsqrtf(tot * (1.0f / 1024.0f) + EPS);
    bf16_t* op = MIX + orow * DM + 1024 + 32 * dsub;
#pragma unroll
    for (int h = 0; h < 8; ++h)
#pragma unroll
        for (int g = 0; g < 4; ++g) {
            u32x2 w; w.x = cvt_pk_bf16(acc[h][4 * g] * rs, acc[h][4 * g + 1] * rs); w.y = cvt_pk_bf16(acc[h][4 * g + 2] * rs, acc[h][4 * g + 3] * rs);
            *(u32x2*)(op + h * 128 + 8 * g + 4 * hh) = w;
        }
    __syncthreads();
}

__device__ __forceinline__ void fixup_phase(const bf16_t* HALO, const float* cw, const float* cb, bf16_t* ACT, int G, int wv) {
    constexpr int CH = DFF / 8;
    const int total = (T / 64) * 2 * CH;
    const int tid = fresh_tid(wv);
    for (int it = blockIdx.x * 512 + tid; it < total; it += G * 512) {
        const int ch = it % CH, br = it / CH, sl = br >> 1, side = br & 1;
        const int row = sl * 64 + (side ? 63 : 0), pos = row & (SEQ - 1);
        const int j = ch * 8;
        const bf16_t* hc = HALO + (size_t)(4 * sl + (side ? 3 : 0)) * NUP;
        const bf16_t* hp = side ? HALO + (size_t)(4 * sl + 2) * NUP : (pos == 0 ? nullptr : HALO + (size_t)(4 * (sl - 1) + 3) * NUP);
        const bf16_t* hn = side ? (pos == SEQ - 1 ? nullptr : HALO + (size_t)(4 * (sl + 1)) * NUP) : HALO + (size_t)(4 * sl + 1) * NUP;
        float a[2][8];
#pragma unroll
        for (int gu = 0; gu < 2; ++gu) {
            const int col = gu * DFF + j;
            const u32x4 z = {0u, 0u, 0u, 0u};
            const u32x4 vc = *(const u32x4*)(hc + col), vp = hp ? *(const u32x4*)(hp + col) : z, vn = hn ? *(const u32x4*)(hn + col) : z;
#pragma unroll
            for (int e = 0; e < 4; ++e) {
                const int c0 = col + 2 * e;
                a[gu][2 * e] = cb[c0] + cw[c0] * bf_lo(vp[e]) + cw[NUP + c0] * bf_lo(vc[e]) + cw[2 * NUP + c0] * bf_lo(vn[e]);
                a[gu][2 * e + 1] = cb[c0 + 1] + cw[c0 + 1] * bf_hi(vp[e]) + cw[NUP + c0 + 1] * bf_hi(vc[e]) + cw[2 * NUP + c0 + 1] * bf_hi(vn[e]);
            }
        }
        u32x4 w;
        w.x = cvt_pk_bf16(silu_f(a[0][0]) * a[1][0], silu_f(a[0][1]) * a[1][1]); w.y = cvt_pk_bf16(silu_f(a[0][2]) * a[1][2], silu_f(a[0][3]) * a[1][3]);
        w.z = cvt_pk_bf16(silu_f(a[0][4]) * a[1][4], silu_f(a[0][5]) * a[1][5]); w.w = cvt_pk_bf16(silu_f(a[0][6]) * a[1][6], silu_f(a[0][7]) * a[1][7]);
        *(u32x4*)(ACT + (size_t)row * DFF + j) = w;
    }
}


#define XB_TMO      128
#define XB_XCNT(j)  (256  + 64 * (j))
#define XB_XSUB(j)  (1280 + 64 * (j))
#define XB_XGEN(j)  (2304 + 64 * (j))
#define XB_TOP      3328
#define XB_TOPGEN   3392
#define XCD_BAR_WORDS 3456
#define XB_SPIN_CAP (1u << 18)
__device__ __forceinline__ unsigned xb_ld(unsigned* p)              { return __hip_atomic_load(p, __ATOMIC_RELAXED, __HIP_MEMORY_SCOPE_AGENT); }
__device__ __forceinline__ unsigned xb_add(unsigned* p, unsigned v) { return __hip_atomic_fetch_add(p, v, __ATOMIC_RELAXED, __HIP_MEMORY_SCOPE_AGENT); }
__device__ __forceinline__ unsigned xb_xcc_id() { return (unsigned)__builtin_amdgcn_s_getreg((3 << 11) | 20) & 0xFu; }
#define XB_SPIN(cond, bar) do { unsigned _sp = 0; while (cond) { __builtin_amdgcn_s_sleep(1); \
    if ((++_sp & 255u) == 0u) { if (xb_ld(&(bar)[XB_TMO])) break; if (_sp > XB_SPIN_CAP) { atomicAdd(&(bar)[XB_TMO], 1u); break; } } } } while (0)
struct XcdBarrier { unsigned* bar; unsigned x; volatile LAS unsigned* st; };
__device__ __forceinline__ XcdBarrier xcd_barrier_post(unsigned* bar, volatile LAS unsigned* st) {
    XcdBarrier b; b.bar = bar; b.x = xb_xcc_id(); b.st = st;
    if (threadIdx.x == 0) (void)xb_add(&bar[XB_XCNT(b.x)], 1u);
    return b;
}
__device__ __forceinline__ void xcd_barrier_complete(unsigned* bar, unsigned x, unsigned& nloc, unsigned& nx) {
    const unsigned G = gridDim.x * gridDim.y * gridDim.z;
    unsigned sum, cnt, mine, sp = 0u;
    for (;;) {
        sum = 0u; cnt = 0u; mine = 0u;
#pragma unroll
        for (unsigned j = 0; j < 16; ++j) { const unsigned c = xb_ld(&bar[XB_XCNT(j)]); sum += c; cnt += (c > 0u) ? 1u : 0u; mine = (j == x) ? c : mine; }
        if (sum == G) break;
        __builtin_amdgcn_s_sleep(1);
        if ((++sp & 255u) == 0u) { if (xb_ld(&bar[XB_TMO])) break; if (sp > XB_SPIN_CAP) { atomicAdd(&bar[XB_TMO], 1u); break; } }
    }
    nloc = mine > 0u ? mine : 1u; nx = cnt > 0u ? cnt : 1u;
}
__device__ __forceinline__ void xcd_barrier(const XcdBarrier& b) {
    asm volatile("s_waitcnt vmcnt(0)" ::: "memory");
    __syncthreads();
    const unsigned lane = (unsigned)lane_id_fresh();
    bool leader = false;
    if (lane == 0) { const unsigned t = __hip_atomic_fetch_add((LAS unsigned*)(b.st + 2), 1u, __ATOMIC_RELAXED, __HIP_MEMORY_SCOPE_WORKGROUP); leader = (t & 7u) == 0u; }
    if (leader) {
        unsigned* bar = b.bar; unsigned x = b.x; asm volatile("" : "+s"(x));
        __builtin_amdgcn_s_waitcnt(0);
        unsigned nloc = b.st[0], nx = b.st[1];
        if (nloc == 0u) { xcd_barrier_complete(bar, x, nloc, nx); b.st[0] = nloc; b.st[1] = nx; }
        const unsigned old = xb_add(&bar[XB_XSUB(x)], 1u);
        const unsigned gen = old / nloc;
        if (old + 1u == (gen + 1u) * nloc) {
            __builtin_amdgcn_fence(__ATOMIC_RELEASE, "agent");
            asm volatile("s_waitcnt vmcnt(0)" ::: "memory");
            const unsigned og = xb_add(&bar[XB_TOP], 1u);
            const unsigned tg = og / nx;
            if (og + 1u == (tg + 1u) * nx) xb_add(&bar[XB_TOPGEN], 1u);
            else XB_SPIN(xb_ld(&bar[XB_TOPGEN]) == tg, bar);
            __builtin_amdgcn_fence(__ATOMIC_ACQUIRE, "agent");
            xb_add(&bar[XB_XGEN(x)], 1u);
            asm volatile("s_waitcnt vmcnt(0)" ::: "memory");
        } else {
            XB_SPIN(xb_ld(&bar[XB_XGEN(x)]) == gen, bar);
            __builtin_amdgcn_fence(__ATOMIC_ACQUIRE, "agent");
            asm volatile("s_waitcnt vmcnt(0)" ::: "memory");
        }
    }
    __syncthreads();
}

typedef const __attribute__((address_space(4))) Args* ArgsP;
#define FRESH_ARGS() ArgsP ap = (ArgsP)__builtin_amdgcn_kernarg_segment_ptr(); asm volatile("" : "+s"(ap)); unsigned char* ws = ap->ws; const int G = gridDim.x, bx = blockIdx.x
__global__ void __launch_bounds__(512, 2) fwd_megakernel(Args a_unused) {
    extern __shared__ __attribute__((aligned(16))) unsigned char lds_raw[];
    LAS unsigned char* lds = (LAS unsigned char*)lds_raw;
    cg::grid_group grid = cg::this_grid();
    const int wv = __builtin_amdgcn_readfirstlane(threadIdx.x >> 6);
    volatile LAS unsigned* bst = (volatile LAS unsigned*)(lds + LDS_BYTES - 16);
    if (threadIdx.x < 4) bst[threadIdx.x] = 0u;
    __syncthreads();
    XcdBarrier xbar;
    { FRESH_ARGS(); xbar = xcd_barrier_post((unsigned*)(ws + OFF_CTL), bst); (void)G; (void)bx; }
    {
        FRESH_ARGS();
        Args a;
#pragma unroll
        for (int i = 0; i < 18; ++i) a.in[i] = ap->in[i];
        a.out = ap->out; a.ws = ws;
        prologue(a, lds, G, wv);
    }
    grid.sync();

    for (int l = 0; l < DEPTH; ++l) {
        {
            FRESH_ARGS();
            pg8::Gemm g{(const bf16_t*)(ws + OFF_XB), (const bf16_t*)(ws + OFF_WIN + l * SZ_WIN), T, NIN, DM}; pg8::StaticOrder S; S.init(T, NIN, G, bx);
            EpiIn E{(const float*)(ws + OFF_XSS), ap->in[3] + l * 128, ap->in[4] + l * 128, (const float*)(ws + OFF_COS), (const float*)(ws + OFF_SIN),
                    (bf16_t*)(ws + OFF_Q), (bf16_t*)(ws + OFF_K), (bf16_t*)(ws + OFF_V), (bf16_t*)(ws + OFF_GU), (bf16_t*)(ws + OFF_GV),
                    (float*)(ws + OFF_QSS), (float*)(ws + OFF_KSS), (float*)(ws + OFF_GVS)};
            pg8::gemm_phase(lds, g, S, E, wv);
        }
        xcd_barrier(xbar);
        {
            FRESH_ARGS();
            for (int u = bx; u < 512; u += G) attn_unit(lds, u, ap->in[5] + l * 8, (const bf16_t*)(ws + OFF_Q), (const bf16_t*)(ws + OFF_K), (const bf16_t*)(ws + OFF_V),
                                                        (const float*)(ws + OFF_QSS), (const float*)(ws + OFF_KSS), (bf16_t*)(ws + OFF_MIX), wv);
        }
        {
            FRESH_ARGS();
            for (int u = bx; u < 256; u += G) sgu_unit(lds, u, (const bf16_t*)(ws + OFF_GU), (const bf16_t*)(ws + OFF_GV), (const float*)(ws + OFF_GVS), ap->in[6] + l * 1024, ap->in[7] + l * 1024,
                                                       (const bf16_t*)(ws + OFF_WS) + (size_t)l * 8 * 128 * 128, ap->in[9] + l * 1024, (bf16_t*)(ws + OFF_MIX), wv);
        }
        xcd_barrier(xbar);
        {
            FRESH_ARGS();
            pg8::Gemm g{(const bf16_t*)(ws + OFF_MIX), (const bf16_t*)(ws + OFF_WO + l * SZ_WO), T, DM, DM}; pg8::StaticOrder S; S.init(T, DM, G, bx);
            EpiRes E{l == 0 ? ap->in[0] : ap->out, ap->out, (bf16_t*)(ws + OFF_XB), (float*)(ws + OFF_XSS)};
            pg8::gemm_phase(lds, g, S, E, wv);
        }
        xcd_barrier(xbar);
        {
            FRESH_ARGS();
            pg8::Gemm g{(const bf16_t*)(ws + OFF_XB), (const bf16_t*)(ws + OFF_WUP + l * SZ_WUP), T, NUP, DM}; pg8::StaticOrder S; S.init(T, NUP, G, bx);
            EpiUp E{(const float*)(ws + OFF_XSS), ap->in[15] + (size_t)l * 3 * NUP, ap->in[16] + (size_t)l * NUP, (bf16_t*)(ws + OFF_ACT), (bf16_t*)(ws + OFF_HALO)};
            pg8::gemm_phase(lds, g, S, E, wv);
        }
        xcd_barrier(xbar);
        {
            FRESH_ARGS();
            fixup_phase((const bf16_t*)(ws + OFF_HALO), ap->in[15] + (size_t)l * 3 * NUP, ap->in[16] + (size_t)l * NUP, (bf16_t*)(ws + OFF_ACT), G, wv);
        }
        xcd_barrier(xbar);
        {
            FRESH_ARGS();
            pg8::Gemm g{(const bf16_t*)(ws + OFF_ACT), (const bf16_t*)(ws + OFF_WDN + l * SZ_WDN), T, DM, DFF}; pg8::StaticOrder S; S.init(T, DM, G, bx);
            EpiRes E{ap->out, ap->out, (bf16_t*)(ws + OFF_XB), (float*)(ws + OFF_XSS)};
            pg8::gemm_phase(lds, g, S, E, wv);
        }
        if (l + 1 < DEPTH) xcd_barrier(xbar);
    }
}

extern "C" void kernel_launch(void* const* d_in, const int* in_sizes, int n_in, void* d_out, int out_size, void* d_ws, size_t ws_size, hipStream_t stream) {
    static int grid = 0;
    if (grid == 0) {
        if (n_in != 18 || out_size != T * DM || ws_size < WS_END) { fprintf(stderr, "kernel_launch: unexpected problem (n_in %d, out %d, ws %zu < %zu)\n", n_in, out_size, ws_size, (size_t)WS_END); grid = -1; return; }
        int dev = 0, cus = 0, per_cu = 0;
        hipGetDevice(&dev);
        hipDeviceGetAttribute(&cus, hipDeviceAttributeMultiprocessorCount, dev);
        hipFuncSetAttribute((const void*)fwd_megakernel, hipFuncAttributeMaxDynamicSharedMemorySize, LDS_BYTES);
        hipOccupancyMaxActiveBlocksPerMultiprocessor(&per_cu, (const void*)fwd_megakernel, 512, LDS_BYTES);
        if (per_cu < 1) per_cu = 1;
        grid = cus * per_cu;
        (void)hipGetLastError();
    }
    if (grid < 0) return;
    Args a{};
    for (int i = 0; i < 18; ++i) a.in[i] = (const float*)d_in[i];
    a.out = (float*)d_out; a.ws = (unsigned char*)d_ws;
    (void)hipMemsetAsync((unsigned char*)d_ws + OFF_CTL, 0, CTL_BYTES, stream);
    void* args[] = {&a};
    hipError_t e = hipLaunchCooperativeKernel((const void*)fwd_megakernel, dim3(grid), dim3(512), args, LDS_BYTES, stream);
    if (e != hipSuccess) fprintf(stderr, "cooperative launch failed: %s (grid %d)\n", hipGetErrorString(e), grid);
}
```

```cpp
#include <hip/hip_runtime.h>
#include <hip/hip_cooperative_groups.h>
#include <cstdio>
#include <cstdint>
namespace cg = cooperative_groups;

#define LAS __attribute__((address_space(3)))
typedef unsigned short bf16_t;
typedef short bf16x8 __attribute__((ext_vector_type(8)));
typedef short s16x4 __attribute__((ext_vector_type(4)));
typedef float f32x4 __attribute__((ext_vector_type(4)));
typedef float f32x2 __attribute__((ext_vector_type(2)));
typedef float f32x16 __attribute__((ext_vector_type(16)));
typedef unsigned u32x4 __attribute__((ext_vector_type(4)));
typedef unsigned u32x2 __attribute__((ext_vector_type(2)));
typedef __bf16 bf16x2_t __attribute__((ext_vector_type(2)));

constexpr int T = 16384, SEQ = 2048, DM = 2048, NIN = 3584, DFF = 5632, NUP = 11264, DEPTH = 2;
constexpr float EPS = 1e-6f;
constexpr float LOG2E = 1.4426950408889634f;

constexpr size_t SZ_WIN = (size_t)NIN * DM * 2, SZ_WO = (size_t)DM * DM * 2, SZ_WUP = (size_t)NUP * DM * 2, SZ_WDN = (size_t)DM * DFF * 2;
constexpr size_t OFF_WIN = 0;
constexpr size_t OFF_WO = OFF_WIN + DEPTH * SZ_WIN;
constexpr size_t OFF_WUP = OFF_WO + DEPTH * SZ_WO;
constexpr size_t OFF_WDN = OFF_WUP + DEPTH * SZ_WUP;
constexpr size_t OFF_WS = OFF_WDN + DEPTH * SZ_WDN;
constexpr size_t OFF_COS = OFF_WS + (size_t)DEPTH * 8 * 128 * 128 * 2;
constexpr size_t OFF_SIN = OFF_COS + (size_t)SEQ * 64 * 4;
constexpr size_t OFF_XB = OFF_SIN + (size_t)SEQ * 64 * 4;
constexpr size_t OFF_XSS = OFF_XB + (size_t)T * DM * 2;
constexpr size_t OFF_Q = OFF_XSS + (size_t)T * 32 * 4;
constexpr size_t OFF_K = OFF_Q + (size_t)T * 1024 * 2;
constexpr size_t OFF_V = OFF_K + (size_t)T * 256 * 2;
constexpr size_t OFF_GU = OFF_V + (size_t)T * 256 * 2;
constexpr size_t OFF_GV = OFF_GU + (size_t)T * 1024 * 2;
constexpr size_t OFF_MIX = OFF_GV + (size_t)T * 1024 * 2;
constexpr size_t OFF_QSS = OFF_MIX + (size_t)T * DM * 2;
constexpr size_t OFF_KSS = OFF_QSS + (size_t)T * 32 * 4;
constexpr size_t OFF_GVS = OFF_KSS + (size_t)T * 8 * 4;
constexpr size_t OFF_ACT = OFF_GVS + (size_t)T * 32 * 4;
constexpr size_t OFF_HALO = OFF_ACT + (size_t)T * DFF * 2;
constexpr size_t OFF_CTL = OFF_HALO + (size_t)(T / 64 * 4) * NUP * 2;
constexpr size_t CTL_BYTES = 16384;
constexpr size_t WS_END = OFF_CTL + CTL_BYTES;

constexpr int LDS_BYTES = 147456;

__device__ __forceinline__ unsigned cvt_pk_bf16(float lo, float hi) { f32x2 v = {lo, hi}; bf16x2_t b = __builtin_convertvector(v, bf16x2_t); return __builtin_bit_cast(unsigned, b); }
__device__ __forceinline__ float bf_lo(unsigned u) { return __uint_as_float(u << 16); }
__device__ __forceinline__ float bf_hi(unsigned u) { return __uint_as_float(u & 0xffff0000u); }
__device__ __forceinline__ float gelu_tanh(float x) {
    const float u = 0.7978845608028654f * (x + 0.044715f * x * x * x);
    const float e = __builtin_amdgcn_exp2f(-2.0f * LOG2E * u);
    return x * __builtin_amdgcn_rcpf(1.0f + e);
}
__device__ __forceinline__ float silu_f(float x) { const float e = __builtin_amdgcn_exp2f(-LOG2E * x); return x * __builtin_amdgcn_rcpf(1.0f + e); }
__device__ __forceinline__ float dot4(f32x4 a) { return (a.x * a.x + a.y * a.y) + (a.z * a.z + a.w * a.w); }
__device__ __forceinline__ float sum4(f32x4 a) { return (a.x + a.y) + (a.z + a.w); }
__device__ __forceinline__ int crow(int r, int hi) { return (r & 3) + 8 * (r >> 2) + 4 * hi; }
__device__ __forceinline__ float wave_sum(float v) {
#pragma unroll
    for (int o = 1; o < 64; o <<= 1) v += __shfl_xor(v, o);
    return v;
}

__device__ __forceinline__ float dpp_prev(float v) { return __int_as_float(__builtin_amdgcn_mov_dpp(__float_as_int(v), 0x121, 0xF, 0xF, false)); }
__device__ __forceinline__ float dpp_next(float v) { return __int_as_float(__builtin_amdgcn_mov_dpp(__float_as_int(v), 0x12F, 0xF, 0xF, false)); }

__device__ __forceinline__ int lane_id_fresh() { int l; asm volatile("v_mbcnt_lo_u32_b32 %0, -1, 0\n\tv_mbcnt_hi_u32_b32 %0, -1, %0" : "=v"(l)); return l; }
__device__ __forceinline__ int fresh_tid(int wv) { return wv * 64 + lane_id_fresh(); }

namespace pg8 {
constexpr int BM = 256, BK = 64, HALF = 128, HTB = HALF * BK * 2, STAGE_BYTES = 8 * HTB, NXCD = 8, WGM = 8;
__host__ __device__ __forceinline__ int lds_byte(int r, int c) { const int st = (r >> 4) * 2 + (c >> 5), rr = r & 15, cc = c & 31, ob = rr * 64 + cc * 2; return st * 1024 + (ob ^ (((ob >> 9) & 1) << 5)); }
__host__ __device__ __forceinline__ void stage_rc(int b, int& R, int& C) { const int st = b / 1024, sb = b % 1024, swz = sb ^ (((sb >> 9) & 1) << 5); R = (st >> 1) * 16 + swz / 64; C = (st & 1) * 32 + (swz % 64) / 2; }
__host__ __device__ __forceinline__ int perm32(int rho) { const int n = rho >> 4, i = rho & 15; return 8 * (i >> 2) + 4 * n + (i & 3); }
struct Unit { int pm, pn; };
struct Gemm { const bf16_t* A; const bf16_t* Bt; int M, N, K; };
struct StaticOrder {
    int nM, nN, nwg, G, c;
    __host__ __device__ void init(int M, int N, int G_, int c_) { nM = M / BM; nN = N / BM; nwg = nM * nN; G = G_; c = c_; }
    __host__ __device__ bool next(int i, Unit& u) const {
        const long L = (long)i * G + c; if (L >= nwg) return false;
        int wgid = (int)L; { const int q = nwg / NXCD, r = nwg % NXCD, xcd = wgid % NXCD, off = wgid / NXCD; wgid = (xcd < r ? xcd * (q + 1) : r * (q + 1) + (xcd - r) * q) + off; }
        const int nig = WGM * nN, gid = wgid / nig, fm = gid * WGM, gsz = (nM - fm) < WGM ? (nM - fm) : WGM;
        u.pm = fm + ((wgid % nig) % gsz); u.pn = (wgid % nig) / gsz; return true;
    }
};

template <class Epi, class Sched>
__device__ __forceinline__ void gemm_phase(LAS unsigned char* lds, const Gemm g, const Sched& S, const Epi& E, int wv) {
    const int tid = fresh_tid(wv);
    const int wid = __builtin_amdgcn_readfirstlane(tid >> 6), lane = tid & 63, wr = wid >> 2, wc = wid & 3, fr = lane & 15, fq = lane >> 4;
    const int K = g.K, nt = K / BK;
    unsigned voffA[2], voffB[2];
#pragma unroll
    for (int i = 0; i < 2; ++i) { int R, C; stage_rc(tid * 16 + i * 8192, R, C); const int Rb = (R & ~31) + perm32(R & 31);
        voffA[i] = (unsigned)(R * K + C) * 2u; voffB[i] = (unsigned)(Rb * K + C) * 2u; }
    const size_t kstep = (size_t)(BK * 2);
    const size_t hstep = (size_t)HALF * K * 2;
    const size_t tstep = 2 * hstep;
    const unsigned ldsw = (unsigned)wid * 1024u;
    const int aoff = lds_byte(wr * 64 + fr, fq * 8), boff = lds_byte(wc * 32 + fr, fq * 8);
#define PG8_SA(b, h) (((b) * 2 + (h)) * HTB)
#define PG8_SB(b, h) ((4 + (b) * 2 + (h)) * HTB)
#define PG8_STAGE(bufoff, gbase, voff) do { _Pragma("unroll") for (int _i = 0; _i < 2; ++_i) \
        __builtin_amdgcn_global_load_lds((const unsigned*)((const char*)(gbase) + (voff)[_i]), (LAS unsigned*)(lds + (bufoff) + ldsw + _i * 8192), 16, 0, 0); } while (0)
#define PG8_LDA(dst, b, h) do { _Pragma("unroll") for (int m = 0; m < 4; ++m) _Pragma("unroll") for (int k = 0; k < 2; ++k) dst[m][k] = *(const LAS bf16x8*)(lds + PG8_SA(b, h) + aoff + m * 2048 + k * 1024); } while (0)
#define PG8_LDB(dst, b, h) do { _Pragma("unroll") for (int n = 0; n < 2; ++n) _Pragma("unroll") for (int k = 0; k < 2; ++k) dst[n][k] = *(const LAS bf16x8*)(lds + PG8_SB(b, h) + boff + n * 2048 + k * 1024); } while (0)
#define PG8_MMA(ai, bj, At, Bt) do { __builtin_amdgcn_s_setprio(1); _Pragma("unroll") for (int m = 0; m < 4; ++m) _Pragma("unroll") for (int n = 0; n < 2; ++n) _Pragma("unroll") for (int k = 0; k < 2; ++k) \
        acc[ai][bj][m][n] = __builtin_amdgcn_mfma_f32_16x16x32_bf16(Bt[n][k], At[m][k], acc[ai][bj][m][n], 0, 0, 0); __builtin_amdgcn_s_setprio(0); } while (0)
#define PG8_WAIT_V(n) asm volatile("s_waitcnt vmcnt(" #n ")" ::: "memory")
#define PG8_WAIT_L(n) asm volatile("s_waitcnt lgkmcnt(" #n ")" ::: "memory")
#define PG8_BAR __builtin_amdgcn_s_barrier()
#define PG8_SCHED __builtin_amdgcn_sched_barrier(0)
    Unit cur, nxt; int ui = 0;
    if (!S.next(0, cur)) return;
    f32x4 acc[2][2][4][2];
#pragma unroll
    for (int a = 0; a < 2; ++a)
#pragma unroll
        for (int b = 0; b < 2; ++b)
#pragma unroll
            for (int m = 0; m < 4; ++m)
#pragma unroll
                for (int n = 0; n < 2; ++n) acc[a][b][m][n] = (f32x4){0.f, 0.f, 0.f, 0.f};
    bf16x8 At[4][2], B0[2][2], B1[2][2];
    const char* cA = (const char*)g.A + (size_t)cur.pm * tstep; const char* cB = (const char*)g.Bt + (size_t)cur.pn * tstep;
    PG8_STAGE(PG8_SB(0, 0), cB, voffB); PG8_STAGE(PG8_SB(0, 1), cB + hstep, voffB); PG8_STAGE(PG8_SA(0, 0), cA, voffA); PG8_STAGE(PG8_SA(0, 1), cA + hstep, voffA);
    if (wr == 1) PG8_BAR;
    PG8_WAIT_V(2); PG8_BAR;
    PG8_STAGE(PG8_SB(1, 0), cB + kstep, voffB); PG8_STAGE(PG8_SA(1, 0), cA + kstep, voffA); PG8_STAGE(PG8_SB(1, 1), cB + hstep + kstep, voffB);
    PG8_WAIT_V(6); PG8_BAR;
    for (;;) {
        const bool has_next = S.next(ui + 1, nxt);
        const char* nA = has_next ? (const char*)g.A + (size_t)nxt.pm * tstep : cA; const char* nB = has_next ? (const char*)g.Bt + (size_t)nxt.pn * tstep : cB;
        for (int t = 0; t < nt; t += 2) {
            const bool last = (t == nt - 2);
            const char* a1 = cA + (size_t)(t + 1) * kstep;
            const char* a2 = last ? nA : cA + (size_t)(t + 2) * kstep; const char* b2 = last ? nB : cB + (size_t)(t + 2) * kstep;
            const char* a3 = a2 + kstep; const char* b3 = b2 + kstep;
            PG8_LDB(B0, 0, 0); PG8_LDB(B1, 0, 1); PG8_SCHED; PG8_LDA(At, 0, 0); PG8_STAGE(PG8_SA(1, 1), a1 + hstep, voffA);
            PG8_WAIT_V(8); PG8_WAIT_L(0); PG8_BAR; PG8_MMA(0, 0, At, B0); PG8_MMA(0, 1, At, B1); PG8_BAR; PG8_SCHED;
            PG8_LDA(At, 0, 1); PG8_STAGE(PG8_SB(0, 0), b2, voffB); PG8_STAGE(PG8_SB(0, 1), b2 + hstep, voffB); PG8_STAGE(PG8_SA(0, 0), a2, voffA);
            PG8_WAIT_V(8); PG8_WAIT_L(0); PG8_BAR; PG8_MMA(1, 0, At, B0); PG8_MMA(1, 1, At, B1); PG8_BAR; PG8_SCHED;
            PG8_LDB(B0, 1, 0); PG8_LDB(B1, 1, 1); PG8_SCHED; PG8_LDA(At, 1, 0); PG8_STAGE(PG8_SA(0, 1), a2 + hstep, voffA);
            PG8_WAIT_V(8); PG8_WAIT_L(0); PG8_BAR; PG8_MMA(0, 0, At, B0); PG8_MMA(0, 1, At, B1); PG8_BAR; PG8_SCHED;
            PG8_LDA(At, 1, 1); PG8_STAGE(PG8_SB(1, 0), b3, voffB); PG8_STAGE(PG8_SB(1, 1), b3 + hstep, voffB); PG8_STAGE(PG8_SA(1, 0), a3, voffA);
            PG8_WAIT_V(8); PG8_WAIT_L(0); PG8_BAR; PG8_MMA(1, 0, At, B0); PG8_MMA(1, 1, At, B1); PG8_BAR; PG8_SCHED;
        }
        if (wr == 0) PG8_BAR;
        E(acc, cur, wr, wc, fr, fq);
        if (!has_next) break;
#pragma unroll
        for (int a = 0; a < 2; ++a)
#pragma unroll
            for (int b = 0; b < 2; ++b)
#pragma unroll
                for (int m = 0; m < 4; ++m)
#pragma unroll
                    for (int n = 0; n < 2; ++n) acc[a][b][m][n] = (f32x4){0.f, 0.f, 0.f, 0.f};
        cur = nxt; cA = nA; cB = nB; ++ui;
        if (wr == 1) PG8_BAR;
    }
    PG8_WAIT_V(0);
    PG8_BAR;
#undef PG8_SA
#undef PG8_SB
#undef PG8_STAGE
#undef PG8_LDA
#undef PG8_LDB
#undef PG8_MMA
#undef PG8_WAIT_V
#undef PG8_WAIT_L
#undef PG8_BAR
#undef PG8_SCHED
}
}
using pg8::Unit;

__device__ __forceinline__ void row_rstd(const float* xss, int row0, int fq, float (&r)[2][4]) {
    f32x4 a[8], b[8];
#pragma unroll
    for (int i = 0; i < 8; ++i) { const f32x4* p = (const f32x4*)(xss + (size_t)(row0 + 128 * (i >> 2) + 16 * (i & 3)) * 32 + 8 * fq); a[i] = p[0]; b[i] = p[1]; }
#pragma unroll
    for (int i = 0; i < 8; ++i) {
        float s = sum4(a[i]) + sum4(b[i]);
        s += __shfl_xor(s, 16); s += __shfl_xor(s, 32);
        r[i >> 2][i & 3] = rsqrtf(s * (1.0f / DM) + EPS);
    }
    asm volatile("" ::: "memory");
}

struct EpiIn {
    const float* xss; const float* qg; const float* kg; const float* cosT; const float* sinT;
    bf16_t *Q, *K, *V, *GU, *GV; float *qss, *kss, *gvs;
    __device__ __forceinline__ void operator()(const f32x4 (&acc)[2][2][4][2], const Unit& u, int wr, int wc, int fr, int fq) const {
        asm volatile("" : "+v"(fr), "+v"(fq));
        const int row0 = u.pm * 256 + wr * 64 + fr;
        float rr[2][4]; row_rstd(xss, row0, fq, rr);
        const int pn = u.pn;
        if (pn < 5) {
            const bool isq = pn < 4;
            const float* gn = isq ? qg : kg;
            const int gg = 4 * wc + fq;
            const f32x4 glo = *(const f32x4*)(gn + 4 * gg), ghi = *(const f32x4*)(gn + 64 + 4 * gg);
#pragma unroll
            for (int ai = 0; ai < 2; ++ai) {
                f32x4 cs[4], sn[4];
#pragma unroll
                for (int i = 0; i < 4; ++i) { const int pos = (row0 + 128 * ai + 16 * i) & (SEQ - 1); cs[i] = *(const f32x4*)(cosT + pos * 64 + 4 * gg); sn[i] = *(const f32x4*)(sinT + pos * 64 + 4 * gg); }
#pragma unroll
                for (int m = 0; m < 4; ++m) {
                    const int row = row0 + 128 * ai + 16 * m;
                    const f32x4 c = cs[m], s = sn[m];
                    const float r = rr[ai][m];
#pragma unroll
                    for (int bj = 0; bj < 2; ++bj) {
                        const f32x4 v0 = acc[ai][bj][m][0] * r, v1 = acc[ai][bj][m][1] * r;
                        float ss = dot4(v0) + dot4(v1);
                        ss += __shfl_xor(ss, 16); ss += __shfl_xor(ss, 32);
                        const int head = isq ? 2 * pn + bj : bj;
                        if (fq == 0) { if (isq) qss[((size_t)row * 8 + head) * 4 + wc] = ss; else kss[((size_t)row * 2 + head) * 4 + wc] = ss; }
                        const f32x4 y0 = v0 * glo, y1 = v1 * ghi;
                        const f32x4 lo = y0 * c - y1 * s, hi = y1 * c + y0 * s;
                        bf16_t* dst = (isq ? Q + (size_t)row * 1024 : K + (size_t)row * 256) + head * 128;
                        u32x2 wl, wh; wl.x = cvt_pk_bf16(lo.x, lo.y); wl.y = cvt_pk_bf16(lo.z, lo.w); wh.x = cvt_pk_bf16(hi.x, hi.y); wh.y = cvt_pk_bf16(hi.z, hi.w);
                        *(u32x2*)(dst + 4 * gg) = wl; *(u32x2*)(dst + 64 + 4 * gg) = wh;
                    }
                }
                asm volatile("" ::: "memory");
            }
        } else if (pn == 5) {
#pragma unroll
            for (int ai = 0; ai < 2; ++ai)
#pragma unroll
                for (int m = 0; m < 4; ++m) {
                    const int row = row0 + 128 * ai + 16 * m; const float r = rr[ai][m];
#pragma unroll
                    for (int bj = 0; bj < 2; ++bj) {
                        const f32x4 v0 = acc[ai][bj][m][0] * r, v1 = acc[ai][bj][m][1] * r;
                        u32x4 w; w.x = cvt_pk_bf16(v0.x, v0.y); w.y = cvt_pk_bf16(v0.z, v0.w); w.z = cvt_pk_bf16(v1.x, v1.y); w.w = cvt_pk_bf16(v1.z, v1.w);
                        *(u32x4*)(V + (size_t)row * 256 + bj * 128 + 32 * wc + 8 * fq) = w;
                    }
                }
        } else {
            const bool isgv = pn >= 10;
            const int ct = isgv ? pn - 10 : pn - 6;
            bf16_t* dstb = (isgv ? GV : GU) + ct * 256 + 32 * wc + 8 * fq;
#pragma unroll
            for (int ai = 0; ai < 2; ++ai)
#pragma unroll
                for (int m = 0; m < 4; ++m) {
                    const int row = row0 + 128 * ai + 16 * m; const float r = rr[ai][m];
                    float s1 = 0.f, s2 = 0.f;
#pragma unroll
                    for (int bj = 0; bj < 2; ++bj) {
                        f32x4 v0 = acc[ai][bj][m][0] * r, v1 = acc[ai][bj][m][1] * r;
                        v0.x = gelu_tanh(v0.x); v0.y = gelu_tanh(v0.y); v0.z = gelu_tanh(v0.z); v0.w = gelu_tanh(v0.w);
                        v1.x = gelu_tanh(v1.x); v1.y = gelu_tanh(v1.y); v1.z = gelu_tanh(v1.z); v1.w = gelu_tanh(v1.w);
                        s1 += sum4(v0) + sum4(v1); s2 += dot4(v0) + dot4(v1);
                        u32x4 w; w.x = cvt_pk_bf16(v0.x, v0.y); w.y = cvt_pk_bf16(v0.z, v0.w); w.z = cvt_pk_bf16(v1.x, v1.y); w.w = cvt_pk_bf16(v1.z, v1.w);
                        *(u32x4*)(dstb + (size_t)row * 1024 + bj * 128) = w;
                    }
                    if (isgv) {
                        s1 += __shfl_xor(s1, 16); s1 += __shfl_xor(s1, 32);
                        s2 += __shfl_xor(s2, 16); s2 += __shfl_xor(s2, 32);
                        if (fq == 0) *(f32x2*)(gvs + ((size_t)row * 16 + ct * 4 + wc) * 2) = (f32x2){s1, s2};
                    }
                    asm volatile("" ::: "memory");
                }
        }
    }
};

struct EpiRes {
    const float* base; float* out; bf16_t* xb; float* xss;
    __device__ __forceinline__ void operator()(const f32x4 (&acc)[2][2][4][2], const Unit& u, int wr, int wc, int fr, int fq) const {
        asm volatile("" : "+v"(fr), "+v"(fq));
        const int row0 = u.pm * 256 + wr * 64 + fr, col0 = u.pn * 256 + 32 * wc + 8 * fq;
#pragma unroll
        for (int ai = 0; ai < 2; ++ai)
#pragma unroll
            for (int m = 0; m < 4; ++m) {
                const int row = row0 + 128 * ai + 16 * m; float ss = 0.f;
#pragma unroll
                for (int bj = 0; bj < 2; ++bj) {
                    const size_t off = (size_t)row * DM + col0 + bj * 128;
                    const f32x4 b0 = *(const f32x4*)(base + off), b1 = *(const f32x4*)(base + off + 4);
                    const f32x4 o0 = b0 + acc[ai][bj][m][0], o1 = b1 + acc[ai][bj][m][1];
                    *(f32x4*)(out + off) = o0; *(f32x4*)(out + off + 4) = o1;
                    u32x4 w; w.x = cvt_pk_bf16(o0.x, o0.y); w.y = cvt_pk_bf16(o0.z, o0.w); w.z = cvt_pk_bf16(o1.x, o1.y); w.w = cvt_pk_bf16(o1.z, o1.w);
                    *(u32x4*)(xb + off) = w;
                    ss += dot4(o0) + dot4(o1);
                }
                ss += __shfl_xor(ss, 16); ss += __shfl_xor(ss, 32);
                if (fq == 0) xss[(size_t)row * 32 + u.pn * 4 + wc] = ss;
                if (m == 3) asm volatile("" ::: "memory");
            }
    }
};

struct EpiUp {
    const float* xss; const float* cw; const float* cb; bf16_t* ACT; bf16_t* HALO;
    __device__ __forceinline__ void operator()(f32x4 (&acc)[2][2][4][2], const Unit& u, int wr, int wc, int fr, int fq) const {
        asm volatile("" : "+v"(fr), "+v"(fq));
        const int row0 = u.pm * 256 + wr * 64 + fr;
        float rr[2][4]; row_rstd(xss, row0, fq, rr);
        const int jg = u.pn * 128 + 32 * wc + 8 * fq;
#pragma unroll
        for (int ai = 0; ai < 2; ++ai)
#pragma unroll
            for (int m = 0; m < 4; ++m) {
                const float r = rr[ai][m];
#pragma unroll
                for (int bj = 0; bj < 2; ++bj) { acc[ai][bj][m][0] *= r; acc[ai][bj][m][1] *= r; }
                if (m == 0 || m == 3) {
                    const bool hal = (m == 0) ? (fr < 2) : (fr >= 14);
                    if (hal) {
                        const int row = row0 + 128 * ai + 16 * m;
                        const int hr = (row >> 6) * 4 + (m == 0 ? fr : fr - 12);
#pragma unroll
                        for (int bj = 0; bj < 2; ++bj) {
                            const f32x4 v0 = acc[ai][bj][m][0], v1 = acc[ai][bj][m][1];
                            u32x4 w; w.x = cvt_pk_bf16(v0.x, v0.y); w.y = cvt_pk_bf16(v0.z, v0.w); w.z = cvt_pk_bf16(v1.x, v1.y); w.w = cvt_pk_bf16(v1.z, v1.w);
                            *(u32x4*)(HALO + (size_t)hr * NUP + (bj ? DFF : 0) + jg) = w;
                        }
                    }
                }
            }
        __builtin_amdgcn_sched_barrier(0);
#pragma unroll
        for (int n = 0; n < 2; ++n) {
            f32x4 wv[2][2][4];
#pragma unroll
            for (int bj = 0; bj < 2; ++bj) {
                const int col = (bj ? DFF : 0) + jg + 4 * n;
                const float ksc = bj ? -0.6931471805599453f : -LOG2E;
                wv[n][bj][0] = *(const f32x4*)(cw + col) * ksc; wv[n][bj][1] = *(const f32x4*)(cw + NUP + col) * ksc; wv[n][bj][2] = *(const f32x4*)(cw + 2 * NUP + col) * ksc; wv[n][bj][3] = *(const f32x4*)(cb + col) * ksc;
            }
#pragma unroll
            for (int e = 0; e < 4; ++e) {
#pragma unroll
                for (int ai = 0; ai < 2; ++ai) {
                    float a[2][4];
#pragma unroll
                    for (int bj = 0; bj < 2; ++bj) {
                        float raw[4], P[4], N[4];
#pragma unroll
                        for (int m = 0; m < 4; ++m) raw[m] = acc[ai][bj][m][n][e];
                        asm volatile("" : "+v"(raw[0]), "+v"(raw[1]), "+v"(raw[2]), "+v"(raw[3]));
#pragma unroll
                        for (int m = 0; m < 4; ++m) { P[m] = dpp_prev(raw[m]); N[m] = dpp_next(raw[m]); }
#pragma unroll
                        for (int m = 0; m < 4; ++m) {
                            const float prev = fr > 0 ? P[m] : (m > 0 ? P[m > 0 ? m - 1 : 0] : 0.f);
                            const float next = fr < 15 ? N[m] : (m < 3 ? N[m < 3 ? m + 1 : 3] : 0.f);
                            a[bj][m] = __builtin_fmaf(wv[n][bj][0][e], prev, __builtin_fmaf(wv[n][bj][1][e], raw[m], __builtin_fmaf(wv[n][bj][2][e], next, wv[n][bj][3][e])));
                        }
                        asm volatile("" : "+v"(a[bj][0]), "+v"(a[bj][1]), "+v"(a[bj][2]), "+v"(a[bj][3]));
                    }
#pragma unroll
                    for (int m = 0; m < 4; ++m) acc[ai][0][m][n][e] = (a[0][m] * a[1][m]) * __builtin_amdgcn_rcpf(1.0f + __builtin_amdgcn_exp2f(a[0][m]));
                }
            }
        }
#pragma unroll
        for (int ai = 0; ai < 2; ++ai)
#pragma unroll
            for (int m = 0; m < 4; ++m) {
                const int row = row0 + 128 * ai + 16 * m;
                const bool edge = (m == 0 && fr == 0) || (m == 3 && fr == 15);
                if (!edge) {
                    const f32x4 v0 = acc[ai][0][m][0], v1 = acc[ai][0][m][1];
                    u32x4 w; w.x = cvt_pk_bf16(v0.x, v0.y); w.y = cvt_pk_bf16(v0.z, v0.w); w.z = cvt_pk_bf16(v1.x, v1.y); w.w = cvt_pk_bf16(v1.z, v1.w);
                    *(u32x4*)(ACT + (size_t)row * DFF + jg) = w;
                }
            }
    }
};

struct Args { const float* in[18]; float* out; unsigned char* ws; };

__device__ __forceinline__ int cmap_in(int n) {
    if (n >= 1280) return n;
    const int head = n >> 7, c = n & 127, g = c >> 3, j = c & 7;
    return head * 128 + ((j < 4) ? 4 * g + j : 64 + 4 * g + (j - 4));
}
__device__ __forceinline__ int cmap_up(int n) { const int pn = n >> 8, c = n & 255; return (c < 128) ? 128 * pn + c : DFF + 128 * pn + (c - 128); }

template <int MODE>
__device__ __forceinline__ void transpose_item(const float* W, int K, int N, bf16_t* WT, const float* gk, LAS float* scr, int item, int lane) {
    const int nblk = N / 64, kb = item / nblk, nb = item % nblk, k0 = 64 * kb, n0 = 64 * nb;
    const int c4 = lane & 15, r4 = lane >> 4;
    const int nn = n0 + 4 * c4;
    const int sc = MODE == 1 ? cmap_in(nn) : (MODE == 2 ? cmap_up(nn) : nn);
    f32x4 v[16];
    const float* src = W + (size_t)(k0 + r4) * N + sc;
#pragma unroll
    for (int i = 0; i < 16; ++i) v[i] = *(const f32x4*)(src + (size_t)(4 * i) * N);
    if (gk) {
#pragma unroll
        for (int i = 0; i < 16; ++i) v[i] *= gk[k0 + 4 * i + r4];
    }
#pragma unroll
    for (int i = 0; i < 16; ++i) { LAS float* d = scr + (4 * i + r4) * 65 + 4 * c4; d[0] = v[i].x; d[1] = v[i].y; d[2] = v[i].z; d[3] = v[i].w; }
    asm volatile("s_waitcnt lgkmcnt(0)" ::: "memory");
    const int c = lane & 7;
#pragma unroll
    for (int j = 0; j < 8; ++j) { const int n = (lane >> 3) + 8 * j; const LAS float* p = scr + (8 * c) * 65 + n;
        u32x4 o; o.x = cvt_pk_bf16(p[0 * 65], p[1 * 65]); o.y = cvt_pk_bf16(p[2 * 65], p[3 * 65]); o.z = cvt_pk_bf16(p[4 * 65], p[5 * 65]); o.w = cvt_pk_bf16(p[6 * 65], p[7 * 65]);
        *(u32x4*)(WT + (size_t)(n0 + n) * K + k0 + 8 * c) = o; }
    asm volatile("s_waitcnt lgkmcnt(0)" ::: "memory");
}

__device__ __forceinline__ void prologue(const Args& a, LAS unsigned char* lds, int G, int wv) {
    const int tid = fresh_tid(wv);
    const int lane = tid & 63, wave = tid >> 6;
    LAS float* scr = (LAS float*)(lds + wave * 16640);
    const int gw = blockIdx.x * 8 + wave, NGW = G * 8;
    unsigned char* ws = a.ws;
    constexpr int I_IN = (DM / 64) * (NIN / 64), I_O = (DM / 64) * (DM / 64), I_UP = (DM / 64) * (NUP / 64), I_DN = (DFF / 64) * (DM / 64);
    constexpr int I_L = I_IN + I_O + I_UP + I_DN;
    for (int it = gw; it < DEPTH * I_L; it += NGW) {
        const int l = it / I_L; int r = it % I_L;
        if (r < I_IN) { transpose_item<1>(a.in[2] + (size_t)l * DM * NIN, DM, NIN, (bf16_t*)(ws + OFF_WIN + l * SZ_WIN), a.in[1] + l * DM, scr, r, lane); continue; } r -= I_IN;
        if (r < I_O) {
            const int kb = r / (DM / 64); const float* gk = (kb < 16) ? (a.in[10] + l * 1024) : (a.in[11] + l * 1024 - 1024);
            transpose_item<0>(a.in[12] + (size_t)l * DM * DM, DM, DM, (bf16_t*)(ws + OFF_WO + l * SZ_WO), gk, scr, r, lane); continue; } r -= I_O;
        if (r < I_UP) { transpose_item<2>(a.in[14] + (size_t)l * DM * NUP, DM, NUP, (bf16_t*)(ws + OFF_WUP + l * SZ_WUP), a.in[13] + l * DM, scr, r, lane); continue; } r -= I_UP;
        transpose_item<0>(a.in[17] + (size_t)l * DFF * DM, DFF, DM, (bf16_t*)(ws + OFF_WDN + l * SZ_WDN), nullptr, scr, r, lane);
    }
    {
        const float* x = a.in[0]; bf16_t* xb = (bf16_t*)(ws + OFF_XB); float* xss = (float*)(ws + OFF_XSS);
        for (int m = gw; m < T; m += 2 * NGW) {
            const int m2 = m + NGW;
            const bool has2 = m2 < T;
            const f32x4* xr = (const f32x4*)(x + (size_t)m * DM) + lane; const f32x4* xr2 = (const f32x4*)(x + (size_t)(has2 ? m2 : m) * DM) + lane;
            f32x4 va[8], vb[8];
#pragma unroll
            for (int j = 0; j < 8; ++j) { va[j] = xr[64 * j]; vb[j] = xr2[64 * j]; }
            float s = 0.f, s2 = 0.f;
            u32x2* o8 = (u32x2*)(xb + (size_t)m * DM) + lane; u32x2* o82 = (u32x2*)(xb + (size_t)(has2 ? m2 : m) * DM) + lane;
#pragma unroll
            for (int j = 0; j < 8; ++j) { s += dot4(va[j]); s2 += dot4(vb[j]);
                u32x2 w; w.x = cvt_pk_bf16(va[j].x, va[j].y); w.y = cvt_pk_bf16(va[j].z, va[j].w); o8[64 * j] = w;
                u32x2 w2; w2.x = cvt_pk_bf16(vb[j].x, vb[j].y); w2.y = cvt_pk_bf16(vb[j].z, vb[j].w); if (has2) o82[64 * j] = w2; }
            s = wave_sum(s); s2 = wave_sum(s2);
            if (lane < 32) { xss[(size_t)m * 32 + lane] = (lane == 0) ? s : 0.f; if (has2) xss[(size_t)m2 * 32 + lane] = (lane == 0) ? s2 : 0.f; }
        }
    }
    {
        float* cosT = (float*)(ws + OFF_COS); float* sinT = (float*)(ws + OFF_SIN);
        for (int i = blockIdx.x * 512 + tid; i < SEQ * 64; i += G * 512) {
            const int pos = i >> 6, k = i & 63;
            const float inv = (float)exp2(-(double)k * (13.287712379549449 / 64.0));
            const float ang = (float)pos * inv;
            double rev = (double)ang * 0.15915494309189535; rev -= rint(rev);
            const float fr = (float)rev;
            cosT[i] = __builtin_amdgcn_cosf(fr); sinT[i] = __builtin_amdgcn_sinf(fr);
        }
    }
    {
        const float* wsrc = a.in[8]; bf16_t* wd = (bf16_t*)(ws + OFF_WS);
        for (int i = blockIdx.x * 512 + tid; i < DEPTH * 8 * 128 * 128 / 4; i += G * 512) {
            const f32x4 v = *((const f32x4*)wsrc + i); u32x2 w; w.x = cvt_pk_bf16(v.x, v.y); w.y = cvt_pk_bf16(v.z, v.w); *((u32x2*)wd + i) = w;
        }
    }
}

__device__ __forceinline__ s16x4 vtr(const LAS unsigned char* p) { typedef short v4i16_t __attribute__((ext_vector_type(4))); return __builtin_bit_cast(s16x4, __builtin_amdgcn_ds_read_tr16_b64_v4i16((LAS v4i16_t*)p)); }
#define MFMA32(a, b, c) __builtin_amdgcn_mfma_f32_32x32x16_bf16((a), (b), (c), 0, 0, 0)

constexpr int AT_KROW = 272, AT_VROW = 288, AT_KSZ = 32 * AT_KROW, AT_VSZ = 32 * AT_VROW, AT_BUF = 2 * AT_KSZ + 2 * AT_VSZ;
constexpr int AT_RED = 2 * AT_BUF;

__device__ __forceinline__ void attn_unit(LAS unsigned char* lds, int unit, const float* sinkl, const bf16_t* Q, const bf16_t* K, const bf16_t* V, const float* qss, const float* kss, bf16_t* MIX, int wv) {
    const int tid = fresh_tid(wv);
    const int lane = tid & 63, wid = __builtin_amdgcn_readfirstlane(tid >> 6), qi = lane & 31, hh = lane >> 5;
    const int b = unit >> 6, qb = unit & 63, q0 = qb * 32;
    const size_t rowbase = (size_t)b * SEQ;
    const int hq = wid, kvh = wid >> 2;
    const size_t qrow = rowbase + q0 + qi;
    bf16x8 qf[8];
    { const bf16_t* qp = Q + qrow * 1024 + hq * 128 + 8 * hh;
#pragma unroll
      for (int s = 0; s < 8; ++s) qf[s] = *(const bf16x8*)(qp + 16 * s); }
    const f32x4 qs = *(const f32x4*)(qss + (qrow * 8 + hq) * 4);
    const float rq = rsqrtf(sum4(qs) * (1.0f / 128.0f) + EPS);
    const float sc = rq * 0.08838834764831845f * LOG2E;
    const float sk = sinkl[hq] * LOG2E;
    float m_run = sk, l_run = (hh == 0) ? 1.f : 0.f;
    f32x16 o[4];
#pragma unroll
    for (int c = 0; c < 4; ++c)
#pragma unroll
        for (int i = 0; i < 16; ++i) o[c][i] = 0.f;
    int kb_lo = 0, kb_hi = 8;
    if (qb < 4) kb_lo = 4 - qb;
    if (qb > 59) kb_hi = 67 - qb;
    const int skey = tid >> 4, spart = tid & 15;
    u32x4 pk0, pk1, pv0, pv1; f32x4 ks0, ks1;
#define AT_LOAD(kb) do { const size_t r_ = rowbase + (size_t)(q0 - 128 + 32 * (kb) + skey); \
        pk0 = *(const u32x4*)(K + r_ * 256 + 8 * spart); pk1 = *(const u32x4*)(K + r_ * 256 + 128 + 8 * spart); \
        pv0 = *(const u32x4*)(V + r_ * 256 + 8 * spart); pv1 = *(const u32x4*)(V + r_ * 256 + 128 + 8 * spart); \
        ks0 = *(const f32x4*)(kss + r_ * 8); ks1 = *(const f32x4*)(kss + r_ * 8 + 4); } while (0)
#define AT_SCALE(p, r) do { u32x4 t_; \
        t_.x = cvt_pk_bf16(bf_lo(p.x) * r, bf_hi(p.x) * r); t_.y = cvt_pk_bf16(bf_lo(p.y) * r, bf_hi(p.y) * r); \
        t_.z = cvt_pk_bf16(bf_lo(p.z) * r, bf_hi(p.z) * r); t_.w = cvt_pk_bf16(bf_lo(p.w) * r, bf_hi(p.w) * r); p = t_; } while (0)
#define AT_WRITE(buf) do { const float r0_ = rsqrtf(sum4(ks0) * (1.0f / 128.0f) + EPS), r1_ = rsqrtf(sum4(ks1) * (1.0f / 128.0f) + EPS); \
        AT_SCALE(pk0, r0_); AT_SCALE(pk1, r1_); \
        LAS unsigned char* b_ = lds + (buf) * AT_BUF; \
        *(LAS u32x4*)(b_ + skey * AT_KROW + spart * 16) = pk0; *(LAS u32x4*)(b_ + AT_KSZ + skey * AT_KROW + spart * 16) = pk1; \
        *(LAS u32x4*)(b_ + 2 * AT_KSZ + skey * AT_VROW + spart * 16) = pv0; *(LAS u32x4*)(b_ + 2 * AT_KSZ + AT_VSZ + skey * AT_VROW + spart * 16) = pv1; } while (0)
    AT_LOAD(kb_lo); AT_WRITE(0);
    __syncthreads();
    int cur = 0;
    const int trq = (lane & 15) >> 2, trp = lane & 3, blk = (lane >> 4) & 1;
    for (int kb = kb_lo; kb <= kb_hi; ++kb) {
        if (kb < kb_hi) AT_LOAD(kb + 1);
        const LAS unsigned char* Kb = lds + cur * AT_BUF + kvh * AT_KSZ;
        const LAS unsigned char* Vb = lds + cur * AT_BUF + 2 * AT_KSZ + kvh * AT_VSZ;
        f32x16 st;
#pragma unroll
        for (int i = 0; i < 16; ++i) st[i] = 0.f;
#pragma unroll
        for (int s = 0; s < 8; ++s) { const bf16x8 kf = *(const LAS bf16x8*)(Kb + qi * AT_KROW + (16 * s + 8 * hh) * 2); st = MFMA32(kf, qf[s], st); }
        float tt[16];
#pragma unroll
        for (int i = 0; i < 16; ++i) tt[i] = st[i] * sc;
        if (kb == 0) {
#pragma unroll
            for (int i = 0; i < 16; ++i) if (crow(i, hh) < qi) tt[i] = -INFINITY;
        }
        if (kb == 8) {
#pragma unroll
            for (int i = 0; i < 16; ++i) if (crow(i, hh) > qi) tt[i] = -INFINITY;
        }
        float mx = tt[0];
#pragma unroll
        for (int i = 1; i < 16; ++i) mx = fmaxf(mx, tt[i]);
        mx = fmaxf(mx, __shfl_xor(mx, 32));
        const float m_new = fmaxf(m_run, mx);
        const float alpha = __builtin_amdgcn_exp2f(m_run - m_new);
        float ps = 0.f;
#pragma unroll
        for (int i = 0; i < 16; ++i) { tt[i] = __builtin_amdgcn_exp2f(tt[i] - m_new); ps += tt[i]; }
        l_run = l_run * alpha + ps; m_run = m_new;
#pragma unroll
        for (int c = 0; c < 4; ++c)
#pragma unroll
            for (int i = 0; i < 16; ++i) o[c][i] *= alpha;
#pragma unroll
        for (int s2 = 0; s2 < 2; ++s2) {
            u32x4 pw; pw.x = cvt_pk_bf16(tt[8 * s2 + 0], tt[8 * s2 + 1]); pw.y = cvt_pk_bf16(tt[8 * s2 + 2], tt[8 * s2 + 3]); pw.z = cvt_pk_bf16(tt[8 * s2 + 4], tt[8 * s2 + 5]); pw.w = cvt_pk_bf16(tt[8 * s2 + 6], tt[8 * s2 + 7]);
            const bf16x8 pb = __builtin_bit_cast(bf16x8, pw);
#pragma unroll
            for (int c = 0; c < 4; ++c) {
                const LAS unsigned char* vp = Vb + (16 * s2 + 4 * hh + trq) * AT_VROW + (32 * c + 16 * blk) * 2 + 8 * trp;
                const s16x4 lo = vtr(vp), hi = vtr(vp + 8 * AT_VROW);
                const bf16x8 vf = {lo[0], lo[1], lo[2], lo[3], hi[0], hi[1], hi[2], hi[3]};
                o[c] = MFMA32(vf, pb, o[c]);
            }
        }
        if (kb < kb_hi) AT_WRITE(cur ^ 1);
        __syncthreads();
        cur ^= 1;
    }
#undef AT_LOAD
#undef AT_SCALE
#undef AT_WRITE
    const float lt = l_run + __shfl_xor(l_run, 32);
    const float inv = 1.0f / lt;
    float ss = 0.f;
#pragma unroll
    for (int c = 0; c < 4; ++c)
#pragma unroll
        for (int i = 0; i < 16; ++i) { o[c][i] *= inv; ss += o[c][i] * o[c][i]; }
    ss += __shfl_xor(ss, 32);
    LAS float* red = (LAS float*)(lds + AT_RED);
    if (hh == 0) red[hq * 32 + qi] = ss;
    __syncthreads();
    float tot = 0.f;
#pragma unroll
    for (int h = 0; h < 8; ++h) tot += red[h * 32 + qi];
    const float ra = rsqrtf(tot * (1.0f / 1024.0f) + EPS);
    bf16_t* op = MIX + qrow * DM + hq * 128;
#pragma unroll
    for (int c = 0; c < 4; ++c)
#pragma unroll
        for (int g = 0; g < 4; ++g) {
            u32x2 w; w.x = cvt_pk_bf16(o[c][4 * g] * ra, o[c][4 * g + 1] * ra); w.y = cvt_pk_bf16(o[c][4 * g + 2] * ra, o[c][4 * g + 3] * ra);
            *(u32x2*)(op + 32 * c + 8 * g + 4 * hh) = w;
        }
    __syncthreads();
}

constexpr int SG_ROW = 288, SG_BUF = 128 * SG_ROW, SG_STAT = 2 * SG_BUF, SG_RED = SG_STAT + 128 * 8;
__device__ __forceinline__ void sgu_unit(LAS unsigned char* lds, int unit, const bf16_t* GU, const bf16_t* GV, const float* gvs, const float* lng, const float* lnb,
                                         const bf16_t* WS, const float* bs, bf16_t* MIX, int wv) {
    const int tid = fresh_tid(wv);
    const int lane = tid & 63, wid = __builtin_amdgcn_readfirstlane(tid >> 6), pi = lane & 31, hh = lane >> 5;
    const int bc = unit >> 1, ph = unit & 1;
    const size_t rowbase = (size_t)bc * 128;
    LAS f32x2* stat = (LAS f32x2*)(lds + SG_STAT);
    if (tid < 128) {
        const f32x4* p = (const f32x4*)(gvs + (rowbase + tid) * 32);
        float s1 = 0.f, s2 = 0.f;
#pragma unroll
        for (int i = 0; i < 8; ++i) { const f32x4 v = p[i]; s1 += v.x + v.z; s2 += v.y + v.w; }
        const float mu = s1 * (1.0f / 1024.0f);
        const float var = s2 * (1.0f / 1024.0f) - mu * mu;
        stat[tid] = (f32x2){mu, rsqrtf(fmaxf(var, 0.f) + EPS)};
    }
    __syncthreads();
    const int psub = wid & 1, dsub = wid >> 1;
    const int spart = tid & 15;
    const int prow = ph * 64 + psub * 32 + pi;
    const int trq = (lane & 15) >> 2, trp = lane & 3, blk = (lane >> 4) & 1;
    f32x16 acc[8];
#pragma unroll
    for (int h = 0; h < 8; ++h) {
#pragma unroll
        for (int i = 0; i < 16; ++i) acc[h][i] = 0.f;
        LAS unsigned char* buf = lds + (h & 1) * SG_BUF;
        const f32x4 g0 = *(const f32x4*)(lng + h * 128 + 8 * spart), g1 = *(const f32x4*)(lng + h * 128 + 8 * spart + 4);
        const f32x4 b0 = *(const f32x4*)(lnb + h * 128 + 8 * spart), b1 = *(const f32x4*)(lnb + h * 128 + 8 * spart + 4);
#pragma unroll
        for (int i = 0; i < 4; ++i) {
            const int q = (tid >> 4) + 32 * i;
            const u32x4 v = *(const u32x4*)(GV + (rowbase + q) * 1024 + h * 128 + 8 * spart);
            const f32x2 st = stat[q];
            u32x4 w;
            w.x = cvt_pk_bf16((bf_lo(v.x) - st.x) * st.y * g0.x + b0.x, (bf_hi(v.x) - st.x) * st.y * g0.y + b0.y);
            w.y = cvt_pk_bf16((bf_lo(v.y) - st.x) * st.y * g0.z + b0.z, (bf_hi(v.y) - st.x) * st.y * g0.w + b0.w);
            w.z = cvt_pk_bf16((bf_lo(v.z) - st.x) * st.y * g1.x + b1.x, (bf_hi(v.z) - st.x) * st.y * g1.y + b1.y);
            w.w = cvt_pk_bf16((bf_lo(v.w) - st.x) * st.y * g1.z + b1.z, (bf_hi(v.w) - st.x) * st.y * g1.w + b1.w);
            *(LAS u32x4*)(buf + q * SG_ROW + spart * 16) = w;
        }
        __syncthreads();
        const bf16_t* wp = WS + ((size_t)h * 128 + prow) * 128 + 8 * hh;
#pragma unroll
        for (int s = 0; s < 8; ++s) {
            const bf16x8 wf = *(const bf16x8*)(wp + 16 * s);
            const LAS unsigned char* vp = buf + (16 * s + 8 * hh + trq) * SG_ROW + (32 * dsub + 16 * blk) * 2 + 8 * trp;
            const s16x4 lo = vtr(vp), hi = vtr(vp + 4 * SG_ROW);
            const bf16x8 vf = {lo[0], lo[1], lo[2], lo[3], hi[0], hi[1], hi[2], hi[3]};
            acc[h] = MFMA32(vf, wf, acc[h]);
        }
    }
    const size_t orow = rowbase + prow;
    float ss = 0.f;
#pragma unroll
    for (int h = 0; h < 8; ++h) {
        const float bb = bs[h * 128 + prow];
#pragma unroll
        for (int g = 0; g < 4; ++g) {
            const u32x2 gu = *(const u32x2*)(GU + orow * 1024 + h * 128 + 32 * dsub + 8 * g + 4 * hh);
            acc[h][4 * g + 0] = bf_lo(gu.x) * (acc[h][4 * g + 0] + bb); acc[h][4 * g + 1] = bf_hi(gu.x) * (acc[h][4 * g + 1] + bb);
            acc[h][4 * g + 2] = bf_lo(gu.y) * (acc[h][4 * g + 2] + bb); acc[h][4 * g + 3] = bf_hi(gu.y) * (acc[h][4 * g + 3] + bb);
        }
#pragma unroll
        for (int i = 0; i < 16; ++i) ss += acc[h][i] * acc[h][i];
    }
    ss += __shfl_xor(ss, 32);
    LAS float* red = (LAS float*)(lds + SG_RED);
    if (hh == 0) red[dsub * 64 + psub * 32 + pi] = ss;
    __syncthreads();
    const float tot = (red[psub * 32 + pi] + red[64 + psub * 32 + pi]) + (red[128 + psub * 32 + pi] + red[192 + psub * 32 + pi]);
    const float rs = rsqrtf(tot * (1.0f / 1024.0f) + EPS);
    bf16_t* op = MIX + orow * DM + 1024 + 32 * dsub;
#pragma unroll
    for (int h = 0; h < 8; ++h)
#pragma unroll
        for (int g = 0; g < 4; ++g) {
            u32x2 w; w.x = cvt_pk_bf16(acc[h][4 * g] * rs, acc[h][4 * g + 1] * rs); w.y = cvt_pk_bf16(acc[h][4 * g + 2] * rs, acc[h][4 * g + 3] * rs);
            *(u32x2*)(op + h * 128 + 8 * g + 4 * hh) = w;
        }
    __syncthreads();
}

__device__ __forceinline__ void fixup_phase(const bf16_t* HALO, const float* cw, const float* cb, bf16_t* ACT, int G, int wv) {
    constexpr int CH = DFF / 8;
    const int total = (T / 64) * 2 * CH;
    const int tid = fresh_tid(wv);
    for (int it = blockIdx.x * 512 + tid; it < total; it += G * 512) {
        const int ch = it % CH, br = it / CH, sl = br >> 1, side = br & 1;
        const int row = sl * 64 + (side ? 63 : 0), pos = row & (SEQ - 1);
        const int j = ch * 8;
        const bf16_t* hc = HALO + (size_t)(4 * sl + (side ? 3 : 0)) * NUP;
        const bf16_t* hp = side ? HALO + (size_t)(4 * sl + 2) * NUP : (pos == 0 ? nullptr : HALO + (size_t)(4 * (sl - 1) + 3) * NUP);
        const bf16_t* hn = side ? (pos == SEQ - 1 ? nullptr : HALO + (size_t)(4 * (sl + 1)) * NUP) : HALO + (size_t)(4 * sl + 1) * NUP;
        float a[2][8];
#pragma unroll
        for (int gu = 0; gu < 2; ++gu) {
            const int col = gu * DFF + j;
            const u32x4 z = {0u, 0u, 0u, 0u};
            const u32x4 vc = *(const u32x4*)(hc + col), vp = hp ? *(const u32x4*)(hp + col) : z, vn = hn ? *(const u32x4*)(hn + col) : z;
#pragma unroll
            for (int e = 0; e < 4; ++e) {
                const int c0 = col + 2 * e;
                a[gu][2 * e] = cb[c0] + cw[c0] * bf_lo(vp[e]) + cw[NUP + c0] * bf_lo(vc[e]) + cw[2 * NUP + c0] * bf_lo(vn[e]);
                a[gu][2 * e + 1] = cb[c0 + 1] + cw[c0 + 1] * bf_hi(vp[e]) + cw[NUP + c0 + 1] * bf_hi(vc[e]) + cw[2 * NUP + c0 + 1] * bf_hi(vn[e]);
            }
        }
        u32x4 w;
        w.x = cvt_pk_bf16(silu_f(a[0][0]) * a[1][0], silu_f(a[0][1]) * a[1][1]); w.y = cvt_pk_bf16(silu_f(a[0][2]) * a[1][2], silu_f(a[0][3]) * a[1][3]);
        w.z = cvt_pk_bf16(silu_f(a[0][4]) * a[1][4], silu_f(a[0][5]) * a[1][5]); w.w = cvt_pk_bf16(silu_f(a[0][6]) * a[1][6], silu_f(a[0][7]) * a[1][7]);
        *(u32x4*)(ACT + (size_t)row * DFF + j) = w;
    }
}


#define XB_TMO      128
#define XB_XCNT(j)  (256  + 64 * (j))
#define XB_XSUB(j)  (1280 + 64 * (j))
#define XB_XGEN(j)  (2304 + 64 * (j))
#define XB_TOP      3328
#define XB_TOPGEN   3392
#define XCD_BAR_WORDS 3456
#define XB_SPIN_CAP (1u << 18)
__device__ __forceinline__ unsigned xb_ld(unsigned* p)              { return __hip_atomic_load(p, __ATOMIC_RELAXED, __HIP_MEMORY_SCOPE_AGENT); }
__device__ __forceinline__ unsigned xb_add(unsigned* p, unsigned v) { return __hip_atomic_fetch_add(p, v, __ATOMIC_RELAXED, __HIP_MEMORY_SCOPE_AGENT); }
__device__ __forceinline__ unsigned xb_xcc_id() { return (unsigned)__builtin_amdgcn_s_getreg((3 << 11) | 20) & 0xFu; }
#define XB_SPIN(cond, bar) do { unsigned _sp = 0; while (cond) { __builtin_amdgcn_s_sleep(1); \
    if ((++_sp & 255u) == 0u) { if (xb_ld(&(bar)[XB_TMO])) break; if (_sp > XB_SPIN_CAP) { atomicAdd(&(bar)[XB_TMO], 1u); break; } } } } while (0)
struct XcdBarrier { unsigned* bar; unsigned x; volatile LAS unsigned* st; };
__device__ __forceinline__ XcdBarrier xcd_barrier_post(unsigned* bar, volatile LAS unsigned* st) {
    XcdBarrier b; b.bar = bar; b.x = xb_xcc_id(); b.st = st;
    if (threadIdx.x == 0) (void)xb_add(&bar[XB_XCNT(b.x)], 1u);
    return b;
}
__device__ __forceinline__ void xcd_barrier_complete(unsigned* bar, unsigned x, unsigned& nloc, unsigned& nx) {
    const unsigned G = gridDim.x * gridDim.y * gridDim.z;
    unsigned sum, cnt, mine, sp = 0u;
    for (;;) {
        sum = 0u; cnt = 0u; mine = 0u;
#pragma unroll
        for (unsigned j = 0; j < 16; ++j) { const unsigned c = xb_ld(&bar[XB_XCNT(j)]); sum += c; cnt += (c > 0u) ? 1u : 0u; mine = (j == x) ? c : mine; }
        if (sum == G) break;
        __builtin_amdgcn_s_sleep(1);
        if ((++sp & 255u) == 0u) { if (xb_ld(&bar[XB_TMO])) break; if (sp > XB_SPIN_CAP) { atomicAdd(&bar[XB_TMO], 1u); break; } }
    }
    nloc = mine > 0u ? mine : 1u; nx = cnt > 0u ? cnt : 1u;
}
__device__ __forceinline__ void xcd_barrier(const XcdBarrier& b) {
    asm volatile("s_waitcnt vmcnt(0)" ::: "memory");
    __syncthreads();
    const unsigned lane = (unsigned)lane_id_fresh();
    bool leader = false;
    if (lane == 0) { const unsigned t = __hip_atomic_fetch_add((LAS unsigned*)(b.st + 2), 1u, __ATOMIC_RELAXED, __HIP_MEMORY_SCOPE_WORKGROUP); leader = (t & 7u) == 0u; }
    if (leader) {
        unsigned* bar = b.bar; unsigned x = b.x; asm volatile("" : "+s"(x));
        __builtin_amdgcn_s_waitcnt(0);
        unsigned nloc = b.st[0], nx = b.st[1];
        if (nloc == 0u) { xcd_barrier_complete(bar, x, nloc, nx); b.st[0] = nloc; b.st[1] = nx; }
        const unsigned old = xb_add(&bar[XB_XSUB(x)], 1u);
        const unsigned gen = old / nloc;
        if (old + 1u == (gen + 1u) * nloc) {
            __builtin_amdgcn_fence(__ATOMIC_RELEASE, "agent");
            asm volatile("s_waitcnt vmcnt(0)" ::: "memory");
            const unsigned og = xb_add(&bar[XB_TOP], 1u);
            const unsigned tg = og / nx;
            if (og + 1u == (tg + 1u) * nx) xb_add(&bar[XB_TOPGEN], 1u);
            else XB_SPIN(xb_ld(&bar[XB_TOPGEN]) == tg, bar);
            __builtin_amdgcn_fence(__ATOMIC_ACQUIRE, "agent");
            xb_add(&bar[XB_XGEN(x)], 1u);
            asm volatile("s_waitcnt vmcnt(0)" ::: "memory");
        } else {
            XB_SPIN(xb_ld(&bar[XB_XGEN(x)]) == gen, bar);
            __builtin_amdgcn_fence(__ATOMIC_ACQUIRE, "agent");
            asm volatile("s_waitcnt vmcnt(0)" ::: "memory");
        }
    }
    __syncthreads();
}

typedef const __attribute__((address_space(4))) Args* ArgsP;
#define FRESH_ARGS() ArgsP ap = (ArgsP)__builtin_amdgcn_kernarg_segment_ptr(); asm volatile("" : "+s"(ap)); unsigned char* ws = ap->ws; const int G = gridDim.x, bx = blockIdx.x
__global__ void __launch_bounds__(512, 2) fwd_megakernel(Args a_unused) {
    extern __shared__ __attribute__((aligned(16))) unsigned char lds_raw[];
    LAS unsigned char* lds = (LAS unsigned char*)lds_raw;
    cg::grid_group grid = cg::this_grid();
    const int wv = __builtin_amdgcn_readfirstlane(threadIdx.x >> 6);
    volatile LAS unsigned* bst = (volatile LAS unsigned*)(lds + LDS_BYTES - 16);
    if (threadIdx.x < 4) bst[threadIdx.x] = 0u;
    __syncthreads();
    XcdBarrier xbar;
    { FRESH_ARGS(); xbar = xcd_barrier_post((unsigned*)(ws + OFF_CTL), bst); (void)G; (void)bx; }
    {
        FRESH_ARGS();
        Args a;
#pragma unroll
        for (int i = 0; i < 18; ++i) a.in[i] = ap->in[i];
        a.out = ap->out; a.ws = ws;
#ifndef NO_P0
        prologue(a, lds, G, wv);
#endif
    }
    grid.sync();

    for (int l = 0; l < DEPTH; ++l) {
        {
            FRESH_ARGS();
            pg8::Gemm g{(const bf16_t*)(ws + OFF_XB), (const bf16_t*)(ws + OFF_WIN + l * SZ_WIN), T, NIN, DM}; pg8::StaticOrder S; S.init(T, NIN, G, bx);
            EpiIn E{(const float*)(ws + OFF_XSS), ap->in[3] + l * 128, ap->in[4] + l * 128, (const float*)(ws + OFF_COS), (const float*)(ws + OFF_SIN),
                    (bf16_t*)(ws + OFF_Q), (bf16_t*)(ws + OFF_K), (bf16_t*)(ws + OFF_V), (bf16_t*)(ws + OFF_GU), (bf16_t*)(ws + OFF_GV),
                    (float*)(ws + OFF_QSS), (float*)(ws + OFF_KSS), (float*)(ws + OFF_GVS)};
#ifndef NO_IN
            pg8::gemm_phase(lds, g, S, E, wv);
#endif
        }
        xcd_barrier(xbar);
        {
            FRESH_ARGS();
#ifndef NO_ATT
            for (int u = bx; u < 512; u += G) attn_unit(lds, u, ap->in[5] + l * 8, (const bf16_t*)(ws + OFF_Q), (const bf16_t*)(ws + OFF_K), (const bf16_t*)(ws + OFF_V),
                                                        (const float*)(ws + OFF_QSS), (const float*)(ws + OFF_KSS), (bf16_t*)(ws + OFF_MIX), wv);
#endif
        }
        {
            FRESH_ARGS();
#ifndef NO_SGU
            for (int u = bx; u < 256; u += G) sgu_unit(lds, u, (const bf16_t*)(ws + OFF_GU), (const bf16_t*)(ws + OFF_GV), (const float*)(ws + OFF_GVS), ap->in[6] + l * 1024, ap->in[7] + l * 1024,
                                                       (const bf16_t*)(ws + OFF_WS) + (size_t)l * 8 * 128 * 128, ap->in[9] + l * 1024, (bf16_t*)(ws + OFF_MIX), wv);
#endif
        }
        xcd_barrier(xbar);
        {
            FRESH_ARGS();
            pg8::Gemm g{(const bf16_t*)(ws + OFF_MIX), (const bf16_t*)(ws + OFF_WO + l * SZ_WO), T, DM, DM}; pg8::StaticOrder S; S.init(T, DM, G, bx);
            EpiRes E{l == 0 ? ap->in[0] : ap->out, ap->out, (bf16_t*)(ws + OFF_XB), (float*)(ws + OFF_XSS)};
#ifndef NO_WO
            pg8::gemm_phase(lds, g, S, E, wv);
#endif
        }
        xcd_barrier(xbar);
        {
            FRESH_ARGS();
            pg8::Gemm g{(const bf16_t*)(ws + OFF_XB), (const bf16_t*)(ws + OFF_WUP + l * SZ_WUP), T, NUP, DM}; pg8::StaticOrder S; S.init(T, NUP, G, bx);
            EpiUp E{(const float*)(ws + OFF_XSS), ap->in[15] + (size_t)l * 3 * NUP, ap->in[16] + (size_t)l * NUP, (bf16_t*)(ws + OFF_ACT), (bf16_t*)(ws + OFF_HALO)};
#ifndef NO_UP
            pg8::gemm_phase(lds, g, S, E, wv);
#endif
        }
        xcd_barrier(xbar);
        {
            FRESH_ARGS();
#ifndef NO_FIX
            fixup_phase((const bf16_t*)(ws + OFF_HALO), ap->in[15] + (size_t)l * 3 * NUP, ap->in[16] + (size_t)l * NUP, (bf16_t*)(ws + OFF_ACT), G, wv);
#endif
        }
        xcd_barrier(xbar);
        {
            FRESH_ARGS();
            pg8::Gemm g{(const bf16_t*)(ws + OFF_ACT), (const bf16_t*)(ws + OFF_WDN + l * SZ_WDN), T, DM, DFF}; pg8::StaticOrder S; S.init(T, DM, G, bx);
            EpiRes E{ap->out, ap->out, (bf16_t*)(ws + OFF_XB), (float*)(ws + OFF_XSS)};
#ifndef NO_DN
            pg8::gemm_phase(lds, g, S, E, wv);
#endif
        }
        if (l + 1 < DEPTH) xcd_barrier(xbar);
    }
}

extern "C" void kernel_launch(void* const* d_in, const int* in_sizes, int n_in, void* d_out, int out_size, void* d_ws, size_t ws_size, hipStream_t stream) {
    static int grid = 0;
    if (grid == 0) {
        if (n_in != 18 || out_size != T * DM || ws_size < WS_END) { fprintf(stderr, "kernel_launch: unexpected problem (n_in %d, out %d, ws %zu < %zu)\n", n_in, out_size, ws_size, (size_t)WS_END); grid = -1; return; }
        int dev = 0, cus = 0, per_cu = 0;
        hipGetDevice(&dev);
        hipDeviceGetAttribute(&cus, hipDeviceAttributeMultiprocessorCount, dev);
        hipFuncSetAttribute((const void*)fwd_megakernel, hipFuncAttributeMaxDynamicSharedMemorySize, LDS_BYTES);
        hipOccupancyMaxActiveBlocksPerMultiprocessor(&per_cu, (const void*)fwd_megakernel, 512, LDS_BYTES);
        if (per_cu < 1) per_cu = 1;
        grid = cus * per_cu;
        (void)hipGetLastError();
    }
    if (grid < 0) return;
    Args a{};
    for (int i = 0; i < 18; ++i) a.in[i] = (const float*)d_in[i];
    a.out = (float*)d_out; a.ws = (unsigned char*)d_ws;
    (void)hipMemsetAsync((unsigned char*)d_ws + OFF_CTL, 0, CTL_BYTES, stream);
    void* args[] = {&a};
    hipError_t e = hipLaunchCooperativeKernel((const void*)fwd_megakernel, dim3(grid), dim3(512), args, LDS_BYTES, stream);
    if (e != hipSuccess) fprintf(stderr, "cooperative launch failed: %s (grid %d)\n", hipGetErrorString(e), grid);
}
```

```cpp
#include <hip/hip_runtime.h>
#include <hip/hip_cooperative_groups.h>
#include <cstdio>
#include <cstdint>
namespace cg = cooperative_groups;

#define LAS __attribute__((address_space(3)))
typedef unsigned short bf16_t;
typedef short bf16x8 __attribute__((ext_vector_type(8)));
typedef short s16x4 __attribute__((ext_vector_type(4)));
typedef float f32x4 __attribute__((ext_vector_type(4)));
typedef float f32x2 __attribute__((ext_vector_type(2)));
typedef float f32x16 __attribute__((ext_vector_type(16)));
typedef unsigned u32x4 __attribute__((ext_vector_type(4)));
typedef unsigned u32x2 __attribute__((ext_vector_type(2)));
typedef __bf16 bf16x2_t __attribute__((ext_vector_type(2)));

constexpr int T = 16384, SEQ = 2048, DM = 2048, NIN = 3584, DFF = 5632, NUP = 11264, DEPTH = 2;
constexpr float EPS = 1e-6f;
constexpr float LOG2E = 1.4426950408889634f;

constexpr size_t SZ_WIN = (size_t)NIN * DM * 2, SZ_WO = (size_t)DM * DM * 2, SZ_WUP = (size_t)NUP * DM * 2, SZ_WDN = (size_t)DM * DFF * 2;
constexpr size_t OFF_WIN = 0;
constexpr size_t OFF_WO = OFF_WIN + DEPTH * SZ_WIN;
constexpr size_t OFF_WUP = OFF_WO + DEPTH * SZ_WO;
constexpr size_t OFF_WDN = OFF_WUP + DEPTH * SZ_WUP;
constexpr size_t OFF_WS = OFF_WDN + DEPTH * SZ_WDN;
constexpr size_t OFF_COS = OFF_WS + (size_t)DEPTH * 8 * 128 * 128 * 2;
constexpr size_t OFF_SIN = OFF_COS + (size_t)SEQ * 64 * 4;
constexpr size_t OFF_XB = OFF_SIN + (size_t)SEQ * 64 * 4;
constexpr size_t OFF_XSS = OFF_XB + (size_t)T * DM * 2;
constexpr size_t OFF_Q = OFF_XSS + (size_t)T * 32 * 4;
constexpr size_t OFF_K = OFF_Q + (size_t)T * 1024 * 2;
constexpr size_t OFF_V = OFF_K + (size_t)T * 256 * 2;
constexpr size_t OFF_GU = OFF_V + (size_t)T * 256 * 2;
constexpr size_t OFF_GV = OFF_GU + (size_t)T * 1024 * 2;
constexpr size_t OFF_MIX = OFF_GV + (size_t)T * 1024 * 2;
constexpr size_t OFF_QSS = OFF_MIX + (size_t)T * DM * 2;
constexpr size_t OFF_KSS = OFF_QSS + (size_t)T * 32 * 4;
constexpr size_t OFF_GVS = OFF_KSS + (size_t)T * 8 * 4;
constexpr size_t OFF_ACT = OFF_GVS + (size_t)T * 32 * 4;
constexpr size_t OFF_HALO = OFF_ACT + (size_t)T * DFF * 2;
constexpr size_t OFF_RSW = OFF_HALO + (size_t)(T / 64 * 4) * NUP * 2;
constexpr size_t OFF_CTL = OFF_RSW + (size_t)DEPTH * 8 * 128 * 4;
constexpr size_t CTL_BYTES = 16384;
constexpr size_t WS_END = OFF_CTL + CTL_BYTES;

constexpr int LDS_BYTES = 147456;

__device__ __forceinline__ unsigned cvt_pk_bf16(float lo, float hi) { f32x2 v = {lo, hi}; bf16x2_t b = __builtin_convertvector(v, bf16x2_t); return __builtin_bit_cast(unsigned, b); }
__device__ __forceinline__ float bf_lo(unsigned u) { return __uint_as_float(u << 16); }
__device__ __forceinline__ float bf_hi(unsigned u) { return __uint_as_float(u & 0xffff0000u); }
__device__ __forceinline__ float gelu_tanh(float x) {
    const float u = 0.7978845608028654f * (x + 0.044715f * x * x * x);
    const float e = __builtin_amdgcn_exp2f(-2.0f * LOG2E * u);
    return x * __builtin_amdgcn_rcpf(1.0f + e);
}
__device__ __forceinline__ float silu_f(float x) { const float e = __builtin_amdgcn_exp2f(-LOG2E * x); return x * __builtin_amdgcn_rcpf(1.0f + e); }
__device__ __forceinline__ float dot4(f32x4 a) { return (a.x * a.x + a.y * a.y) + (a.z * a.z + a.w * a.w); }
__device__ __forceinline__ float sum4(f32x4 a) { return (a.x + a.y) + (a.z + a.w); }
__device__ __forceinline__ int crow(int r, int hi) { return (r & 3) + 8 * (r >> 2) + 4 * hi; }
__device__ __forceinline__ float wave_sum(float v) {
#pragma unroll
    for (int o = 1; o < 64; o <<= 1) v += __shfl_xor(v, o);
    return v;
}

__device__ __forceinline__ float dpp_prev(float v) { return __int_as_float(__builtin_amdgcn_mov_dpp(__float_as_int(v), 0x121, 0xF, 0xF, false)); }
__device__ __forceinline__ float dpp_next(float v) { return __int_as_float(__builtin_amdgcn_mov_dpp(__float_as_int(v), 0x12F, 0xF, 0xF, false)); }

__device__ __forceinline__ int lane_id_fresh() { int l; asm volatile("v_mbcnt_lo_u32_b32 %0, -1, 0\n\tv_mbcnt_hi_u32_b32 %0, -1, %0" : "=v"(l)); return l; }
__device__ __forceinline__ int fresh_tid(int wv) { return wv * 64 + lane_id_fresh(); }

namespace pg8 {
constexpr int BM = 256, BK = 64, HALF = 128, HTB = HALF * BK * 2, STAGE_BYTES = 8 * HTB, NXCD = 8, WGM = 8;
__host__ __device__ __forceinline__ int lds_byte(int r, int c) { const int st = (r >> 4) * 2 + (c >> 5), rr = r & 15, cc = c & 31, ob = rr * 64 + cc * 2; return st * 1024 + (ob ^ (((ob >> 9) & 1) << 5)); }
__host__ __device__ __forceinline__ void stage_rc(int b, int& R, int& C) { const int st = b / 1024, sb = b % 1024, swz = sb ^ (((sb >> 9) & 1) << 5); R = (st >> 1) * 16 + swz / 64; C = (st & 1) * 32 + (swz % 64) / 2; }
__host__ __device__ __forceinline__ int perm32(int rho) { const int n = rho >> 4, i = rho & 15; return 8 * (i >> 2) + 4 * n + (i & 3); }
struct Unit { int pm, pn; };
struct Gemm { const bf16_t* A; const bf16_t* Bt; int M, N, K; };
struct StaticOrder {
    int nM, nN, nwg, G, c, Lbase, Lend;
    __host__ __device__ void init(int M, int N, int G_, int c_) { nM = M / BM; nN = N / BM; nwg = nM * nN; G = G_; c = c_; Lbase = 0; Lend = nwg; }
    __host__ __device__ bool next(int i, Unit& u) const {
        const long L = (long)Lbase + (long)i * G + c; if (L >= Lend) return false;
        int wgid = (int)L; { const int q = nwg / NXCD, r = nwg % NXCD, xcd = wgid % NXCD, off = wgid / NXCD; wgid = (xcd < r ? xcd * (q + 1) : r * (q + 1) + (xcd - r) * q) + off; }
        const int nig = WGM * nN, gid = wgid / nig, fm = gid * WGM, gsz = (nM - fm) < WGM ? (nM - fm) : WGM;
        u.pm = fm + ((wgid % nig) % gsz); u.pn = (wgid % nig) / gsz; return true;
    }
};

template <class Epi, class Sched>
__device__ __forceinline__ void gemm_phase(LAS unsigned char* lds, const Gemm g, const Sched& S, const Epi& E, int wv) {
    const int tid = fresh_tid(wv);
    const int wid = __builtin_amdgcn_readfirstlane(tid >> 6), lane = tid & 63, wr = wid >> 2, wc = wid & 3, fr = lane & 15, fq = lane >> 4;
    const int K = g.K, nt = K / BK;
    unsigned voffA[2], voffB[2];
#pragma unroll
    for (int i = 0; i < 2; ++i) { int R, C; stage_rc(tid * 16 + i * 8192, R, C); const int Rb = (R & ~31) + perm32(R & 31);
        voffA[i] = (unsigned)(R * K + C) * 2u; voffB[i] = (unsigned)(Rb * K + C) * 2u; }
    const size_t kstep = (size_t)(BK * 2);
    const size_t hstep = (size_t)HALF * K * 2;
    const size_t tstep = 2 * hstep;
    const unsigned ldsw = (unsigned)wid * 1024u;
    const int aoff = lds_byte(wr * 64 + fr, fq * 8), boff = lds_byte(wc * 32 + fr, fq * 8);
#define PG8_SA(b, h) (((b) * 2 + (h)) * HTB)
#define PG8_SB(b, h) ((4 + (b) * 2 + (h)) * HTB)
#define PG8_STAGE(bufoff, gbase, voff) do { _Pragma("unroll") for (int _i = 0; _i < 2; ++_i) \
        __builtin_amdgcn_global_load_lds((const unsigned*)((const char*)(gbase) + (voff)[_i]), (LAS unsigned*)(lds + (bufoff) + ldsw + _i * 8192), 16, 0, 0); } while (0)
#define PG8_LDA(dst, b, h) do { _Pragma("unroll") for (int m = 0; m < 4; ++m) _Pragma("unroll") for (int k = 0; k < 2; ++k) dst[m][k] = *(const LAS bf16x8*)(lds + PG8_SA(b, h) + aoff + m * 2048 + k * 1024); } while (0)
#define PG8_LDB(dst, b, h) do { _Pragma("unroll") for (int n = 0; n < 2; ++n) _Pragma("unroll") for (int k = 0; k < 2; ++k) dst[n][k] = *(const LAS bf16x8*)(lds + PG8_SB(b, h) + boff + n * 2048 + k * 1024); } while (0)
#define PG8_MMA(ai, bj, At, Bt) do { __builtin_amdgcn_s_setprio(1); _Pragma("unroll") for (int m = 0; m < 4; ++m) _Pragma("unroll") for (int n = 0; n < 2; ++n) _Pragma("unroll") for (int k = 0; k < 2; ++k) \
        acc[ai][bj][m][n] = __builtin_amdgcn_mfma_f32_16x16x32_bf16(Bt[n][k], At[m][k], acc[ai][bj][m][n], 0, 0, 0); __builtin_amdgcn_s_setprio(0); } while (0)
#define PG8_WAIT_V(n) asm volatile("s_waitcnt vmcnt(" #n ")" ::: "memory")
#define PG8_WAIT_L(n) asm volatile("s_waitcnt lgkmcnt(" #n ")" ::: "memory")
#define PG8_BAR __builtin_amdgcn_s_barrier()
#define PG8_SCHED __builtin_amdgcn_sched_barrier(0)
    Unit cur, nxt; int ui = 0;
    if (!S.next(0, cur)) return;
    f32x4 acc[2][2][4][2];
#pragma unroll
    for (int a = 0; a < 2; ++a)
#pragma unroll
        for (int b = 0; b < 2; ++b)
#pragma unroll
            for (int m = 0; m < 4; ++m)
#pragma unroll
                for (int n = 0; n < 2; ++n) acc[a][b][m][n] = (f32x4){0.f, 0.f, 0.f, 0.f};
    bf16x8 At[4][2], B0[2][2], B1[2][2];
    const char* cA = (const char*)g.A + (size_t)cur.pm * tstep; const char* cB = (const char*)g.Bt + (size_t)cur.pn * tstep;
    PG8_STAGE(PG8_SB(0, 0), cB, voffB); PG8_STAGE(PG8_SB(0, 1), cB + hstep, voffB); PG8_STAGE(PG8_SA(0, 0), cA, voffA); PG8_STAGE(PG8_SA(0, 1), cA + hstep, voffA);
    if (wr == 1) PG8_BAR;
    PG8_WAIT_V(2); PG8_BAR;
    PG8_STAGE(PG8_SB(1, 0), cB + kstep, voffB); PG8_STAGE(PG8_SA(1, 0), cA + kstep, voffA); PG8_STAGE(PG8_SB(1, 1), cB + hstep + kstep, voffB);
    PG8_WAIT_V(6); PG8_BAR;
    for (;;) {
        const bool has_next = S.next(ui + 1, nxt);
        const char* nA = has_next ? (const char*)g.A + (size_t)nxt.pm * tstep : cA; const char* nB = has_next ? (const char*)g.Bt + (size_t)nxt.pn * tstep : cB;
        for (int t = 0; t < nt; t += 2) {
            const bool last = (t == nt - 2);
            const char* a1 = cA + (size_t)(t + 1) * kstep;
            const char* a2 = last ? nA : cA + (size_t)(t + 2) * kstep; const char* b2 = last ? nB : cB + (size_t)(t + 2) * kstep;
            const char* a3 = a2 + kstep; const char* b3 = b2 + kstep;
            PG8_LDB(B0, 0, 0); PG8_LDB(B1, 0, 1); PG8_SCHED; PG8_LDA(At, 0, 0); PG8_STAGE(PG8_SA(1, 1), a1 + hstep, voffA);
            PG8_WAIT_V(8); PG8_WAIT_L(0); PG8_BAR; PG8_MMA(0, 0, At, B0); PG8_MMA(0, 1, At, B1); PG8_BAR; PG8_SCHED;
            PG8_LDA(At, 0, 1); PG8_STAGE(PG8_SB(0, 0), b2, voffB); PG8_STAGE(PG8_SB(0, 1), b2 + hstep, voffB); PG8_STAGE(PG8_SA(0, 0), a2, voffA);
            PG8_WAIT_V(8); PG8_WAIT_L(0); PG8_BAR; PG8_MMA(1, 0, At, B0); PG8_MMA(1, 1, At, B1); PG8_BAR; PG8_SCHED;
            PG8_LDB(B0, 1, 0); PG8_LDB(B1, 1, 1); PG8_SCHED; PG8_LDA(At, 1, 0); PG8_STAGE(PG8_SA(0, 1), a2 + hstep, voffA);
            PG8_WAIT_V(8); PG8_WAIT_L(0); PG8_BAR; PG8_MMA(0, 0, At, B0); PG8_MMA(0, 1, At, B1); PG8_BAR; PG8_SCHED;
            PG8_LDA(At, 1, 1); PG8_STAGE(PG8_SB(1, 0), b3, voffB); PG8_STAGE(PG8_SB(1, 1), b3 + hstep, voffB); PG8_STAGE(PG8_SA(1, 0), a3, voffA);
            PG8_WAIT_V(8); PG8_WAIT_L(0); PG8_BAR; PG8_MMA(1, 0, At, B0); PG8_MMA(1, 1, At, B1); PG8_BAR; PG8_SCHED;
        }
        if (wr == 0) PG8_BAR;
        E(acc, cur, wr, wc, fr, fq);
        if (!has_next) break;
#pragma unroll
        for (int a = 0; a < 2; ++a)
#pragma unroll
            for (int b = 0; b < 2; ++b)
#pragma unroll
                for (int m = 0; m < 4; ++m)
#pragma unroll
                    for (int n = 0; n < 2; ++n) acc[a][b][m][n] = (f32x4){0.f, 0.f, 0.f, 0.f};
        cur = nxt; cA = nA; cB = nB; ++ui;
        if (wr == 1) PG8_BAR;
    }
    PG8_WAIT_V(0);
    PG8_BAR;
#undef PG8_SA
#undef PG8_SB
#undef PG8_STAGE
#undef PG8_LDA
#undef PG8_LDB
#undef PG8_MMA
#undef PG8_WAIT_V
#undef PG8_WAIT_L
#undef PG8_BAR
#undef PG8_SCHED
}
}
using pg8::Unit;

__device__ __forceinline__ void row_rstd(const float* xss, int row0, int fq, float (&r)[2][4]) {
    f32x4 a[8], b[8];
#pragma unroll
    for (int i = 0; i < 8; ++i) { const f32x4* p = (const f32x4*)(xss + (size_t)(row0 + 128 * (i >> 2) + 16 * (i & 3)) * 32 + 8 * fq); a[i] = p[0]; b[i] = p[1]; }
#pragma unroll
    for (int i = 0; i < 8; ++i) {
        float s = sum4(a[i]) + sum4(b[i]);
        s += __shfl_xor(s, 16); s += __shfl_xor(s, 32);
        r[i >> 2][i & 3] = rsqrtf(s * (1.0f / DM) + EPS);
    }
    asm volatile("" ::: "memory");
}

struct EpiIn {
    const float* xss; const float* qg; const float* kg; const float* cosT; const float* sinT;
    bf16_t *Q, *K, *V, *GU, *GV; float *qss, *kss, *gvs;
    __device__ __forceinline__ void operator()(const f32x4 (&acc)[2][2][4][2], const Unit& u, int wr, int wc, int fr, int fq) const {
        asm volatile("" : "+v"(fr), "+v"(fq));
        const int row0 = u.pm * 256 + wr * 64 + fr;
        float rr[2][4]; row_rstd(xss, row0, fq, rr);
        const int pn = u.pn;
        if (pn < 5) {
            const bool isq = pn < 4;
            const float* gn = isq ? qg : kg;
            const int gg = 4 * wc + fq;
            const f32x4 glo = *(const f32x4*)(gn + 4 * gg), ghi = *(const f32x4*)(gn + 64 + 4 * gg);
#pragma unroll
            for (int ai = 0; ai < 2; ++ai) {
                f32x4 cs[4], sn[4];
#pragma unroll
                for (int i = 0; i < 4; ++i) { const int pos = (row0 + 128 * ai + 16 * i) & (SEQ - 1); cs[i] = *(const f32x4*)(cosT + pos * 64 + 4 * gg); sn[i] = *(const f32x4*)(sinT + pos * 64 + 4 * gg); }
#pragma unroll
                for (int m = 0; m < 4; ++m) {
                    const int row = row0 + 128 * ai + 16 * m;
                    const f32x4 c = cs[m], s = sn[m];
                    const float r = rr[ai][m];
#pragma unroll
                    for (int bj = 0; bj < 2; ++bj) {
                        const f32x4 v0 = acc[ai][bj][m][0] * r, v1 = acc[ai][bj][m][1] * r;
                        float ss = dot4(v0) + dot4(v1);
                        ss += __shfl_xor(ss, 16); ss += __shfl_xor(ss, 32);
                        const int head = isq ? 2 * pn + bj : bj;
                        if (fq == 0) { if (isq) qss[((size_t)row * 8 + head) * 4 + wc] = ss; else kss[((size_t)row * 2 + head) * 4 + wc] = ss; }
                        const f32x4 y0 = v0 * glo, y1 = v1 * ghi;
                        const f32x4 lo = y0 * c - y1 * s, hi = y1 * c + y0 * s;
                        bf16_t* dst = (isq ? Q + (size_t)row * 1024 : K + (size_t)row * 256) + head * 128;
                        u32x2 wl, wh; wl.x = cvt_pk_bf16(lo.x, lo.y); wl.y = cvt_pk_bf16(lo.z, lo.w); wh.x = cvt_pk_bf16(hi.x, hi.y); wh.y = cvt_pk_bf16(hi.z, hi.w);
                        *(u32x2*)(dst + 4 * gg) = wl; *(u32x2*)(dst + 64 + 4 * gg) = wh;
                    }
                }
                asm volatile("" ::: "memory");
            }
        } else if (pn == 5) {
#pragma unroll
            for (int ai = 0; ai < 2; ++ai)
#pragma unroll
                for (int m = 0; m < 4; ++m) {
                    const int row = row0 + 128 * ai + 16 * m; const float r = rr[ai][m];
#pragma unroll
                    for (int bj = 0; bj < 2; ++bj) {
                        const f32x4 v0 = acc[ai][bj][m][0] * r, v1 = acc[ai][bj][m][1] * r;
                        u32x4 w; w.x = cvt_pk_bf16(v0.x, v0.y); w.y = cvt_pk_bf16(v0.z, v0.w); w.z = cvt_pk_bf16(v1.x, v1.y); w.w = cvt_pk_bf16(v1.z, v1.w);
                        *(u32x4*)(V + (size_t)row * 256 + bj * 128 + 32 * wc + 8 * fq) = w;
                    }
                }
        } else {
            const bool isgv = pn >= 10;
            const int ct = isgv ? pn - 10 : pn - 6;
            bf16_t* dstb = (isgv ? GV : GU) + ct * 256 + 32 * wc + 8 * fq;
#pragma unroll
            for (int ai = 0; ai < 2; ++ai)
#pragma unroll
                for (int m = 0; m < 4; ++m) {
                    const int row = row0 + 128 * ai + 16 * m; const float r = rr[ai][m];
                    float s1 = 0.f, s2 = 0.f;
#pragma unroll
                    for (int bj = 0; bj < 2; ++bj) {
                        f32x4 v0 = acc[ai][bj][m][0] * r, v1 = acc[ai][bj][m][1] * r;
                        v0.x = gelu_tanh(v0.x); v0.y = gelu_tanh(v0.y); v0.z = gelu_tanh(v0.z); v0.w = gelu_tanh(v0.w);
                        v1.x = gelu_tanh(v1.x); v1.y = gelu_tanh(v1.y); v1.z = gelu_tanh(v1.z); v1.w = gelu_tanh(v1.w);
                        s1 += sum4(v0) + sum4(v1); s2 += dot4(v0) + dot4(v1);
                        u32x4 w; w.x = cvt_pk_bf16(v0.x, v0.y); w.y = cvt_pk_bf16(v0.z, v0.w); w.z = cvt_pk_bf16(v1.x, v1.y); w.w = cvt_pk_bf16(v1.z, v1.w);
                        *(u32x4*)(dstb + (size_t)row * 1024 + bj * 128) = w;
                    }
                    if (isgv) {
                        s1 += __shfl_xor(s1, 16); s1 += __shfl_xor(s1, 32);
                        s2 += __shfl_xor(s2, 16); s2 += __shfl_xor(s2, 32);
                        if (fq == 0) *(f32x2*)(gvs + ((size_t)row * 16 + ct * 4 + wc) * 2) = (f32x2){s1, s2};
                    }
                    asm volatile("" ::: "memory");
                }
        }
    }
};

struct EpiRes {
    float* out; bf16_t* xb; float* xss;
    __device__ __forceinline__ void operator()(const f32x4 (&acc)[2][2][4][2], const Unit& u, int wr, int wc, int fr, int fq) const {
        asm volatile("" : "+v"(fr), "+v"(fq));
        const int row0 = u.pm * 256 + wr * 64 + fr, col0 = u.pn * 256 + 32 * wc + 8 * fq;
#pragma unroll
        for (int ai = 0; ai < 2; ++ai) {
            u32x4 bv[2][4][2];
#pragma unroll
            for (int m = 0; m < 4; ++m)
#pragma unroll
                for (int bj = 0; bj < 2; ++bj) bv[ai][m][bj] = *(const u32x4*)(xb + (size_t)(row0 + 128 * ai + 16 * m) * DM + col0 + bj * 128);
#pragma unroll
            for (int m = 0; m < 4; ++m) {
                const int row = row0 + 128 * ai + 16 * m; float ss = 0.f;
#pragma unroll
                for (int bj = 0; bj < 2; ++bj) {
                    const size_t off = (size_t)row * DM + col0 + bj * 128;
                    const u32x4 b = bv[ai][m][bj];
                    const f32x4 o0 = (f32x4){bf_lo(b.x), bf_hi(b.x), bf_lo(b.y), bf_hi(b.y)} + acc[ai][bj][m][0];
                    const f32x4 o1 = (f32x4){bf_lo(b.z), bf_hi(b.z), bf_lo(b.w), bf_hi(b.w)} + acc[ai][bj][m][1];
                    if (out) { *(f32x4*)(out + off) = o0; *(f32x4*)(out + off + 4) = o1; }
                    else {
                        u32x4 w; w.x = cvt_pk_bf16(o0.x, o0.y); w.y = cvt_pk_bf16(o0.z, o0.w); w.z = cvt_pk_bf16(o1.x, o1.y); w.w = cvt_pk_bf16(o1.z, o1.w);
                        *(u32x4*)(xb + off) = w;
                        ss += dot4(o0) + dot4(o1);
                    }
                }
                if (!out) {
                    ss += __shfl_xor(ss, 16); ss += __shfl_xor(ss, 32);
                    if (fq == 0) xss[(size_t)row * 32 + u.pn * 4 + wc] = ss;
                }
            }
            asm volatile("" ::: "memory");
        }
    }
};

struct EpiUp {
    const float* xss; const float* cw; const float* cb; bf16_t* ACT; bf16_t* HALO;
    __device__ __forceinline__ void operator()(f32x4 (&acc)[2][2][4][2], const Unit& u, int wr, int wc, int fr, int fq) const {
        asm volatile("" : "+v"(fr), "+v"(fq));
        const int row0 = u.pm * 256 + wr * 64 + fr;
        float rr[2][4]; row_rstd(xss, row0, fq, rr);
        const int jg = u.pn * 128 + 32 * wc + 8 * fq;
#pragma unroll
        for (int ai = 0; ai < 2; ++ai)
#pragma unroll
            for (int m = 0; m < 4; ++m) {
                const float r = rr[ai][m];
#pragma unroll
                for (int bj = 0; bj < 2; ++bj) { acc[ai][bj][m][0] *= r; acc[ai][bj][m][1] *= r; }
                if (m == 0 || m == 3) {
                    const bool hal = (m == 0) ? (fr < 2) : (fr >= 14);
                    if (hal) {
                        const int row = row0 + 128 * ai + 16 * m;
                        const int hr = (row >> 6) * 4 + (m == 0 ? fr : fr - 12);
#pragma unroll
                        for (int bj = 0; bj < 2; ++bj) {
                            const f32x4 v0 = acc[ai][bj][m][0], v1 = acc[ai][bj][m][1];
                            u32x4 w; w.x = cvt_pk_bf16(v0.x, v0.y); w.y = cvt_pk_bf16(v0.z, v0.w); w.z = cvt_pk_bf16(v1.x, v1.y); w.w = cvt_pk_bf16(v1.z, v1.w);
                            *(u32x4*)(HALO + (size_t)hr * NUP + (bj ? DFF : 0) + jg) = w;
                        }
                    }
                }
            }
        __builtin_amdgcn_sched_barrier(0);
#pragma unroll
        for (int n = 0; n < 2; ++n) {
            f32x4 wv[2][2][4];
#pragma unroll
            for (int bj = 0; bj < 2; ++bj) {
                const int col = (bj ? DFF : 0) + jg + 4 * n;
                const float ksc = bj ? -0.6931471805599453f : -LOG2E;
                wv[n][bj][0] = *(const f32x4*)(cw + col) * ksc; wv[n][bj][1] = *(const f32x4*)(cw + NUP + col) * ksc; wv[n][bj][2] = *(const f32x4*)(cw + 2 * NUP + col) * ksc; wv[n][bj][3] = *(const f32x4*)(cb + col) * ksc;
            }
#pragma unroll
            for (int e = 0; e < 4; ++e) {
#pragma unroll
                for (int ai = 0; ai < 2; ++ai) {
                    float a[2][4];
#pragma unroll
                    for (int bj = 0; bj < 2; ++bj) {
                        float raw[4], P[4], N[4];
#pragma unroll
                        for (int m = 0; m < 4; ++m) raw[m] = acc[ai][bj][m][n][e];
                        asm volatile("" : "+v"(raw[0]), "+v"(raw[1]), "+v"(raw[2]), "+v"(raw[3]));
#pragma unroll
                        for (int m = 0; m < 4; ++m) { P[m] = dpp_prev(raw[m]); N[m] = dpp_next(raw[m]); }
#pragma unroll
                        for (int m = 0; m < 4; ++m) {
                            const float prev = fr > 0 ? P[m] : (m > 0 ? P[m > 0 ? m - 1 : 0] : 0.f);
                            const float next = fr < 15 ? N[m] : (m < 3 ? N[m < 3 ? m + 1 : 3] : 0.f);
                            a[bj][m] = __builtin_fmaf(wv[n][bj][0][e], prev, __builtin_fmaf(wv[n][bj][1][e], raw[m], __builtin_fmaf(wv[n][bj][2][e], next, wv[n][bj][3][e])));
                        }
                        asm volatile("" : "+v"(a[bj][0]), "+v"(a[bj][1]), "+v"(a[bj][2]), "+v"(a[bj][3]));
                    }
#pragma unroll
                    for (int m = 0; m < 4; ++m) acc[ai][0][m][n][e] = (a[0][m] * a[1][m]) * __builtin_amdgcn_rcpf(1.0f + __builtin_amdgcn_exp2f(a[0][m]));
                }
            }
        }
#pragma unroll
        for (int ai = 0; ai < 2; ++ai)
#pragma unroll
            for (int m = 0; m < 4; ++m) {
                const int row = row0 + 128 * ai + 16 * m;
                const bool edge = (m == 0 && fr == 0) || (m == 3 && fr == 15);
                if (!edge) {
                    const f32x4 v0 = acc[ai][0][m][0], v1 = acc[ai][0][m][1];
                    u32x4 w; w.x = cvt_pk_bf16(v0.x, v0.y); w.y = cvt_pk_bf16(v0.z, v0.w); w.z = cvt_pk_bf16(v1.x, v1.y); w.w = cvt_pk_bf16(v1.z, v1.w);
                    *(u32x4*)(ACT + (size_t)row * DFF + jg) = w;
                }
            }
    }
};

struct Args { const float* in[18]; float* out; unsigned char* ws; };

__device__ __forceinline__ int cmap_in(int n) {
    if (n >= 1280) return n;
    const int head = n >> 7, c = n & 127, g = c >> 3, j = c & 7;
    return head * 128 + ((j < 4) ? 4 * g + j : 64 + 4 * g + (j - 4));
}
__device__ __forceinline__ int cmap_up(int n) { const int pn = n >> 8, c = n & 255; return (c < 128) ? 128 * pn + c : DFF + 128 * pn + (c - 128); }

template <int MODE>
__device__ __forceinline__ void transpose_item(const float* W, int K, int N, bf16_t* WT, const float* gk, LAS float* scr, int item, int lane) {
    const int nblk = N / 64, kb = item / nblk, nb = item % nblk, k0 = 64 * kb, n0 = 64 * nb;
    const int c4 = lane & 15, r4 = lane >> 4;
    const int nn = n0 + 4 * c4;
    const int sc = MODE == 1 ? cmap_in(nn) : (MODE == 2 ? cmap_up(nn) : nn);
    f32x4 v[16];
    const float* src = W + (size_t)(k0 + r4) * N + sc;
#pragma unroll
    for (int i = 0; i < 16; ++i) v[i] = *(const f32x4*)(src + (size_t)(4 * i) * N);
    if (gk) {
#pragma unroll
        for (int i = 0; i < 16; ++i) v[i] *= gk[k0 + 4 * i + r4];
    }
#pragma unroll
    for (int i = 0; i < 16; ++i) { LAS float* d = scr + (4 * i + r4) * 65 + 4 * c4; d[0] = v[i].x; d[1] = v[i].y; d[2] = v[i].z; d[3] = v[i].w; }
    asm volatile("s_waitcnt lgkmcnt(0)" ::: "memory");
    const int c = lane & 7;
#pragma unroll
    for (int j = 0; j < 8; ++j) { const int n = (lane >> 3) + 8 * j; const LAS float* p = scr + (8 * c) * 65 + n;
        u32x4 o; o.x = cvt_pk_bf16(p[0 * 65], p[1 * 65]); o.y = cvt_pk_bf16(p[2 * 65], p[3 * 65]); o.z = cvt_pk_bf16(p[4 * 65], p[5 * 65]); o.w = cvt_pk_bf16(p[6 * 65], p[7 * 65]);
        *(u32x4*)(WT + (size_t)(n0 + n) * K + k0 + 8 * c) = o; }
    asm volatile("s_waitcnt lgkmcnt(0)" ::: "memory");
}

__device__ __forceinline__ void prologue(const Args& a, LAS unsigned char* lds, int G, int wv) {
    const int tid = fresh_tid(wv);
    const int lane = tid & 63, wave = tid >> 6;
    LAS float* scr = (LAS float*)(lds + wave * 16640);
    const int gw = blockIdx.x * 8 + wave, NGW = G * 8;
    unsigned char* ws = a.ws;
    constexpr int I_IN = (DM / 64) * (NIN / 64), I_O = (DM / 64) * (DM / 64), I_UP = (DM / 64) * (NUP / 64), I_DN = (DFF / 64) * (DM / 64);
    constexpr int I_L = I_IN + I_O + I_UP + I_DN;
    for (int it = gw; it < DEPTH * I_L; it += NGW) {
        const int l = it / I_L; int r = it % I_L;
        if (r < I_IN) { transpose_item<1>(a.in[2] + (size_t)l * DM * NIN, DM, NIN, (bf16_t*)(ws + OFF_WIN + l * SZ_WIN), a.in[1] + l * DM, scr, r, lane); continue; } r -= I_IN;
        if (r < I_O) {
            const int kb = r / (DM / 64); const float* gk = (kb < 16) ? (a.in[10] + l * 1024) : (a.in[11] + l * 1024 - 1024);
            transpose_item<0>(a.in[12] + (size_t)l * DM * DM, DM, DM, (bf16_t*)(ws + OFF_WO + l * SZ_WO), gk, scr, r, lane); continue; } r -= I_O;
        if (r < I_UP) { transpose_item<2>(a.in[14] + (size_t)l * DM * NUP, DM, NUP, (bf16_t*)(ws + OFF_WUP + l * SZ_WUP), a.in[13] + l * DM, scr, r, lane); continue; } r -= I_UP;
        transpose_item<0>(a.in[17] + (size_t)l * DFF * DM, DFF, DM, (bf16_t*)(ws + OFF_WDN + l * SZ_WDN), nullptr, scr, r, lane);
    }
    {
        const float* x = a.in[0]; bf16_t* xb = (bf16_t*)(ws + OFF_XB); float* xss = (float*)(ws + OFF_XSS);
        for (int m = gw; m < T; m += 2 * NGW) {
            const int m2 = m + NGW;
            const bool has2 = m2 < T;
            const f32x4* xr = (const f32x4*)(x + (size_t)m * DM) + lane; const f32x4* xr2 = (const f32x4*)(x + (size_t)(has2 ? m2 : m) * DM) + lane;
            f32x4 va[8], vb[8];
#pragma unroll
            for (int j = 0; j < 8; ++j) { va[j] = xr[64 * j]; vb[j] = xr2[64 * j]; }
            float s = 0.f, s2 = 0.f;
            u32x2* o8 = (u32x2*)(xb + (size_t)m * DM) + lane; u32x2* o82 = (u32x2*)(xb + (size_t)(has2 ? m2 : m) * DM) + lane;
#pragma unroll
            for (int j = 0; j < 8; ++j) { s += dot4(va[j]); s2 += dot4(vb[j]);
                u32x2 w; w.x = cvt_pk_bf16(va[j].x, va[j].y); w.y = cvt_pk_bf16(va[j].z, va[j].w); o8[64 * j] = w;
                u32x2 w2; w2.x = cvt_pk_bf16(vb[j].x, vb[j].y); w2.y = cvt_pk_bf16(vb[j].z, vb[j].w); if (has2) o82[64 * j] = w2; }
            s = wave_sum(s); s2 = wave_sum(s2);
            if (lane < 32) { xss[(size_t)m * 32 + lane] = (lane == 0) ? s : 0.f; if (has2) xss[(size_t)m2 * 32 + lane] = (lane == 0) ? s2 : 0.f; }
        }
    }
    {
        float* cosT = (float*)(ws + OFF_COS); float* sinT = (float*)(ws + OFF_SIN);
        for (int i = blockIdx.x * 512 + tid; i < SEQ * 64; i += G * 512) {
            const int pos = i >> 6, k = i & 63;
            const float inv = (float)exp2(-(double)k * (13.287712379549449 / 64.0));
            const float ang = (float)pos * inv;
            double rev = (double)ang * 0.15915494309189535; rev -= rint(rev);
            const float fr = (float)rev;
            cosT[i] = __builtin_amdgcn_cosf(fr); sinT[i] = __builtin_amdgcn_sinf(fr);
        }
    }
    {
        const float* wsrc = a.in[8]; float* rsw = (float*)(ws + OFF_RSW);
        for (int r = gw; r < DEPTH * 8 * 128; r += NGW) {
            const f32x2 v = *((const f32x2*)(wsrc + (size_t)r * 128) + lane);
            const float t = wave_sum(v.x + v.y);
            if (lane == 0) rsw[r] = t;
        }
    }
    {
        const float* wsrc = a.in[8]; bf16_t* wd = (bf16_t*)(ws + OFF_WS);
        for (int i = blockIdx.x * 512 + tid; i < DEPTH * 8 * 128 * 128 / 4; i += G * 512) {
            const f32x4 v = *((const f32x4*)wsrc + i); u32x2 w; w.x = cvt_pk_bf16(v.x, v.y); w.y = cvt_pk_bf16(v.z, v.w); *((u32x2*)wd + i) = w;
        }
    }
}

#define LDS_BARRIER() do { asm volatile("s_waitcnt lgkmcnt(0)" ::: "memory"); __builtin_amdgcn_s_barrier(); asm volatile("" ::: "memory"); } while (0)

__device__ __forceinline__ s16x4 vtr(const LAS unsigned char* p) { typedef short v4i16_t __attribute__((ext_vector_type(4))); return __builtin_bit_cast(s16x4, __builtin_amdgcn_ds_read_tr16_b64_v4i16((LAS v4i16_t*)p)); }
#define MFMA32(a, b, c) __builtin_amdgcn_mfma_f32_32x32x16_bf16((a), (b), (c), 0, 0, 0)

constexpr int AT_KROW = 272, AT_VROW = 288, AT_KSZ = 32 * AT_KROW, AT_VSZ = 32 * AT_VROW, AT_BUF = 2 * AT_KSZ + 2 * AT_VSZ;
constexpr int AT_RED = 2 * AT_BUF;

__device__ __forceinline__ void attn_unit(LAS unsigned char* lds, int unit, const float* sinkl, const bf16_t* Q, const bf16_t* K, const bf16_t* V, const float* qss, const float* kss, bf16_t* MIX, int wv) {
    const int tid = fresh_tid(wv);
    const int lane = tid & 63, wid = __builtin_amdgcn_readfirstlane(tid >> 6), qi = lane & 31, hh = lane >> 5;
    const int b = unit >> 6, qb = unit & 63, q0 = qb * 32;
    const size_t rowbase = (size_t)b * SEQ;
    const int hq = wid, kvh = wid >> 2;
    const size_t qrow = rowbase + q0 + qi;
    bf16x8 qf[8];
    { const bf16_t* qp = Q + qrow * 1024 + hq * 128 + 8 * hh;
#pragma unroll
      for (int s = 0; s < 8; ++s) qf[s] = *(const bf16x8*)(qp + 16 * s); }
    const f32x4 qs = *(const f32x4*)(qss + (qrow * 8 + hq) * 4);
    const float rq = rsqrtf(sum4(qs) * (1.0f / 128.0f) + EPS);
    const float sc = rq * 0.08838834764831845f * LOG2E;
    const float sk = sinkl[hq] * LOG2E;
    float m_run = sk, l_run = (hh == 0) ? 1.f : 0.f;
    f32x16 o[4];
#pragma unroll
    for (int c = 0; c < 4; ++c)
#pragma unroll
        for (int i = 0; i < 16; ++i) o[c][i] = 0.f;
    int kb_lo = 0, kb_hi = 8;
    if (qb < 4) kb_lo = 4 - qb;
    if (qb > 59) kb_hi = 67 - qb;
    const int skey = tid >> 4, spart = tid & 15;
    u32x4 pk0A, pk1A, pv0A, pv1A, pk0B, pk1B, pv0B, pv1B; f32x4 ks0A, ks1A, ks0B, ks1B;
#define AT_LOAD(S, kb) do { const size_t r_ = rowbase + (size_t)(q0 - 128 + 32 * (kb) + skey); \
        pk0##S = *(const u32x4*)(K + r_ * 256 + 8 * spart); pk1##S = *(const u32x4*)(K + r_ * 256 + 128 + 8 * spart); \
        pv0##S = *(const u32x4*)(V + r_ * 256 + 8 * spart); pv1##S = *(const u32x4*)(V + r_ * 256 + 128 + 8 * spart); \
        ks0##S = *(const f32x4*)(kss + r_ * 8); ks1##S = *(const f32x4*)(kss + r_ * 8 + 4); } while (0)
#define AT_SCALE(p, r) do { u32x4 t_; \
        t_.x = cvt_pk_bf16(bf_lo(p.x) * r, bf_hi(p.x) * r); t_.y = cvt_pk_bf16(bf_lo(p.y) * r, bf_hi(p.y) * r); \
        t_.z = cvt_pk_bf16(bf_lo(p.z) * r, bf_hi(p.z) * r); t_.w = cvt_pk_bf16(bf_lo(p.w) * r, bf_hi(p.w) * r); p = t_; } while (0)
#define AT_WRITE(S, buf) do { const float r0_ = rsqrtf(sum4(ks0##S) * (1.0f / 128.0f) + EPS), r1_ = rsqrtf(sum4(ks1##S) * (1.0f / 128.0f) + EPS); \
        AT_SCALE(pk0##S, r0_); AT_SCALE(pk1##S, r1_); \
        LAS unsigned char* b_ = lds + (buf) * AT_BUF; \
        *(LAS u32x4*)(b_ + skey * AT_KROW + spart * 16) = pk0##S; *(LAS u32x4*)(b_ + AT_KSZ + skey * AT_KROW + spart * 16) = pk1##S; \
        *(LAS u32x4*)(b_ + 2 * AT_KSZ + skey * AT_VROW + spart * 16) = pv0##S; *(LAS u32x4*)(b_ + 2 * AT_KSZ + AT_VSZ + skey * AT_VROW + spart * 16) = pv1##S; } while (0)
    const int trq = (lane & 15) >> 2, trp = lane & 3, blk = (lane >> 4) & 1;
#define AT_COMPUTE(kb, cur) do { \
        const LAS unsigned char* Kb = lds + (cur) * AT_BUF + kvh * AT_KSZ; \
        const LAS unsigned char* Vb = lds + (cur) * AT_BUF + 2 * AT_KSZ + kvh * AT_VSZ; \
        f32x16 st; \
        _Pragma("unroll") for (int i = 0; i < 16; ++i) st[i] = 0.f; \
        _Pragma("unroll") for (int s_ = 0; s_ < 8; ++s_) { const bf16x8 kf = *(const LAS bf16x8*)(Kb + qi * AT_KROW + (16 * s_ + 8 * hh) * 2); st = MFMA32(kf, qf[s_], st); } \
        float tt[16]; \
        _Pragma("unroll") for (int i = 0; i < 16; ++i) tt[i] = st[i] * sc; \
        if ((kb) == 0) { _Pragma("unroll") for (int i = 0; i < 16; ++i) if (crow(i, hh) < qi) tt[i] = -INFINITY; } \
        if ((kb) == 8) { _Pragma("unroll") for (int i = 0; i < 16; ++i) if (crow(i, hh) > qi) tt[i] = -INFINITY; } \
        float mx = tt[0]; \
        _Pragma("unroll") for (int i = 1; i < 16; ++i) mx = fmaxf(mx, tt[i]); \
        mx = fmaxf(mx, __shfl_xor(mx, 32)); \
        const float m_new = fmaxf(m_run, mx); \
        const float alpha = __builtin_amdgcn_exp2f(m_run - m_new); \
        float ps = 0.f; \
        _Pragma("unroll") for (int i = 0; i < 16; ++i) { tt[i] = __builtin_amdgcn_exp2f(tt[i] - m_new); ps += tt[i]; } \
        l_run = l_run * alpha + ps; m_run = m_new; \
        _Pragma("unroll") for (int c = 0; c < 4; ++c) _Pragma("unroll") for (int i = 0; i < 16; ++i) o[c][i] *= alpha; \
        _Pragma("unroll") for (int s2 = 0; s2 < 2; ++s2) { \
            u32x4 pw; pw.x = cvt_pk_bf16(tt[8 * s2 + 0], tt[8 * s2 + 1]); pw.y = cvt_pk_bf16(tt[8 * s2 + 2], tt[8 * s2 + 3]); pw.z = cvt_pk_bf16(tt[8 * s2 + 4], tt[8 * s2 + 5]); pw.w = cvt_pk_bf16(tt[8 * s2 + 6], tt[8 * s2 + 7]); \
            const bf16x8 pb = __builtin_bit_cast(bf16x8, pw); \
            _Pragma("unroll") for (int c = 0; c < 4; ++c) { \
                const LAS unsigned char* vp = Vb + (16 * s2 + 4 * hh + trq) * AT_VROW + (32 * c + 16 * blk) * 2 + 8 * trp; \
                const s16x4 lo = vtr(vp), hi = vtr(vp + 8 * AT_VROW); \
                const bf16x8 vf = {lo[0], lo[1], lo[2], lo[3], hi[0], hi[1], hi[2], hi[3]}; \
                o[c] = MFMA32(vf, pb, o[c]); } } } while (0)
    AT_LOAD(A, kb_lo);
    if (kb_lo + 1 <= kb_hi) AT_LOAD(B, kb_lo + 1);
    AT_WRITE(A, 0);
    LDS_BARRIER();
    if (kb_lo + 2 <= kb_hi) AT_LOAD(A, kb_lo + 2);
    for (int kb = kb_lo; ; kb += 2) {
        AT_COMPUTE(kb, 0);
        if (kb + 1 <= kb_hi) AT_WRITE(B, 1);
        LDS_BARRIER();
        if (kb + 1 > kb_hi) break;
        if (kb + 3 <= kb_hi) AT_LOAD(B, kb + 3);
        AT_COMPUTE(kb + 1, 1);
        if (kb + 2 <= kb_hi) AT_WRITE(A, 0);
        LDS_BARRIER();
        if (kb + 2 > kb_hi) break;
        if (kb + 4 <= kb_hi) AT_LOAD(A, kb + 4);
    }
#undef AT_LOAD
#undef AT_SCALE
#undef AT_WRITE
#undef AT_COMPUTE
    const float lt = l_run + __shfl_xor(l_run, 32);
    const float inv = 1.0f / lt;
    float ss = 0.f;
#pragma unroll
    for (int c = 0; c < 4; ++c)
#pragma unroll
        for (int i = 0; i < 16; ++i) { o[c][i] *= inv; ss += o[c][i] * o[c][i]; }
    ss += __shfl_xor(ss, 32);
    LAS float* red = (LAS float*)(lds + AT_RED);
    if (hh == 0) red[hq * 32 + qi] = ss;
    LDS_BARRIER();
    float tot = 0.f;
#pragma unroll
    for (int h = 0; h < 8; ++h) tot += red[h * 32 + qi];
    const float ra = rsqrtf(tot * (1.0f / 1024.0f) + EPS);
    bf16_t* op = MIX + qrow * DM + hq * 128;
#pragma unroll
    for (int c = 0; c < 4; ++c)
#pragma unroll
        for (int g = 0; g < 4; ++g) {
            u32x2 w; w.x = cvt_pk_bf16(o[c][4 * g] * ra, o[c][4 * g + 1] * ra); w.y = cvt_pk_bf16(o[c][4 * g + 2] * ra, o[c][4 * g + 3] * ra);
            *(u32x2*)(op + 32 * c + 8 * g + 4 * hh) = w;
        }
    LDS_BARRIER();
}

constexpr int SG_ROW = 288, SG_BUF = 128 * SG_ROW, SG_STAT = 2 * SG_BUF, SG_RED = SG_STAT + 128 * 8, SG_LN = SG_RED + 1024;
__device__ __forceinline__ void sgu_unit(LAS unsigned char* lds, int unit, const bf16_t* GU, const bf16_t* GV, const float* gvs, const float* lng, const float* lnb,
                                         const bf16_t* WS, const float* rsw, const float* bs, bf16_t* MIX, int wv) {
    const int tid = fresh_tid(wv);
    const int lane = tid & 63, wid = __builtin_amdgcn_readfirstlane(tid >> 6), pi = lane & 31, hh = lane >> 5;
    const int bc = unit >> 1, ph = unit & 1;
    const size_t rowbase = (size_t)bc * 128;
    LAS f32x2* stat = (LAS f32x2*)(lds + SG_STAT);
    const int spart = tid & 15, sq = tid >> 4;
    const bf16_t* gvp = GV + (rowbase + sq) * 1024 + 8 * spart;
    u32x4 gvr[4];
#define SG_LOADGV(h) do { _Pragma("unroll") for (int i = 0; i < 4; ++i) gvr[i] = *(const u32x4*)(gvp + (size_t)(32 * i) * 1024 + (h) * 128); } while (0)
    SG_LOADGV(0);
    {
        const f32x4 t4 = (tid < 256) ? *(const f32x4*)(lng + 4 * tid) : *(const f32x4*)(lnb + 4 * (tid - 256));
        *(LAS f32x4*)(lds + SG_LN + 16 * tid) = t4;
    }
    if (tid < 128) {
        const f32x4* p = (const f32x4*)(gvs + (rowbase + tid) * 32);
        float s1 = 0.f, s2 = 0.f;
#pragma unroll
        for (int i = 0; i < 8; ++i) { const f32x4 v = p[i]; s1 += v.x + v.z; s2 += v.y + v.w; }
        const float mu = s1 * (1.0f / 1024.0f);
        const float var = s2 * (1.0f / 1024.0f) - mu * mu;
        stat[tid] = (f32x2){mu, rsqrtf(fmaxf(var, 0.f) + EPS)};
    }
    LDS_BARRIER();
    const int psub = wid & 1, dsub = wid >> 1;
    const int prow = ph * 64 + psub * 32 + pi;
    const int trq = (lane & 15) >> 2, trp = lane & 3, blk = (lane >> 4) & 1;
    const bf16_t* wp = WS + (size_t)prow * 128 + 8 * hh;
    unsigned accp[8][8];
#pragma unroll
    for (int h = 0; h < 8; ++h) {
        f32x16 acch;
#pragma unroll
        for (int i = 0; i < 16; ++i) acch[i] = 0.f;
        bf16x8 wf[8];
#pragma unroll
        for (int s_ = 0; s_ < 8; ++s_) wf[s_] = *(const bf16x8*)(wp + (size_t)h * 128 * 128 + 16 * s_);
        LAS unsigned char* buf = lds + (h & 1) * SG_BUF;
#pragma unroll
        for (int i = 0; i < 4; ++i) {
            const int q = sq + 32 * i;
            const u32x4 v = gvr[i];
            const f32x2 st = stat[q];
            const float nm = -st.x * st.y;
            u32x4 w;
            w.x = cvt_pk_bf16(__builtin_fmaf(bf_lo(v.x), st.y, nm), __builtin_fmaf(bf_hi(v.x), st.y, nm));
            w.y = cvt_pk_bf16(__builtin_fmaf(bf_lo(v.y), st.y, nm), __builtin_fmaf(bf_hi(v.y), st.y, nm));
            w.z = cvt_pk_bf16(__builtin_fmaf(bf_lo(v.z), st.y, nm), __builtin_fmaf(bf_hi(v.z), st.y, nm));
            w.w = cvt_pk_bf16(__builtin_fmaf(bf_lo(v.w), st.y, nm), __builtin_fmaf(bf_hi(v.w), st.y, nm));
            *(LAS u32x4*)(buf + q * SG_ROW + spart * 16) = w;
        }
        if (h + 1 < 8) SG_LOADGV(h + 1);
        LDS_BARRIER();
#pragma unroll
        for (int s_ = 0; s_ < 8; ++s_) {
            const LAS unsigned char* vp = buf + (16 * s_ + 8 * hh + trq) * SG_ROW + (32 * dsub + 16 * blk) * 2 + 8 * trp;
            const s16x4 lo = vtr(vp), hi = vtr(vp + 4 * SG_ROW);
            const bf16x8 vf = {lo[0], lo[1], lo[2], lo[3], hi[0], hi[1], hi[2], hi[3]};
            acch = MFMA32(vf, wf[s_], acch);
            if (s_ & 1) __builtin_amdgcn_sched_barrier(0);
        }
#pragma unroll
        for (int k = 0; k < 8; ++k) accp[h][k] = cvt_pk_bf16(acch[2 * k], acch[2 * k + 1]);
    }
#undef SG_LOADGV
    const size_t orow = rowbase + prow;
    float ss = 0.f;
    u32x2 guv[8][4]; float bbv[8], rwv[8];
#pragma unroll
    for (int h = 0; h < 8; ++h) {
        bbv[h] = bs[h * 128 + prow]; rwv[h] = rsw[h * 128 + prow];
#pragma unroll
        for (int g = 0; g < 4; ++g) guv[h][g] = *(const u32x2*)(GU + orow * 1024 + h * 128 + 32 * dsub + 8 * g + 4 * hh);
    }
    const LAS float* lnl = (const LAS float*)(lds + SG_LN);
#pragma unroll
    for (int h = 0; h < 8; ++h) {
        const float bb = bbv[h], rw = rwv[h];
#pragma unroll
        for (int g = 0; g < 4; ++g) {
            const int d0 = h * 128 + 32 * dsub + 8 * g + 4 * hh;
            const u32x2 gu = guv[h][g];
            const f32x4 lg = *(const LAS f32x4*)(lnl + d0), lb = *(const LAS f32x4*)(lnl + 1024 + d0);
            const float o0 = bf_lo(gu.x) * (__builtin_fmaf(lg.x, bf_lo(accp[h][2 * g]), __builtin_fmaf(lb.x, rw, bb)));
            const float o1 = bf_hi(gu.x) * (__builtin_fmaf(lg.y, bf_hi(accp[h][2 * g]), __builtin_fmaf(lb.y, rw, bb)));
            const float o2 = bf_lo(gu.y) * (__builtin_fmaf(lg.z, bf_lo(accp[h][2 * g + 1]), __builtin_fmaf(lb.z, rw, bb)));
            const float o3 = bf_hi(gu.y) * (__builtin_fmaf(lg.w, bf_hi(accp[h][2 * g + 1]), __builtin_fmaf(lb.w, rw, bb)));
            ss += (o0 * o0 + o1 * o1) + (o2 * o2 + o3 * o3);
            accp[h][2 * g] = cvt_pk_bf16(o0, o1); accp[h][2 * g + 1] = cvt_pk_bf16(o2, o3);
        }
        __builtin_amdgcn_sched_barrier(0);
    }
    ss += __shfl_xor(ss, 32);
    LAS float* red = (LAS float*)(lds + SG_RED);
    if (hh == 0) red[dsub * 64 + psub * 32 + pi] = ss;
    LDS_BARRIER();
    const float tot = (red[psub * 32 + pi] + red[64 + psub * 32 + pi]) + (red[128 + psub * 32 + pi] + red[192 + psub * 32 + pi]);
    const float rs = rsqrtf(tot * (1.0f / 1024.0f) + EPS);
    bf16_t* op = MIX + orow * DM + 1024 + 32 * dsub;
#pragma unroll
    for (int h = 0; h < 8; ++h)
#pragma unroll
        for (int g = 0; g < 4; ++g) {
            u32x2 w; w.x = cvt_pk_bf16(bf_lo(accp[h][2 * g]) * rs, bf_hi(accp[h][2 * g]) * rs); w.y = cvt_pk_bf16(bf_lo(accp[h][2 * g + 1]) * rs, bf_hi(accp[h][2 * g + 1]) * rs);
            *(u32x2*)(op + h * 128 + 8 * g + 4 * hh) = w;
        }
    LDS_BARRIER();
}

__device__ __forceinline__ void fixup_phase(const bf16_t* HALO, const float* cw, const float* cb, bf16_t* ACT, int G, int wv) {
    constexpr int CH = DFF / 8;
    constexpr int NB = 3;
    const int total = (T / 64) * 2 * CH;
    const int tid = fresh_tid(wv);
    const u32x4 z = {0u, 0u, 0u, 0u};
    for (int it0 = blockIdx.x * 512 + tid; it0 < total; it0 += NB * G * 512) {
        u32x4 vc[NB][2], vp[NB][2], vn[NB][2];
#pragma unroll
        for (int b = 0; b < NB; ++b) {
            const int it = it0 + b * G * 512;
            if (it < total) {
                const int ch = it % CH, br = it / CH, sl = br >> 1, side = br & 1;
                const int row = sl * 64 + (side ? 63 : 0), pos = row & (SEQ - 1);
                const bf16_t* hc = HALO + (size_t)(4 * sl + (side ? 3 : 0)) * NUP;
                const bf16_t* hp = side ? HALO + (size_t)(4 * sl + 2) * NUP : (pos == 0 ? nullptr : HALO + (size_t)(4 * (sl - 1) + 3) * NUP);
                const bf16_t* hn = side ? (pos == SEQ - 1 ? nullptr : HALO + (size_t)(4 * (sl + 1)) * NUP) : HALO + (size_t)(4 * sl + 1) * NUP;
#pragma unroll
                for (int gu = 0; gu < 2; ++gu) {
                    const int col = gu * DFF + ch * 8;
                    vc[b][gu] = *(const u32x4*)(hc + col); vp[b][gu] = hp ? *(const u32x4*)(hp + col) : z; vn[b][gu] = hn ? *(const u32x4*)(hn + col) : z;
                }
            }
        }
#pragma unroll
        for (int b = 0; b < NB; ++b) {
            const int it = it0 + b * G * 512;
            if (it < total) {
                const int ch = it % CH, br = it / CH, sl = br >> 1, side = br & 1;
                const int row = sl * 64 + (side ? 63 : 0);
                const int j = ch * 8;
                float a[2][8];
#pragma unroll
                for (int gu = 0; gu < 2; ++gu) {
                    const int col = gu * DFF + j;
                    const f32x4 w0a = *(const f32x4*)(cw + col), w0b = *(const f32x4*)(cw + col + 4), w1a = *(const f32x4*)(cw + NUP + col), w1b = *(const f32x4*)(cw + NUP + col + 4);
                    const f32x4 w2a = *(const f32x4*)(cw + 2 * NUP + col), w2b = *(const f32x4*)(cw + 2 * NUP + col + 4), ba = *(const f32x4*)(cb + col), bb = *(const f32x4*)(cb + col + 4);
#pragma unroll
                    for (int e = 0; e < 4; ++e) {
                        const float w0l = e < 2 ? w0a[2 * e] : w0b[2 * e - 4], w0h = e < 2 ? w0a[2 * e + 1] : w0b[2 * e - 3];
                        const float w1l = e < 2 ? w1a[2 * e] : w1b[2 * e - 4], w1h = e < 2 ? w1a[2 * e + 1] : w1b[2 * e - 3];
                        const float w2l = e < 2 ? w2a[2 * e] : w2b[2 * e - 4], w2h = e < 2 ? w2a[2 * e + 1] : w2b[2 * e - 3];
                        const float bl = e < 2 ? ba[2 * e] : bb[2 * e - 4], bh = e < 2 ? ba[2 * e + 1] : bb[2 * e - 3];
                        a[gu][2 * e] = bl + w0l * bf_lo(vp[b][gu][e]) + w1l * bf_lo(vc[b][gu][e]) + w2l * bf_lo(vn[b][gu][e]);
                        a[gu][2 * e + 1] = bh + w0h * bf_hi(vp[b][gu][e]) + w1h * bf_hi(vc[b][gu][e]) + w2h * bf_hi(vn[b][gu][e]);
                    }
                }
                u32x4 w;
                w.x = cvt_pk_bf16(silu_f(a[0][0]) * a[1][0], silu_f(a[0][1]) * a[1][1]); w.y = cvt_pk_bf16(silu_f(a[0][2]) * a[1][2], silu_f(a[0][3]) * a[1][3]);
                w.z = cvt_pk_bf16(silu_f(a[0][4]) * a[1][4], silu_f(a[0][5]) * a[1][5]); w.w = cvt_pk_bf16(silu_f(a[0][6]) * a[1][6], silu_f(a[0][7]) * a[1][7]);
                *(u32x4*)(ACT + (size_t)row * DFF + j) = w;
            }
        }
    }
}

#define XB_TMO      128
#define XB_XCNT(j)  (256  + 64 * (j))
#define XB_XSUB(j)  (1280 + 64 * (j))
#define XB_XGEN(j)  (2304 + 64 * (j))
#define XB_TOP      3328
#define XB_TOPGEN   3392
#define XCD_BAR_WORDS 3456
#define XB_SPIN_CAP (1u << 18)
__device__ __forceinline__ unsigned xb_ld(unsigned* p)              { return __hip_atomic_load(p, __ATOMIC_RELAXED, __HIP_MEMORY_SCOPE_AGENT); }
__device__ __forceinline__ unsigned xb_add(unsigned* p, unsigned v) { return __hip_atomic_fetch_add(p, v, __ATOMIC_RELAXED, __HIP_MEMORY_SCOPE_AGENT); }
__device__ __forceinline__ unsigned xb_xcc_id() { return (unsigned)__builtin_amdgcn_s_getreg((3 << 11) | 20) & 0xFu; }
#define XB_SPIN(cond, bar) do { unsigned _sp = 0; while (cond) { __builtin_amdgcn_s_sleep(1); \
    if ((++_sp & 255u) == 0u) { if (xb_ld(&(bar)[XB_TMO])) break; if (_sp > XB_SPIN_CAP) { atomicAdd(&(bar)[XB_TMO], 1u); break; } } } } while (0)
struct XcdBarrier { unsigned* bar; unsigned x; volatile LAS unsigned* st; };
__device__ __forceinline__ XcdBarrier xcd_barrier_post(unsigned* bar, volatile LAS unsigned* st) {
    XcdBarrier b; b.bar = bar; b.x = xb_xcc_id(); b.st = st;
    if (threadIdx.x == 0) (void)xb_add(&bar[XB_XCNT(b.x)], 1u);
    return b;
}
__device__ __forceinline__ void xcd_barrier_complete(unsigned* bar, unsigned x, unsigned& nloc, unsigned& nx) {
    const unsigned G = gridDim.x * gridDim.y * gridDim.z;
    unsigned sum, cnt, mine, sp = 0u;
    for (;;) {
        sum = 0u; cnt = 0u; mine = 0u;
#pragma unroll
        for (unsigned j = 0; j < 16; ++j) { const unsigned c = xb_ld(&bar[XB_XCNT(j)]); sum += c; cnt += (c > 0u) ? 1u : 0u; mine = (j == x) ? c : mine; }
        if (sum == G) break;
        __builtin_amdgcn_s_sleep(1);
        if ((++sp & 255u) == 0u) { if (xb_ld(&bar[XB_TMO])) break; if (sp > XB_SPIN_CAP) { atomicAdd(&bar[XB_TMO], 1u); break; } }
    }
    nloc = mine > 0u ? mine : 1u; nx = cnt > 0u ? cnt : 1u;
}
__device__ __forceinline__ void xcd_barrier(const XcdBarrier& b) {
    asm volatile("s_waitcnt vmcnt(0)" ::: "memory");
    __syncthreads();
    const unsigned lane = (unsigned)lane_id_fresh();
    bool leader = false;
    if (lane == 0) { const unsigned t = __hip_atomic_fetch_add((LAS unsigned*)(b.st + 2), 1u, __ATOMIC_RELAXED, __HIP_MEMORY_SCOPE_WORKGROUP); leader = (t & 7u) == 0u; }
    if (leader) {
        unsigned* bar = b.bar; unsigned x = b.x; asm volatile("" : "+s"(x));
        __builtin_amdgcn_s_waitcnt(0);
        unsigned nloc = b.st[0], nx = b.st[1];
        if (nloc == 0u) { xcd_barrier_complete(bar, x, nloc, nx); b.st[0] = nloc; b.st[1] = nx; }
        const unsigned old = xb_add(&bar[XB_XSUB(x)], 1u);
        const unsigned gen = old / nloc;
        if (old + 1u == (gen + 1u) * nloc) {
            __builtin_amdgcn_fence(__ATOMIC_RELEASE, "agent");
            asm volatile("s_waitcnt vmcnt(0)" ::: "memory");
            const unsigned og = xb_add(&bar[XB_TOP], 1u);
            const unsigned tg = og / nx;
            if (og + 1u == (tg + 1u) * nx) xb_add(&bar[XB_TOPGEN], 1u);
            else XB_SPIN(xb_ld(&bar[XB_TOPGEN]) == tg, bar);
            __builtin_amdgcn_fence(__ATOMIC_ACQUIRE, "agent");
            xb_add(&bar[XB_XGEN(x)], 1u);
            asm volatile("s_waitcnt vmcnt(0)" ::: "memory");
        } else {
            XB_SPIN(xb_ld(&bar[XB_XGEN(x)]) == gen, bar);
            __builtin_amdgcn_fence(__ATOMIC_ACQUIRE, "agent");
            asm volatile("s_waitcnt vmcnt(0)" ::: "memory");
        }
    }
    __syncthreads();
}

#ifndef PROBE_SEL
#define PROBE_SEL 0
#endif
#if PROBE_SEL
#define TIC(sel) do { if (PROBE_SEL == (sel)) { asm volatile("s_waitcnt vmcnt(0) lgkmcnt(0)" ::: "memory"); probe_t0 = __builtin_amdgcn_s_memrealtime(); } } while (0)
#define TOC(sel) do { if (PROBE_SEL == (sel)) { asm volatile("s_waitcnt vmcnt(0) lgkmcnt(0)" ::: "memory"); probe_acc += __builtin_amdgcn_s_memrealtime() - probe_t0; } } while (0)
#else
#define TIC(sel) do {} while (0)
#define TOC(sel) do {} while (0)
#endif
typedef const __attribute__((address_space(4))) Args* ArgsP;
#define FRESH_ARGS() ArgsP ap = (ArgsP)__builtin_amdgcn_kernarg_segment_ptr(); asm volatile("" : "+s"(ap)); unsigned char* ws = ap->ws; const int G = gridDim.x, bx = blockIdx.x
__global__ void __launch_bounds__(512, 2) fwd_megakernel(Args a_unused) {
    extern __shared__ __attribute__((aligned(16))) unsigned char lds_raw[];
    LAS unsigned char* lds = (LAS unsigned char*)lds_raw;
    cg::grid_group grid = cg::this_grid();
#if PROBE_SEL
    unsigned long long probe_t0 = 0, probe_acc = 0;
#endif
    const int wv = __builtin_amdgcn_readfirstlane(threadIdx.x >> 6);
    volatile LAS unsigned* bst = (volatile LAS unsigned*)(lds + LDS_BYTES - 16);
    if (threadIdx.x < 4) bst[threadIdx.x] = 0u;
    __syncthreads();
    XcdBarrier xbar;
    { FRESH_ARGS(); xbar = xcd_barrier_post((unsigned*)(ws + OFF_CTL), bst); (void)G; (void)bx; }
    {
        FRESH_ARGS();
        Args a;
#pragma unroll
        for (int i = 0; i < 18; ++i) a.in[i] = ap->in[i];
        a.out = ap->out; a.ws = ws;
        TIC(9);
#ifndef NO_P0
        prologue(a, lds, G, wv);
#endif
        TOC(9);
    }
    TIC(1); grid.sync(); TOC(1);

    for (int l = 0; l < DEPTH; ++l) {
        for (int part = 0; part < 2; ++part) {
            FRESH_ARGS();
            const bool split = (G == 256);
            if (part == 1 && !split) break;
            pg8::Gemm g{(const bf16_t*)(ws + OFF_XB), (const bf16_t*)(ws + OFF_WIN + l * SZ_WIN), T, NIN, DM}; pg8::StaticOrder S; S.init(T, NIN, G, bx);
            if (split) { S.Lbase = part ? 768 : 0; S.Lend = part ? 896 : 768; }
            EpiIn E{(const float*)(ws + OFF_XSS), ap->in[3] + l * 128, ap->in[4] + l * 128, (const float*)(ws + OFF_COS), (const float*)(ws + OFF_SIN),
                    (bf16_t*)(ws + OFF_Q), (bf16_t*)(ws + OFF_K), (bf16_t*)(ws + OFF_V), (bf16_t*)(ws + OFF_GU), (bf16_t*)(ws + OFF_GV),
                    (float*)(ws + OFF_QSS), (float*)(ws + OFF_KSS), (float*)(ws + OFF_GVS)};
            TIC(7);
#ifndef NO_IN
            pg8::gemm_phase(lds, g, S, E, wv);
#endif
            TOC(7);
            if (part == 0) { TIC(1); xcd_barrier(xbar); TOC(1); }
        }
        {
            FRESH_ARGS();
            TIC(2);
#ifndef NO_ATT
            if (G == 256) {
                const int heavy = bx >= 128;
                const int idx = (bx % 8) * 16 + (heavy ? (bx - 128) / 8 : bx / 8);
                const int u0 = heavy ? 3 * idx : 384 + idx, nu = heavy ? 3 : 1;
                for (int u = u0; u < u0 + nu; ++u) attn_unit(lds, u, ap->in[5] + l * 8, (const bf16_t*)(ws + OFF_Q), (const bf16_t*)(ws + OFF_K), (const bf16_t*)(ws + OFF_V),
                                                             (const float*)(ws + OFF_QSS), (const float*)(ws + OFF_KSS), (bf16_t*)(ws + OFF_MIX), wv);
            } else {
                for (int u = bx; u < 512; u += G) attn_unit(lds, u, ap->in[5] + l * 8, (const bf16_t*)(ws + OFF_Q), (const bf16_t*)(ws + OFF_K), (const bf16_t*)(ws + OFF_V),
                                                            (const float*)(ws + OFF_QSS), (const float*)(ws + OFF_KSS), (bf16_t*)(ws + OFF_MIX), wv);
            }
#endif
            TOC(2);
        }
        TIC(1); xcd_barrier(xbar); TOC(1);
        {
            FRESH_ARGS();
            TIC(3);
#ifndef NO_SGU
            for (int u = bx; u < 256; u += G) sgu_unit(lds, u, (const bf16_t*)(ws + OFF_GU), (const bf16_t*)(ws + OFF_GV), (const float*)(ws + OFF_GVS), ap->in[6] + l * 1024, ap->in[7] + l * 1024,
                                                       (const bf16_t*)(ws + OFF_WS) + (size_t)l * 8 * 128 * 128, (const float*)(ws + OFF_RSW) + l * 1024, ap->in[9] + l * 1024, (bf16_t*)(ws + OFF_MIX), wv);
#endif
            TOC(3);
        }
        TIC(1); xcd_barrier(xbar); TOC(1);
        {
            FRESH_ARGS();
            pg8::Gemm g{(const bf16_t*)(ws + OFF_MIX), (const bf16_t*)(ws + OFF_WO + l * SZ_WO), T, DM, DM}; pg8::StaticOrder S; S.init(T, DM, G, bx);
            EpiRes E{nullptr, (bf16_t*)(ws + OFF_XB), (float*)(ws + OFF_XSS)};
            TIC(5);
#ifndef NO_WO
            pg8::gemm_phase(lds, g, S, E, wv);
#endif
            TOC(5);
        }
        TIC(1); xcd_barrier(xbar); TOC(1);
        {
            FRESH_ARGS();
            pg8::Gemm g{(const bf16_t*)(ws + OFF_XB), (const bf16_t*)(ws + OFF_WUP + l * SZ_WUP), T, NUP, DM}; pg8::StaticOrder S; S.init(T, NUP, G, bx);
            EpiUp E{(const float*)(ws + OFF_XSS), ap->in[15] + (size_t)l * 3 * NUP, ap->in[16] + (size_t)l * NUP, (bf16_t*)(ws + OFF_ACT), (bf16_t*)(ws + OFF_HALO)};
            TIC(8);
#ifndef NO_UP
            pg8::gemm_phase(lds, g, S, E, wv);
#endif
            TOC(8);
        }
        TIC(1); xcd_barrier(xbar); TOC(1);
        {
            FRESH_ARGS();
            TIC(4);
#ifndef NO_FIX
            fixup_phase((const bf16_t*)(ws + OFF_HALO), ap->in[15] + (size_t)l * 3 * NUP, ap->in[16] + (size_t)l * NUP, (bf16_t*)(ws + OFF_ACT), G, wv);
#endif
            TOC(4);
        }
        TIC(1); xcd_barrier(xbar); TOC(1);
        {
            FRESH_ARGS();
            pg8::Gemm g{(const bf16_t*)(ws + OFF_ACT), (const bf16_t*)(ws + OFF_WDN + l * SZ_WDN), T, DM, DFF}; pg8::StaticOrder S; S.init(T, DM, G, bx);
            EpiRes E{l + 1 == DEPTH ? ap->out : nullptr, (bf16_t*)(ws + OFF_XB), (float*)(ws + OFF_XSS)};
            TIC(6);
#ifndef NO_DN
            pg8::gemm_phase(lds, g, S, E, wv);
#endif
            TOC(6);
        }
        if (l + 1 < DEPTH) { TIC(1); xcd_barrier(xbar); TOC(1); }
    }
#if PROBE_SEL
    { const unsigned long long until = __builtin_amdgcn_s_memrealtime() + 4ull * probe_acc; while (__builtin_amdgcn_s_memrealtime() < until) __builtin_amdgcn_s_sleep(16); }
#endif
}

extern "C" void kernel_launch(void* const* d_in, const int* in_sizes, int n_in, void* d_out, int out_size, void* d_ws, size_t ws_size, hipStream_t stream) {
    static int grid = 0;
    if (grid == 0) {
        if (n_in != 18 || out_size != T * DM || ws_size < WS_END) { fprintf(stderr, "kernel_launch: unexpected problem (n_in %d, out %d, ws %zu < %zu)\n", n_in, out_size, ws_size, (size_t)WS_END); grid = -1; return; }
        int dev = 0, cus = 0, per_cu = 0;
        hipGetDevice(&dev);
        hipDeviceGetAttribute(&cus, hipDeviceAttributeMultiprocessorCount, dev);
        hipFuncSetAttribute((const void*)fwd_megakernel, hipFuncAttributeMaxDynamicSharedMemorySize, LDS_BYTES);
        hipOccupancyMaxActiveBlocksPerMultiprocessor(&per_cu, (const void*)fwd_megakernel, 512, LDS_BYTES);
        if (per_cu < 1) per_cu = 1;
        grid = cus * per_cu;
        (void)hipGetLastError();
    }
    if (grid < 0) return;
    Args a{};
    for (int i = 0; i < 18; ++i) a.in[i] = (const float*)d_in[i];
    a.out = (float*)d_out; a.ws = (unsigned char*)d_ws;
    (void)hipMemsetAsync((unsigned char*)d_ws + OFF_CTL, 0, CTL_BYTES, stream);
    void* args[] = {&a};
    hipError_t e = hipLaunchCooperativeKernel((const void*)fwd_megakernel, dim3(grid), dim3(512), args, LDS_BYTES, stream);
    if (e != hipSuccess) fprintf(stderr, "cooperative launch failed: %s (grid %d)\n", hipGetErrorString(e), grid);
}
```

```cpp
#include <hip/hip_runtime.h>
#include <hip/hip_cooperative_groups.h>
#include <cstdio>
#include <cstdint>
namespace cg = cooperative_groups;

#define LAS __attribute__((address_space(3)))
typedef unsigned short bf16_t;
typedef short bf16x8 __attribute__((ext_vector_type(8)));
typedef short s16x4 __attribute__((ext_vector_type(4)));
typedef float f32x4 __attribute__((ext_vector_type(4)));
typedef float f32x2 __attribute__((ext_vector_type(2)));
typedef float f32x16 __attribute__((ext_vector_type(16)));
typedef unsigned u32x4 __attribute__((ext_vector_type(4)));
typedef unsigned u32x2 __attribute__((ext_vector_type(2)));
typedef __bf16 bf16x2_t __attribute__((ext_vector_type(2)));

constexpr int T = 16384, SEQ = 2048, DM = 2048, NIN = 3584, DFF = 5632, NUP = 11264, DEPTH = 2;
constexpr float EPS = 1e-6f;
constexpr float LOG2E = 1.4426950408889634f;

constexpr size_t SZ_WIN = (size_t)NIN * DM * 2, SZ_WO = (size_t)DM * DM * 2, SZ_WUP = (size_t)NUP * DM * 2, SZ_WDN = (size_t)DM * DFF * 2;
constexpr size_t OFF_WIN = 0;
constexpr size_t OFF_WO = OFF_WIN + DEPTH * SZ_WIN;
constexpr size_t OFF_WUP = OFF_WO + DEPTH * SZ_WO;
constexpr size_t OFF_WDN = OFF_WUP + DEPTH * SZ_WUP;
constexpr size_t OFF_WS = OFF_WDN + DEPTH * SZ_WDN;
constexpr size_t OFF_COS = OFF_WS + (size_t)DEPTH * 8 * 128 * 128 * 2;
constexpr size_t OFF_SIN = OFF_COS + (size_t)SEQ * 64 * 4;
constexpr size_t OFF_XB = OFF_SIN + (size_t)SEQ * 64 * 4;
constexpr size_t OFF_XSS = OFF_XB + (size_t)T * DM * 2;
constexpr size_t OFF_Q = OFF_XSS + (size_t)T * 32 * 4;
constexpr size_t OFF_K = OFF_Q + (size_t)T * 1024 * 2;
constexpr size_t OFF_V = OFF_K + (size_t)T * 256 * 2;
constexpr size_t OFF_GU = OFF_V + (size_t)T * 256 * 2;
constexpr size_t OFF_GV = OFF_GU + (size_t)T * 1024 * 2;
constexpr size_t OFF_MIX = OFF_GV + (size_t)T * 1024 * 2;
constexpr size_t OFF_QSS = OFF_MIX + (size_t)T * DM * 2;
constexpr size_t OFF_KSS = OFF_QSS + (size_t)T * 32 * 4;
constexpr size_t OFF_GVS = OFF_KSS + (size_t)T * 8 * 4;
constexpr size_t OFF_ACT = OFF_GVS + (size_t)T * 32 * 4;
constexpr size_t OFF_HALO = OFF_ACT + (size_t)T * DFF * 2;
constexpr size_t OFF_RSW = OFF_HALO + (size_t)(T / 64 * 4) * NUP * 2;
constexpr size_t OFF_CTL = OFF_RSW + (size_t)DEPTH * 8 * 128 * 4;
constexpr size_t CTL_BYTES = 16384;
constexpr size_t WS_END = OFF_CTL + CTL_BYTES;

constexpr int LDS_BYTES = 147456;

__device__ __forceinline__ unsigned cvt_pk_bf16(float lo, float hi) { f32x2 v = {lo, hi}; bf16x2_t b = __builtin_convertvector(v, bf16x2_t); return __builtin_bit_cast(unsigned, b); }
__device__ __forceinline__ float bf_lo(unsigned u) { return __uint_as_float(u << 16); }
__device__ __forceinline__ float bf_hi(unsigned u) { return __uint_as_float(u & 0xffff0000u); }
__device__ __forceinline__ float gelu_tanh(float x) {
    const float u = 0.7978845608028654f * (x + 0.044715f * x * x * x);
    const float e = __builtin_amdgcn_exp2f(-2.0f * LOG2E * u);
    return x * __builtin_amdgcn_rcpf(1.0f + e);
}
__device__ __forceinline__ float silu_f(float x) { const float e = __builtin_amdgcn_exp2f(-LOG2E * x); return x * __builtin_amdgcn_rcpf(1.0f + e); }
__device__ __forceinline__ float dot4(f32x4 a) { return (a.x * a.x + a.y * a.y) + (a.z * a.z + a.w * a.w); }
__device__ __forceinline__ float sum4(f32x4 a) { return (a.x + a.y) + (a.z + a.w); }
__device__ __forceinline__ int crow(int r, int hi) { return (r & 3) + 8 * (r >> 2) + 4 * hi; }
__device__ __forceinline__ float wave_sum(float v) {
#pragma unroll
    for (int o = 1; o < 64; o <<= 1) v += __shfl_xor(v, o);
    return v;
}

__device__ __forceinline__ float dpp_prev(float v) { return __int_as_float(__builtin_amdgcn_mov_dpp(__float_as_int(v), 0x121, 0xF, 0xF, false)); }
__device__ __forceinline__ float dpp_next(float v) { return __int_as_float(__builtin_amdgcn_mov_dpp(__float_as_int(v), 0x12F, 0xF, 0xF, false)); }

__device__ __forceinline__ int lane_id_fresh() { int l; asm volatile("v_mbcnt_lo_u32_b32 %0, -1, 0\n\tv_mbcnt_hi_u32_b32 %0, -1, %0" : "=v"(l)); return l; }
__device__ __forceinline__ int fresh_tid(int wv) { return wv * 64 + lane_id_fresh(); }

namespace pg8 {
constexpr int BM = 256, BK = 64, HALF = 128, HTB = HALF * BK * 2, STAGE_BYTES = 8 * HTB, NXCD = 8, WGM = 8;
__host__ __device__ __forceinline__ int lds_byte(int r, int c) { const int st = (r >> 4) * 2 + (c >> 5), rr = r & 15, cc = c & 31, ob = rr * 64 + cc * 2; return st * 1024 + (ob ^ (((ob >> 9) & 1) << 5)); }
__host__ __device__ __forceinline__ void stage_rc(int b, int& R, int& C) { const int st = b / 1024, sb = b % 1024, swz = sb ^ (((sb >> 9) & 1) << 5); R = (st >> 1) * 16 + swz / 64; C = (st & 1) * 32 + (swz % 64) / 2; }
__host__ __device__ __forceinline__ int perm32(int rho) { const int n = rho >> 4, i = rho & 15; return 8 * (i >> 2) + 4 * n + (i & 3); }
struct Unit { int pm, pn; };
struct Gemm { const bf16_t* A; const bf16_t* Bt; int M, N, K; };
struct StaticOrder {
    int nM, nN, nwg, G, c, Lbase, Lend;
    __host__ __device__ void init(int M, int N, int G_, int c_) { nM = M / BM; nN = N / BM; nwg = nM * nN; G = G_; c = c_; Lbase = 0; Lend = nwg; }
    __host__ __device__ bool next(int i, Unit& u) const {
        const long L = (long)Lbase + (long)i * G + c; if (L >= Lend) return false;
        int wgid = (int)L; { const int q = nwg / NXCD, r = nwg % NXCD, xcd = wgid % NXCD, off = wgid / NXCD; wgid = (xcd < r ? xcd * (q + 1) : r * (q + 1) + (xcd - r) * q) + off; }
        const int nig = WGM * nN, gid = wgid / nig, fm = gid * WGM, gsz = (nM - fm) < WGM ? (nM - fm) : WGM;
        u.pm = fm + ((wgid % nig) % gsz); u.pn = (wgid % nig) / gsz; return true;
    }
};

template <class Epi, class Sched>
__device__ __forceinline__ void gemm_phase(LAS unsigned char* lds, const Gemm g, const Sched& S, const Epi& E, int wv) {
    const int tid = fresh_tid(wv);
    const int wid = __builtin_amdgcn_readfirstlane(tid >> 6), lane = tid & 63, wr = wid >> 2, wc = wid & 3, fr = lane & 15, fq = lane >> 4;
    const int K = g.K, nt = K / BK;
    unsigned voffA[2], voffB[2];
#pragma unroll
    for (int i = 0; i < 2; ++i) { int R, C; stage_rc(tid * 16 + i * 8192, R, C); const int Rb = (R & ~31) + perm32(R & 31);
        voffA[i] = (unsigned)(R * K + C) * 2u; voffB[i] = (unsigned)(Rb * K + C) * 2u; }
    const size_t kstep = (size_t)(BK * 2);
    const size_t hstep = (size_t)HALF * K * 2;
    const size_t tstep = 2 * hstep;
    const unsigned ldsw = (unsigned)wid * 1024u;
    const int aoff = lds_byte(wr * 64 + fr, fq * 8), boff = lds_byte(wc * 32 + fr, fq * 8);
#define PG8_SA(b, h) (((b) * 2 + (h)) * HTB)
#define PG8_SB(b, h) ((4 + (b) * 2 + (h)) * HTB)
#define PG8_STAGE(bufoff, gbase, voff) do { _Pragma("unroll") for (int _i = 0; _i < 2; ++_i) \
        __builtin_amdgcn_global_load_lds((const unsigned*)((const char*)(gbase) + (voff)[_i]), (LAS unsigned*)(lds + (bufoff) + ldsw + _i * 8192), 16, 0, 0); } while (0)
#define PG8_LDA(dst, b, h) do { _Pragma("unroll") for (int m = 0; m < 4; ++m) _Pragma("unroll") for (int k = 0; k < 2; ++k) dst[m][k] = *(const LAS bf16x8*)(lds + PG8_SA(b, h) + aoff + m * 2048 + k * 1024); } while (0)
#define PG8_LDB(dst, b, h) do { _Pragma("unroll") for (int n = 0; n < 2; ++n) _Pragma("unroll") for (int k = 0; k < 2; ++k) dst[n][k] = *(const LAS bf16x8*)(lds + PG8_SB(b, h) + boff + n * 2048 + k * 1024); } while (0)
#define PG8_MMA(ai, bj, At, Bt) do { __builtin_amdgcn_s_setprio(1); _Pragma("unroll") for (int m = 0; m < 4; ++m) _Pragma("unroll") for (int n = 0; n < 2; ++n) _Pragma("unroll") for (int k = 0; k < 2; ++k) \
        acc[ai][bj][m][n] = __builtin_amdgcn_mfma_f32_16x16x32_bf16(Bt[n][k], At[m][k], acc[ai][bj][m][n], 0, 0, 0); __builtin_amdgcn_s_setprio(0); } while (0)
#define PG8_WAIT_V(n) asm volatile("s_waitcnt vmcnt(" #n ")" ::: "memory")
#define PG8_WAIT_L(n) asm volatile("s_waitcnt lgkmcnt(" #n ")" ::: "memory")
#define PG8_BAR __builtin_amdgcn_s_barrier()
#define PG8_SCHED __builtin_amdgcn_sched_barrier(0)
    Unit cur, nxt; int ui = 0;
    if (!S.next(0, cur)) return;
    f32x4 acc[2][2][4][2];
#pragma unroll
    for (int a = 0; a < 2; ++a)
#pragma unroll
        for (int b = 0; b < 2; ++b)
#pragma unroll
            for (int m = 0; m < 4; ++m)
#pragma unroll
                for (int n = 0; n < 2; ++n) acc[a][b][m][n] = (f32x4){0.f, 0.f, 0.f, 0.f};
    bf16x8 At[4][2], B0[2][2], B1[2][2];
    const char* cA = (const char*)g.A + (size_t)cur.pm * tstep; const char* cB = (const char*)g.Bt + (size_t)cur.pn * tstep;
    PG8_STAGE(PG8_SB(0, 0), cB, voffB); PG8_STAGE(PG8_SB(0, 1), cB + hstep, voffB); PG8_STAGE(PG8_SA(0, 0), cA, voffA); PG8_STAGE(PG8_SA(0, 1), cA + hstep, voffA);
    if (wr == 1) PG8_BAR;
    PG8_WAIT_V(2); PG8_BAR;
    PG8_STAGE(PG8_SB(1, 0), cB + kstep, voffB); PG8_STAGE(PG8_SA(1, 0), cA + kstep, voffA); PG8_STAGE(PG8_SB(1, 1), cB + hstep + kstep, voffB);
    PG8_WAIT_V(6); PG8_BAR;
    for (;;) {
        const bool has_next = S.next(ui + 1, nxt);
        const char* nA = has_next ? (const char*)g.A + (size_t)nxt.pm * tstep : cA; const char* nB = has_next ? (const char*)g.Bt + (size_t)nxt.pn * tstep : cB;
        for (int t = 0; t < nt; t += 2) {
            const bool last = (t == nt - 2);
            const char* a1 = cA + (size_t)(t + 1) * kstep;
            const char* a2 = last ? nA : cA + (size_t)(t + 2) * kstep; const char* b2 = last ? nB : cB + (size_t)(t + 2) * kstep;
            const char* a3 = a2 + kstep; const char* b3 = b2 + kstep;
            PG8_LDB(B0, 0, 0); PG8_LDB(B1, 0, 1); PG8_SCHED; PG8_LDA(At, 0, 0); PG8_STAGE(PG8_SA(1, 1), a1 + hstep, voffA);
            PG8_WAIT_V(8); PG8_WAIT_L(0); PG8_BAR; PG8_MMA(0, 0, At, B0); PG8_MMA(0, 1, At, B1); PG8_BAR; PG8_SCHED;
            PG8_LDA(At, 0, 1); PG8_STAGE(PG8_SB(0, 0), b2, voffB); PG8_STAGE(PG8_SB(0, 1), b2 + hstep, voffB); PG8_STAGE(PG8_SA(0, 0), a2, voffA);
            PG8_WAIT_V(8); PG8_WAIT_L(0); PG8_BAR; PG8_MMA(1, 0, At, B0); PG8_MMA(1, 1, At, B1); PG8_BAR; PG8_SCHED;
            PG8_LDB(B0, 1, 0); PG8_LDB(B1, 1, 1); PG8_SCHED; PG8_LDA(At, 1, 0); PG8_STAGE(PG8_SA(0, 1), a2 + hstep, voffA);
            PG8_WAIT_V(8); PG8_WAIT_L(0); PG8_BAR; PG8_MMA(0, 0, At, B0); PG8_MMA(0, 1, At, B1); PG8_BAR; PG8_SCHED;
            PG8_LDA(At, 1, 1); PG8_STAGE(PG8_SB(1, 0), b3, voffB); PG8_STAGE(PG8_SB(1, 1), b3 + hstep, voffB); PG8_STAGE(PG8_SA(1, 0), a3, voffA);
            PG8_WAIT_V(8); PG8_WAIT_L(0); PG8_BAR; PG8_MMA(1, 0, At, B0); PG8_MMA(1, 1, At, B1); PG8_BAR; PG8_SCHED;
        }
        if (wr == 0) PG8_BAR;
        E(acc, cur, wr, wc, fr, fq);
        if (!has_next) break;
#pragma unroll
        for (int a = 0; a < 2; ++a)
#pragma unroll
            for (int b = 0; b < 2; ++b)
#pragma unroll
                for (int m = 0; m < 4; ++m)
#pragma unroll
                    for (int n = 0; n < 2; ++n) acc[a][b][m][n] = (f32x4){0.f, 0.f, 0.f, 0.f};
        cur = nxt; cA = nA; cB = nB; ++ui;
        if (wr == 1) PG8_BAR;
    }
    PG8_WAIT_V(0);
    PG8_BAR;
#undef PG8_SA
#undef PG8_SB
#undef PG8_STAGE
#undef PG8_LDA
#undef PG8_LDB
#undef PG8_MMA
#undef PG8_WAIT_V
#undef PG8_WAIT_L
#undef PG8_BAR
#undef PG8_SCHED
}
}
using pg8::Unit;

__device__ __forceinline__ void row_rstd(const float* xss, int row0, int fq, float (&r)[2][4]) {
    f32x4 a[8], b[8];
#pragma unroll
    for (int i = 0; i < 8; ++i) { const f32x4* p = (const f32x4*)(xss + (size_t)(row0 + 128 * (i >> 2) + 16 * (i & 3)) * 32 + 8 * fq); a[i] = p[0]; b[i] = p[1]; }
#pragma unroll
    for (int i = 0; i < 8; ++i) {
        float s = sum4(a[i]) + sum4(b[i]);
        s += __shfl_xor(s, 16); s += __shfl_xor(s, 32);
        r[i >> 2][i & 3] = rsqrtf(s * (1.0f / DM) + EPS);
    }
    asm volatile("" ::: "memory");
}

struct EpiIn {
    const float* xss; const float* qg; const float* kg; const float* cosT; const float* sinT;
    bf16_t *Q, *K, *V, *GU, *GV; float *qss, *kss, *gvs;
    __device__ __forceinline__ void operator()(const f32x4 (&acc)[2][2][4][2], const Unit& u, int wr, int wc, int fr, int fq) const {
        asm volatile("" : "+v"(fr), "+v"(fq));
        const int row0 = u.pm * 256 + wr * 64 + fr;
        float rr[2][4]; row_rstd(xss, row0, fq, rr);
        const int pn = u.pn;
        if (pn < 5) {
            const bool isq = pn < 4;
            const float* gn = isq ? qg : kg;
            const int gg = 4 * wc + fq;
            const f32x4 glo = *(const f32x4*)(gn + 4 * gg), ghi = *(const f32x4*)(gn + 64 + 4 * gg);
#pragma unroll
            for (int ai = 0; ai < 2; ++ai) {
                f32x4 cs[4], sn[4];
#pragma unroll
                for (int i = 0; i < 4; ++i) { const int pos = (row0 + 128 * ai + 16 * i) & (SEQ - 1); cs[i] = *(const f32x4*)(cosT + pos * 64 + 4 * gg); sn[i] = *(const f32x4*)(sinT + pos * 64 + 4 * gg); }
#pragma unroll
                for (int m = 0; m < 4; ++m) {
                    const int row = row0 + 128 * ai + 16 * m;
                    const f32x4 c = cs[m], s = sn[m];
                    const float r = rr[ai][m];
#pragma unroll
                    for (int bj = 0; bj < 2; ++bj) {
                        const f32x4 v0 = acc[ai][bj][m][0] * r, v1 = acc[ai][bj][m][1] * r;
                        float ss = dot4(v0) + dot4(v1);
                        ss += __shfl_xor(ss, 16); ss += __shfl_xor(ss, 32);
                        const int head = isq ? 2 * pn + bj : bj;
                        if (fq == 0) { if (isq) qss[((size_t)row * 8 + head) * 4 + wc] = ss; else kss[((size_t)row * 2 + head) * 4 + wc] = ss; }
                        const f32x4 y0 = v0 * glo, y1 = v1 * ghi;
                        const f32x4 lo = y0 * c - y1 * s, hi = y1 * c + y0 * s;
                        bf16_t* dst = (isq ? Q + (size_t)row * 1024 : K + (size_t)row * 256) + head * 128;
                        u32x2 wl, wh; wl.x = cvt_pk_bf16(lo.x, lo.y); wl.y = cvt_pk_bf16(lo.z, lo.w); wh.x = cvt_pk_bf16(hi.x, hi.y); wh.y = cvt_pk_bf16(hi.z, hi.w);
                        *(u32x2*)(dst + 4 * gg) = wl; *(u32x2*)(dst + 64 + 4 * gg) = wh;
                    }
                }
                asm volatile("" ::: "memory");
            }
        } else if (pn == 5) {
#pragma unroll
            for (int ai = 0; ai < 2; ++ai)
#pragma unroll
                for (int m = 0; m < 4; ++m) {
                    const int row = row0 + 128 * ai + 16 * m; const float r = rr[ai][m];
#pragma unroll
                    for (int bj = 0; bj < 2; ++bj) {
                        const f32x4 v0 = acc[ai][bj][m][0] * r, v1 = acc[ai][bj][m][1] * r;
                        u32x4 w; w.x = cvt_pk_bf16(v0.x, v0.y); w.y = cvt_pk_bf16(v0.z, v0.w); w.z = cvt_pk_bf16(v1.x, v1.y); w.w = cvt_pk_bf16(v1.z, v1.w);
                        *(u32x4*)(V + (size_t)row * 256 + bj * 128 + 32 * wc + 8 * fq) = w;
                    }
                }
        } else {
            const bool isgv = pn >= 10;
            const int ct = isgv ? pn - 10 : pn - 6;
            bf16_t* dstb = (isgv ? GV : GU) + ct * 256 + 32 * wc + 8 * fq;
#pragma unroll
            for (int ai = 0; ai < 2; ++ai)
#pragma unroll
                for (int m = 0; m < 4; ++m) {
                    const int row = row0 + 128 * ai + 16 * m; const float r = rr[ai][m];
                    float s1 = 0.f, s2 = 0.f;
#pragma unroll
                    for (int bj = 0; bj < 2; ++bj) {
                        f32x4 v0 = acc[ai][bj][m][0] * r, v1 = acc[ai][bj][m][1] * r;
                        v0.x = gelu_tanh(v0.x); v0.y = gelu_tanh(v0.y); v0.z = gelu_tanh(v0.z); v0.w = gelu_tanh(v0.w);
                        v1.x = gelu_tanh(v1.x); v1.y = gelu_tanh(v1.y); v1.z = gelu_tanh(v1.z); v1.w = gelu_tanh(v1.w);
                        s1 += sum4(v0) + sum4(v1); s2 += dot4(v0) + dot4(v1);
                        u32x4 w; w.x = cvt_pk_bf16(v0.x, v0.y); w.y = cvt_pk_bf16(v0.z, v0.w); w.z = cvt_pk_bf16(v1.x, v1.y); w.w = cvt_pk_bf16(v1.z, v1.w);
                        *(u32x4*)(dstb + (size_t)row * 1024 + bj * 128) = w;
                    }
                    if (isgv) {
                        s1 += __shfl_xor(s1, 16); s1 += __shfl_xor(s1, 32);
                        s2 += __shfl_xor(s2, 16); s2 += __shfl_xor(s2, 32);
                        if (fq == 0) *(f32x2*)(gvs + ((size_t)row * 16 + ct * 4 + wc) * 2) = (f32x2){s1, s2};
                    }
                    asm volatile("" ::: "memory");
                }
        }
    }
};

struct EpiRes {
    float* out; bf16_t* xb; float* xss;
    __device__ __forceinline__ void operator()(const f32x4 (&acc)[2][2][4][2], const Unit& u, int wr, int wc, int fr, int fq) const {
        asm volatile("" : "+v"(fr), "+v"(fq));
        const int row0 = u.pm * 256 + wr * 64 + fr, col0 = u.pn * 256 + 32 * wc + 8 * fq;
#pragma unroll
        for (int ai = 0; ai < 2; ++ai) {
            u32x4 bv[2][4][2];
#pragma unroll
            for (int m = 0; m < 4; ++m)
#pragma unroll
                for (int bj = 0; bj < 2; ++bj) bv[ai][m][bj] = *(const u32x4*)(xb + (size_t)(row0 + 128 * ai + 16 * m) * DM + col0 + bj * 128);
#pragma unroll
            for (int m = 0; m < 4; ++m) {
                const int row = row0 + 128 * ai + 16 * m; float ss = 0.f;
#pragma unroll
                for (int bj = 0; bj < 2; ++bj) {
                    const size_t off = (size_t)row * DM + col0 + bj * 128;
                    const u32x4 b = bv[ai][m][bj];
                    const f32x4 o0 = (f32x4){bf_lo(b.x), bf_hi(b.x), bf_lo(b.y), bf_hi(b.y)} + acc[ai][bj][m][0];
                    const f32x4 o1 = (f32x4){bf_lo(b.z), bf_hi(b.z), bf_lo(b.w), bf_hi(b.w)} + acc[ai][bj][m][1];
                    if (out) { *(f32x4*)(out + off) = o0; *(f32x4*)(out + off + 4) = o1; }
                    else {
                        u32x4 w; w.x = cvt_pk_bf16(o0.x, o0.y); w.y = cvt_pk_bf16(o0.z, o0.w); w.z = cvt_pk_bf16(o1.x, o1.y); w.w = cvt_pk_bf16(o1.z, o1.w);
                        *(u32x4*)(xb + off) = w;
                        ss += dot4(o0) + dot4(o1);
                    }
                }
                if (!out) {
                    ss += __shfl_xor(ss, 16); ss += __shfl_xor(ss, 32);
                    if (fq == 0) xss[(size_t)row * 32 + u.pn * 4 + wc] = ss;
                }
            }
            asm volatile("" ::: "memory");
        }
    }
};

struct EpiUp {
    const float* xss; const float* cw; const float* cb; bf16_t* ACT; bf16_t* HALO;
    __device__ __forceinline__ void operator()(f32x4 (&acc)[2][2][4][2], const Unit& u, int wr, int wc, int fr, int fq) const {
        asm volatile("" : "+v"(fr), "+v"(fq));
        const int row0 = u.pm * 256 + wr * 64 + fr;
        float rr[2][4]; row_rstd(xss, row0, fq, rr);
        const int jg = u.pn * 128 + 32 * wc + 8 * fq;
#pragma unroll
        for (int ai = 0; ai < 2; ++ai)
#pragma unroll
            for (int m = 0; m < 4; ++m) {
                const float r = rr[ai][m];
#pragma unroll
                for (int bj = 0; bj < 2; ++bj) { acc[ai][bj][m][0] *= r; acc[ai][bj][m][1] *= r; }
                if (m == 0 || m == 3) {
                    const bool hal = (m == 0) ? (fr < 2) : (fr >= 14);
                    if (hal) {
                        const int row = row0 + 128 * ai + 16 * m;
                        const int hr = (row >> 6) * 4 + (m == 0 ? fr : fr - 12);
#pragma unroll
                        for (int bj = 0; bj < 2; ++bj) {
                            const f32x4 v0 = acc[ai][bj][m][0], v1 = acc[ai][bj][m][1];
                            u32x4 w; w.x = cvt_pk_bf16(v0.x, v0.y); w.y = cvt_pk_bf16(v0.z, v0.w); w.z = cvt_pk_bf16(v1.x, v1.y); w.w = cvt_pk_bf16(v1.z, v1.w);
                            *(u32x4*)(HALO + (size_t)hr * NUP + (bj ? DFF : 0) + jg) = w;
                        }
                    }
                }
            }
        __builtin_amdgcn_sched_barrier(0);
#pragma unroll
        for (int n = 0; n < 2; ++n) {
            f32x4 wv[2][2][4];
#pragma unroll
            for (int bj = 0; bj < 2; ++bj) {
                const int col = (bj ? DFF : 0) + jg + 4 * n;
                const float ksc = bj ? -0.6931471805599453f : -LOG2E;
                wv[n][bj][0] = *(const f32x4*)(cw + col) * ksc; wv[n][bj][1] = *(const f32x4*)(cw + NUP + col) * ksc; wv[n][bj][2] = *(const f32x4*)(cw + 2 * NUP + col) * ksc; wv[n][bj][3] = *(const f32x4*)(cb + col) * ksc;
            }
#pragma unroll
            for (int e = 0; e < 4; ++e) {
#pragma unroll
                for (int ai = 0; ai < 2; ++ai) {
                    float a[2][4];
#pragma unroll
                    for (int bj = 0; bj < 2; ++bj) {
                        float raw[4], P[4], N[4];
#pragma unroll
                        for (int m = 0; m < 4; ++m) raw[m] = acc[ai][bj][m][n][e];
                        asm volatile("" : "+v"(raw[0]), "+v"(raw[1]), "+v"(raw[2]), "+v"(raw[3]));
#pragma unroll
                        for (int m = 0; m < 4; ++m) { P[m] = dpp_prev(raw[m]); N[m] = dpp_next(raw[m]); }
#pragma unroll
                        for (int m = 0; m < 4; ++m) {
                            const float prev = fr > 0 ? P[m] : (m > 0 ? P[m > 0 ? m - 1 : 0] : 0.f);
                            const float next = fr < 15 ? N[m] : (m < 3 ? N[m < 3 ? m + 1 : 3] : 0.f);
                            a[bj][m] = __builtin_fmaf(wv[n][bj][0][e], prev, __builtin_fmaf(wv[n][bj][1][e], raw[m], __builtin_fmaf(wv[n][bj][2][e], next, wv[n][bj][3][e])));
                        }
                        asm volatile("" : "+v"(a[bj][0]), "+v"(a[bj][1]), "+v"(a[bj][2]), "+v"(a[bj][3]));
                    }
#pragma unroll
                    for (int m = 0; m < 4; ++m) acc[ai][0][m][n][e] = (a[0][m] * a[1][m]) * __builtin_amdgcn_rcpf(1.0f + __builtin_amdgcn_exp2f(a[0][m]));
                }
            }
        }
#pragma unroll
        for (int ai = 0; ai < 2; ++ai)
#pragma unroll
            for (int m = 0; m < 4; ++m) {
                const int row = row0 + 128 * ai + 16 * m;
                const bool edge = (m == 0 && fr == 0) || (m == 3 && fr == 15);
                if (!edge) {
                    const f32x4 v0 = acc[ai][0][m][0], v1 = acc[ai][0][m][1];
                    u32x4 w; w.x = cvt_pk_bf16(v0.x, v0.y); w.y = cvt_pk_bf16(v0.z, v0.w); w.z = cvt_pk_bf16(v1.x, v1.y); w.w = cvt_pk_bf16(v1.z, v1.w);
                    *(u32x4*)(ACT + (size_t)row * DFF + jg) = w;
                }
            }
    }
};

struct Args { const float* in[18]; float* out; unsigned char* ws; };

__device__ __forceinline__ int cmap_in(int n) {
    if (n >= 1280) return n;
    const int head = n >> 7, c = n & 127, g = c >> 3, j = c & 7;
    return head * 128 + ((j < 4) ? 4 * g + j : 64 + 4 * g + (j - 4));
}
__device__ __forceinline__ int cmap_up(int n) { const int pn = n >> 8, c = n & 255; return (c < 128) ? 128 * pn + c : DFF + 128 * pn + (c - 128); }

template <int MODE>
__device__ __forceinline__ void transpose_item(const float* W, int K, int N, bf16_t* WT, const float* gk, LAS float* scr, int item, int lane) {
    const int nblk = N / 64, kb = item / nblk, nb = item % nblk, k0 = 64 * kb, n0 = 64 * nb;
    const int c4 = lane & 15, r4 = lane >> 4;
    const int nn = n0 + 4 * c4;
    const int sc = MODE == 1 ? cmap_in(nn) : (MODE == 2 ? cmap_up(nn) : nn);
    f32x4 v[16];
    const float* src = W + (size_t)(k0 + r4) * N + sc;
#pragma unroll
    for (int i = 0; i < 16; ++i) v[i] = *(const f32x4*)(src + (size_t)(4 * i) * N);
    if (gk) {
#pragma unroll
        for (int i = 0; i < 16; ++i) v[i] *= gk[k0 + 4 * i + r4];
    }
#pragma unroll
    for (int i = 0; i < 16; ++i) { LAS float* d = scr + (4 * i + r4) * 65 + 4 * c4; d[0] = v[i].x; d[1] = v[i].y; d[2] = v[i].z; d[3] = v[i].w; }
    asm volatile("s_waitcnt lgkmcnt(0)" ::: "memory");
    const int c = lane & 7;
#pragma unroll
    for (int j = 0; j < 8; ++j) { const int n = (lane >> 3) + 8 * j; const LAS float* p = scr + (8 * c) * 65 + n;
        u32x4 o; o.x = cvt_pk_bf16(p[0 * 65], p[1 * 65]); o.y = cvt_pk_bf16(p[2 * 65], p[3 * 65]); o.z = cvt_pk_bf16(p[4 * 65], p[5 * 65]); o.w = cvt_pk_bf16(p[6 * 65], p[7 * 65]);
        *(u32x4*)(WT + (size_t)(n0 + n) * K + k0 + 8 * c) = o; }
    asm volatile("s_waitcnt lgkmcnt(0)" ::: "memory");
}

__device__ __forceinline__ void prologue(const Args& a, LAS unsigned char* lds, int G, int wv) {
    const int tid = fresh_tid(wv);
    const int lane = tid & 63, wave = tid >> 6;
    LAS float* scr = (LAS float*)(lds + wave * 16640);
    const int gw = blockIdx.x * 8 + wave, NGW = G * 8;
    unsigned char* ws = a.ws;
    constexpr int I_IN = (DM / 64) * (NIN / 64), I_O = (DM / 64) * (DM / 64), I_UP = (DM / 64) * (NUP / 64), I_DN = (DFF / 64) * (DM / 64);
    constexpr int I_L = I_IN + I_O + I_UP + I_DN;
    for (int it = gw; it < DEPTH * I_L; it += NGW) {
        const int l = it / I_L; int r = it % I_L;
        if (r < I_IN) { transpose_item<1>(a.in[2] + (size_t)l * DM * NIN, DM, NIN, (bf16_t*)(ws + OFF_WIN + l * SZ_WIN), a.in[1] + l * DM, scr, r, lane); continue; } r -= I_IN;
        if (r < I_O) {
            const int kb = r / (DM / 64); const float* gk = (kb < 16) ? (a.in[10] + l * 1024) : (a.in[11] + l * 1024 - 1024);
            transpose_item<0>(a.in[12] + (size_t)l * DM * DM, DM, DM, (bf16_t*)(ws + OFF_WO + l * SZ_WO), gk, scr, r, lane); continue; } r -= I_O;
        if (r < I_UP) { transpose_item<2>(a.in[14] + (size_t)l * DM * NUP, DM, NUP, (bf16_t*)(ws + OFF_WUP + l * SZ_WUP), a.in[13] + l * DM, scr, r, lane); continue; } r -= I_UP;
        transpose_item<0>(a.in[17] + (size_t)l * DFF * DM, DFF, DM, (bf16_t*)(ws + OFF_WDN + l * SZ_WDN), nullptr, scr, r, lane);
    }
    {
        const float* x = a.in[0]; bf16_t* xb = (bf16_t*)(ws + OFF_XB); float* xss = (float*)(ws + OFF_XSS);
        for (int m = gw; m < T; m += 2 * NGW) {
            const int m2 = m + NGW;
            const bool has2 = m2 < T;
            const f32x4* xr = (const f32x4*)(x + (size_t)m * DM) + lane; const f32x4* xr2 = (const f32x4*)(x + (size_t)(has2 ? m2 : m) * DM) + lane;
            f32x4 va[8], vb[8];
#pragma unroll
            for (int j = 0; j < 8; ++j) { va[j] = xr[64 * j]; vb[j] = xr2[64 * j]; }
            float s = 0.f, s2 = 0.f;
            u32x2* o8 = (u32x2*)(xb + (size_t)m * DM) + lane; u32x2* o82 = (u32x2*)(xb + (size_t)(has2 ? m2 : m) * DM) + lane;
#pragma unroll
            for (int j = 0; j < 8; ++j) { s += dot4(va[j]); s2 += dot4(vb[j]);
                u32x2 w; w.x = cvt_pk_bf16(va[j].x, va[j].y); w.y = cvt_pk_bf16(va[j].z, va[j].w); o8[64 * j] = w;
                u32x2 w2; w2.x = cvt_pk_bf16(vb[j].x, vb[j].y); w2.y = cvt_pk_bf16(vb[j].z, vb[j].w); if (has2) o82[64 * j] = w2; }
            s = wave_sum(s); s2 = wave_sum(s2);
            if (lane < 32) { xss[(size_t)m * 32 + lane] = (lane == 0) ? s : 0.f; if (has2) xss[(size_t)m2 * 32 + lane] = (lane == 0) ? s2 : 0.f; }
        }
    }
    {
        float* cosT = (float*)(ws + OFF_COS); float* sinT = (float*)(ws + OFF_SIN);
        for (int i = blockIdx.x * 512 + tid; i < SEQ * 64; i += G * 512) {
            const int pos = i >> 6, k = i & 63;
            const float inv = (float)exp2(-(double)k * (13.287712379549449 / 64.0));
            const float ang = (float)pos * inv;
            double rev = (double)ang * 0.15915494309189535; rev -= rint(rev);
            const float fr = (float)rev;
            cosT[i] = __builtin_amdgcn_cosf(fr); sinT[i] = __builtin_amdgcn_sinf(fr);
        }
    }
    {
        const float* wsrc = a.in[8]; float* rsw = (float*)(ws + OFF_RSW);
        for (int r = gw; r < DEPTH * 8 * 128; r += NGW) {
            const f32x2 v = *((const f32x2*)(wsrc + (size_t)r * 128) + lane);
            const float t = wave_sum(v.x + v.y);
            if (lane == 0) rsw[r] = t;
        }
    }
    {
        const float* wsrc = a.in[8]; bf16_t* wd = (bf16_t*)(ws + OFF_WS);
        for (int i = blockIdx.x * 512 + tid; i < DEPTH * 8 * 128 * 128 / 4; i += G * 512) {
            const f32x4 v = *((const f32x4*)wsrc + i); u32x2 w; w.x = cvt_pk_bf16(v.x, v.y); w.y = cvt_pk_bf16(v.z, v.w); *((u32x2*)wd + i) = w;
        }
    }
}

#define LDS_BARRIER() do { asm volatile("s_waitcnt lgkmcnt(0)" ::: "memory"); __builtin_amdgcn_s_barrier(); asm volatile("" ::: "memory"); } while (0)

__device__ __forceinline__ s16x4 vtr(const LAS unsigned char* p) { typedef short v4i16_t __attribute__((ext_vector_type(4))); return __builtin_bit_cast(s16x4, __builtin_amdgcn_ds_read_tr16_b64_v4i16((LAS v4i16_t*)p)); }
#define MFMA32(a, b, c) __builtin_amdgcn_mfma_f32_32x32x16_bf16((a), (b), (c), 0, 0, 0)

constexpr int AT_KROW = 272, AT_VROW = 288, AT_KSZ = 32 * AT_KROW, AT_VSZ = 32 * AT_VROW, AT_BUF = 2 * AT_KSZ + 2 * AT_VSZ;
constexpr int AT_RED = 2 * AT_BUF;

__device__ __forceinline__ void attn_unit(LAS unsigned char* lds, int unit, const float* sinkl, const bf16_t* Q, const bf16_t* K, const bf16_t* V, const float* qss, const float* kss, bf16_t* MIX, int wv) {
    const int tid = fresh_tid(wv);
    const int lane = tid & 63, wid = __builtin_amdgcn_readfirstlane(tid >> 6), qi = lane & 31, hh = lane >> 5;
    const int b = unit >> 6, qb = unit & 63, q0 = qb * 32;
    const size_t rowbase = (size_t)b * SEQ;
    const int hq = wid, kvh = wid >> 2;
    const size_t qrow = rowbase + q0 + qi;
    bf16x8 qf[8];
    { const bf16_t* qp = Q + qrow * 1024 + hq * 128 + 8 * hh;
#pragma unroll
      for (int s = 0; s < 8; ++s) qf[s] = *(const bf16x8*)(qp + 16 * s); }
    const f32x4 qs = *(const f32x4*)(qss + (qrow * 8 + hq) * 4);
    const float rq = rsqrtf(sum4(qs) * (1.0f / 128.0f) + EPS);
    const float sc = rq * 0.08838834764831845f * LOG2E;
    const float sk = sinkl[hq] * LOG2E;
    float m_run = sk, l_run = (hh == 0) ? 1.f : 0.f;
    f32x16 o[4];
#pragma unroll
    for (int c = 0; c < 4; ++c)
#pragma unroll
        for (int i = 0; i < 16; ++i) o[c][i] = 0.f;
    int kb_lo = 0, kb_hi = 8;
    if (qb < 4) kb_lo = 4 - qb;
    if (qb > 59) kb_hi = 67 - qb;
    const int skey = tid >> 4, spart = tid & 15;
    u32x4 pk0A, pk1A, pv0A, pv1A, pk0B, pk1B, pv0B, pv1B; f32x4 ks0A, ks1A, ks0B, ks1B;
#define AT_LOAD(S, kb) do { const size_t r_ = rowbase + (size_t)(q0 - 128 + 32 * (kb) + skey); \
        pk0##S = *(const u32x4*)(K + r_ * 256 + 8 * spart); pk1##S = *(const u32x4*)(K + r_ * 256 + 128 + 8 * spart); \
        pv0##S = *(const u32x4*)(V + r_ * 256 + 8 * spart); pv1##S = *(const u32x4*)(V + r_ * 256 + 128 + 8 * spart); \
        ks0##S = *(const f32x4*)(kss + r_ * 8); ks1##S = *(const f32x4*)(kss + r_ * 8 + 4); } while (0)
#define AT_SCALE(p, r) do { u32x4 t_; \
        t_.x = cvt_pk_bf16(bf_lo(p.x) * r, bf_hi(p.x) * r); t_.y = cvt_pk_bf16(bf_lo(p.y) * r, bf_hi(p.y) * r); \
        t_.z = cvt_pk_bf16(bf_lo(p.z) * r, bf_hi(p.z) * r); t_.w = cvt_pk_bf16(bf_lo(p.w) * r, bf_hi(p.w) * r); p = t_; } while (0)
#define AT_WRITE(S, buf) do { const float r0_ = rsqrtf(sum4(ks0##S) * (1.0f / 128.0f) + EPS), r1_ = rsqrtf(sum4(ks1##S) * (1.0f / 128.0f) + EPS); \
        AT_SCALE(pk0##S, r0_); AT_SCALE(pk1##S, r1_); \
        LAS unsigned char* b_ = lds + (buf) * AT_BUF; \
        *(LAS u32x4*)(b_ + skey * AT_KROW + spart * 16) = pk0##S; *(LAS u32x4*)(b_ + AT_KSZ + skey * AT_KROW + spart * 16) = pk1##S; \
        *(LAS u32x4*)(b_ + 2 * AT_KSZ + skey * AT_VROW + spart * 16) = pv0##S; *(LAS u32x4*)(b_ + 2 * AT_KSZ + AT_VSZ + skey * AT_VROW + spart * 16) = pv1##S; } while (0)
    const int trq = (lane & 15) >> 2, trp = lane & 3, blk = (lane >> 4) & 1;
#define AT_COMPUTE(kb, cur) do { \
        const LAS unsigned char* Kb = lds + (cur) * AT_BUF + kvh * AT_KSZ; \
        const LAS unsigned char* Vb = lds + (cur) * AT_BUF + 2 * AT_KSZ + kvh * AT_VSZ; \
        f32x16 st; \
        _Pragma("unroll") for (int i = 0; i < 16; ++i) st[i] = 0.f; \
        _Pragma("unroll") for (int s_ = 0; s_ < 8; ++s_) { const bf16x8 kf = *(const LAS bf16x8*)(Kb + qi * AT_KROW + (16 * s_ + 8 * hh) * 2); st = MFMA32(kf, qf[s_], st); } \
        float tt[16]; \
        _Pragma("unroll") for (int i = 0; i < 16; ++i) tt[i] = st[i] * sc; \
        if ((kb) == 0) { _Pragma("unroll") for (int i = 0; i < 16; ++i) if (crow(i, hh) < qi) tt[i] = -INFINITY; } \
        if ((kb) == 8) { _Pragma("unroll") for (int i = 0; i < 16; ++i) if (crow(i, hh) > qi) tt[i] = -INFINITY; } \
        float mx = tt[0]; \
        _Pragma("unroll") for (int i = 1; i < 16; ++i) mx = fmaxf(mx, tt[i]); \
        mx = fmaxf(mx, __shfl_xor(mx, 32)); \
        const float m_new = fmaxf(m_run, mx); \
        const float alpha = __builtin_amdgcn_exp2f(m_run - m_new); \
        float ps = 0.f; \
        _Pragma("unroll") for (int i = 0; i < 16; ++i) { tt[i] = __builtin_amdgcn_exp2f(tt[i] - m_new); ps += tt[i]; } \
        l_run = l_run * alpha + ps; m_run = m_new; \
        _Pragma("unroll") for (int c = 0; c < 4; ++c) _Pragma("unroll") for (int i = 0; i < 16; ++i) o[c][i] *= alpha; \
        _Pragma("unroll") for (int s2 = 0; s2 < 2; ++s2) { \
            u32x4 pw; pw.x = cvt_pk_bf16(tt[8 * s2 + 0], tt[8 * s2 + 1]); pw.y = cvt_pk_bf16(tt[8 * s2 + 2], tt[8 * s2 + 3]); pw.z = cvt_pk_bf16(tt[8 * s2 + 4], tt[8 * s2 + 5]); pw.w = cvt_pk_bf16(tt[8 * s2 + 6], tt[8 * s2 + 7]); \
            const bf16x8 pb = __builtin_bit_cast(bf16x8, pw); \
            _Pragma("unroll") for (int c = 0; c < 4; ++c) { \
                const LAS unsigned char* vp = Vb + (16 * s2 + 4 * hh + trq) * AT_VROW + (32 * c + 16 * blk) * 2 + 8 * trp; \
                const s16x4 lo = vtr(vp), hi = vtr(vp + 8 * AT_VROW); \
                const bf16x8 vf = {lo[0], lo[1], lo[2], lo[3], hi[0], hi[1], hi[2], hi[3]}; \
                o[c] = MFMA32(vf, pb, o[c]); } } } while (0)
    AT_LOAD(A, kb_lo);
    if (kb_lo + 1 <= kb_hi) AT_LOAD(B, kb_lo + 1);
    AT_WRITE(A, 0);
    LDS_BARRIER();
    if (kb_lo + 2 <= kb_hi) AT_LOAD(A, kb_lo + 2);
    for (int kb = kb_lo; ; kb += 2) {
        AT_COMPUTE(kb, 0);
        if (kb + 1 <= kb_hi) AT_WRITE(B, 1);
        LDS_BARRIER();
        if (kb + 1 > kb_hi) break;
        if (kb + 3 <= kb_hi) AT_LOAD(B, kb + 3);
        AT_COMPUTE(kb + 1, 1);
        if (kb + 2 <= kb_hi) AT_WRITE(A, 0);
        LDS_BARRIER();
        if (kb + 2 > kb_hi) break;
        if (kb + 4 <= kb_hi) AT_LOAD(A, kb + 4);
    }
#undef AT_LOAD
#undef AT_SCALE
#undef AT_WRITE
#undef AT_COMPUTE
    const float lt = l_run + __shfl_xor(l_run, 32);
    const float inv = 1.0f / lt;
    float ss = 0.f;
#pragma unroll
    for (int c = 0; c < 4; ++c)
#pragma unroll
        for (int i = 0; i < 16; ++i) { o[c][i] *= inv; ss += o[c][i] * o[c][i]; }
    ss += __shfl_xor(ss, 32);
    LAS float* red = (LAS float*)(lds + AT_RED);
    if (hh == 0) red[hq * 32 + qi] = ss;
    LDS_BARRIER();
    float tot = 0.f;
#pragma unroll
    for (int h = 0; h < 8; ++h) tot += red[h * 32 + qi];
    const float ra = rsqrtf(tot * (1.0f / 1024.0f) + EPS);
    bf16_t* op = MIX + qrow * DM + hq * 128;
#pragma unroll
    for (int c = 0; c < 4; ++c)
#pragma unroll
        for (int g = 0; g < 4; ++g) {
            u32x2 w; w.x = cvt_pk_bf16(o[c][4 * g] * ra, o[c][4 * g + 1] * ra); w.y = cvt_pk_bf16(o[c][4 * g + 2] * ra, o[c][4 * g + 3] * ra);
            *(u32x2*)(op + 32 * c + 8 * g + 4 * hh) = w;
        }
    LDS_BARRIER();
}

constexpr int SG_ROW = 288, SG_BUF = 128 * SG_ROW, SG_STAT = 2 * SG_BUF, SG_RED = SG_STAT + 128 * 8, SG_LN = SG_RED + 1024;
__device__ __forceinline__ void sgu_unit(LAS unsigned char* lds, int unit, const bf16_t* GU, const bf16_t* GV, const float* gvs, const float* lng, const float* lnb,
                                         const bf16_t* WS, const float* rsw, const float* bs, bf16_t* MIX, int wv) {
    const int tid = fresh_tid(wv);
    const int lane = tid & 63, wid = __builtin_amdgcn_readfirstlane(tid >> 6), pi = lane & 31, hh = lane >> 5;
    const int bc = unit >> 1, ph = unit & 1;
    const size_t rowbase = (size_t)bc * 128;
    LAS f32x2* stat = (LAS f32x2*)(lds + SG_STAT);
    const int spart = tid & 15, sq = tid >> 4;
    const bf16_t* gvp = GV + (rowbase + sq) * 1024 + 8 * spart;
    u32x4 gvr[4];
#define SG_LOADGV(h) do { _Pragma("unroll") for (int i = 0; i < 4; ++i) gvr[i] = *(const u32x4*)(gvp + (size_t)(32 * i) * 1024 + (h) * 128); } while (0)
    SG_LOADGV(0);
    {
        const f32x4 t4 = (tid < 256) ? *(const f32x4*)(lng + 4 * tid) : *(const f32x4*)(lnb + 4 * (tid - 256));
        *(LAS f32x4*)(lds + SG_LN + 16 * tid) = t4;
    }
    if (tid < 128) {
        const f32x4* p = (const f32x4*)(gvs + (rowbase + tid) * 32);
        float s1 = 0.f, s2 = 0.f;
#pragma unroll
        for (int i = 0; i < 8; ++i) { const f32x4 v = p[i]; s1 += v.x + v.z; s2 += v.y + v.w; }
        const float mu = s1 * (1.0f / 1024.0f);
        const float var = s2 * (1.0f / 1024.0f) - mu * mu;
        stat[tid] = (f32x2){mu, rsqrtf(fmaxf(var, 0.f) + EPS)};
    }
    LDS_BARRIER();
    const int psub = wid & 1, dsub = wid >> 1;
    const int prow = ph * 64 + psub * 32 + pi;
    const int trq = (lane & 15) >> 2, trp = lane & 3, blk = (lane >> 4) & 1;
    const bf16_t* wp = WS + (size_t)prow * 128 + 8 * hh;
    unsigned accp[8][8];
#pragma unroll
    for (int h = 0; h < 8; ++h) {
        f32x16 acch;
#pragma unroll
        for (int i = 0; i < 16; ++i) acch[i] = 0.f;
        bf16x8 wf[8];
#pragma unroll
        for (int s_ = 0; s_ < 8; ++s_) wf[s_] = *(const bf16x8*)(wp + (size_t)h * 128 * 128 + 16 * s_);
        LAS unsigned char* buf = lds + (h & 1) * SG_BUF;
#pragma unroll
        for (int i = 0; i < 4; ++i) {
            const int q = sq + 32 * i;
            const u32x4 v = gvr[i];
            const f32x2 st = stat[q];
            const float nm = -st.x * st.y;
            u32x4 w;
            w.x = cvt_pk_bf16(__builtin_fmaf(bf_lo(v.x), st.y, nm), __builtin_fmaf(bf_hi(v.x), st.y, nm));
            w.y = cvt_pk_bf16(__builtin_fmaf(bf_lo(v.y), st.y, nm), __builtin_fmaf(bf_hi(v.y), st.y, nm));
            w.z = cvt_pk_bf16(__builtin_fmaf(bf_lo(v.z), st.y, nm), __builtin_fmaf(bf_hi(v.z), st.y, nm));
            w.w = cvt_pk_bf16(__builtin_fmaf(bf_lo(v.w), st.y, nm), __builtin_fmaf(bf_hi(v.w), st.y, nm));
            *(LAS u32x4*)(buf + q * SG_ROW + spart * 16) = w;
        }
        if (h + 1 < 8) SG_LOADGV(h + 1);
        LDS_BARRIER();
#pragma unroll
        for (int s_ = 0; s_ < 8; ++s_) {
            const LAS unsigned char* vp = buf + (16 * s_ + 8 * hh + trq) * SG_ROW + (32 * dsub + 16 * blk) * 2 + 8 * trp;
            const s16x4 lo = vtr(vp), hi = vtr(vp + 4 * SG_ROW);
            const bf16x8 vf = {lo[0], lo[1], lo[2], lo[3], hi[0], hi[1], hi[2], hi[3]};
            acch = MFMA32(vf, wf[s_], acch);
            if (s_ & 1) __builtin_amdgcn_sched_barrier(0);
        }
#pragma unroll
        for (int k = 0; k < 8; ++k) accp[h][k] = cvt_pk_bf16(acch[2 * k], acch[2 * k + 1]);
    }
#undef SG_LOADGV
    const size_t orow = rowbase + prow;
    float ss = 0.f;
    u32x2 guv[8][4]; float bbv[8], rwv[8];
#pragma unroll
    for (int h = 0; h < 8; ++h) {
        bbv[h] = bs[h * 128 + prow]; rwv[h] = rsw[h * 128 + prow];
#pragma unroll
        for (int g = 0; g < 4; ++g) guv[h][g] = *(const u32x2*)(GU + orow * 1024 + h * 128 + 32 * dsub + 8 * g + 4 * hh);
    }
    const LAS float* lnl = (const LAS float*)(lds + SG_LN);
#pragma unroll
    for (int h = 0; h < 8; ++h) {
        const float bb = bbv[h], rw = rwv[h];
#pragma unroll
        for (int g = 0; g < 4; ++g) {
            const int d0 = h * 128 + 32 * dsub + 8 * g + 4 * hh;
            const u32x2 gu = guv[h][g];
            const f32x4 lg = *(const LAS f32x4*)(lnl + d0), lb = *(const LAS f32x4*)(lnl + 1024 + d0);
            const float o0 = bf_lo(gu.x) * (__builtin_fmaf(lg.x, bf_lo(accp[h][2 * g]), __builtin_fmaf(lb.x, rw, bb)));
            const float o1 = bf_hi(gu.x) * (__builtin_fmaf(lg.y, bf_hi(accp[h][2 * g]), __builtin_fmaf(lb.y, rw, bb)));
            const float o2 = bf_lo(gu.y) * (__builtin_fmaf(lg.z, bf_lo(accp[h][2 * g + 1]), __builtin_fmaf(lb.z, rw, bb)));
            const float o3 = bf_hi(gu.y) * (__builtin_fmaf(lg.w, bf_hi(accp[h][2 * g + 1]), __builtin_fmaf(lb.w, rw, bb)));
            ss += (o0 * o0 + o1 * o1) + (o2 * o2 + o3 * o3);
            accp[h][2 * g] = cvt_pk_bf16(o0, o1); accp[h][2 * g + 1] = cvt_pk_bf16(o2, o3);
        }
        __builtin_amdgcn_sched_barrier(0);
    }
    ss += __shfl_xor(ss, 32);
    LAS float* red = (LAS float*)(lds + SG_RED);
    if (hh == 0) red[dsub * 64 + psub * 32 + pi] = ss;
    LDS_BARRIER();
    const float tot = (red[psub * 32 + pi] + red[64 + psub * 32 + pi]) + (red[128 + psub * 32 + pi] + red[192 + psub * 32 + pi]);
    const float rs = rsqrtf(tot * (1.0f / 1024.0f) + EPS);
    bf16_t* op = MIX + orow * DM + 1024 + 32 * dsub;
#pragma unroll
    for (int h = 0; h < 8; ++h)
#pragma unroll
        for (int g = 0; g < 4; ++g) {
            u32x2 w; w.x = cvt_pk_bf16(bf_lo(accp[h][2 * g]) * rs, bf_hi(accp[h][2 * g]) * rs); w.y = cvt_pk_bf16(bf_lo(accp[h][2 * g + 1]) * rs, bf_hi(accp[h][2 * g + 1]) * rs);
            *(u32x2*)(op + h * 128 + 8 * g + 4 * hh) = w;
        }
    LDS_BARRIER();
}

__device__ __forceinline__ void fixup_phase(const bf16_t* HALO, const float* cw, const float* cb, bf16_t* ACT, int G, int wv) {
    constexpr int CH = DFF / 8;
    const int total = (T / 64) * 2 * CH;
    const int tid = fresh_tid(wv);
    for (int it = blockIdx.x * 512 + tid; it < total; it += G * 512) {
        const int ch = it % CH, br = it / CH, sl = br >> 1, side = br & 1;
        const int row = sl * 64 + (side ? 63 : 0), pos = row & (SEQ - 1);
        const int j = ch * 8;
        const bf16_t* hc = HALO + (size_t)(4 * sl + (side ? 3 : 0)) * NUP;
        const bf16_t* hp = side ? HALO + (size_t)(4 * sl + 2) * NUP : (pos == 0 ? nullptr : HALO + (size_t)(4 * (sl - 1) + 3) * NUP);
        const bf16_t* hn = side ? (pos == SEQ - 1 ? nullptr : HALO + (size_t)(4 * (sl + 1)) * NUP) : HALO + (size_t)(4 * sl + 1) * NUP;
        float a[2][8];
#pragma unroll
        for (int gu = 0; gu < 2; ++gu) {
            const int col = gu * DFF + j;
            const u32x4 z = {0u, 0u, 0u, 0u};
            const u32x4 vc = *(const u32x4*)(hc + col), vp = hp ? *(const u32x4*)(hp + col) : z, vn = hn ? *(const u32x4*)(hn + col) : z;
#pragma unroll
            for (int e = 0; e < 4; ++e) {
                const int c0 = col + 2 * e;
                a[gu][2 * e] = cb[c0] + cw[c0] * bf_lo(vp[e]) + cw[NUP + c0] * bf_lo(vc[e]) + cw[2 * NUP + c0] * bf_lo(vn[e]);
                a[gu][2 * e + 1] = cb[c0 + 1] + cw[c0 + 1] * bf_hi(vp[e]) + cw[NUP + c0 + 1] * bf_hi(vc[e]) + cw[2 * NUP + c0 + 1] * bf_hi(vn[e]);
            }
        }
        u32x4 w;
        w.x = cvt_pk_bf16(silu_f(a[0][0]) * a[1][0], silu_f(a[0][1]) * a[1][1]); w.y = cvt_pk_bf16(silu_f(a[0][2]) * a[1][2], silu_f(a[0][3]) * a[1][3]);
        w.z = cvt_pk_bf16(silu_f(a[0][4]) * a[1][4], silu_f(a[0][5]) * a[1][5]); w.w = cvt_pk_bf16(silu_f(a[0][6]) * a[1][6], silu_f(a[0][7]) * a[1][7]);
        *(u32x4*)(ACT + (size_t)row * DFF + j) = w;
    }
}


#define XB_TMO      128
#define XB_XCNT(j)  (256  + 64 * (j))
#define XB_XSUB(j)  (1280 + 64 * (j))
#define XB_XGEN(j)  (2304 + 64 * (j))
#define XB_TOP      3328
#define XB_TOPGEN   3392
#define XCD_BAR_WORDS 3456
#define XB_SPIN_CAP (1u << 18)
__device__ __forceinline__ unsigned xb_ld(unsigned* p)              { return __hip_atomic_load(p, __ATOMIC_RELAXED, __HIP_MEMORY_SCOPE_AGENT); }
__device__ __forceinline__ unsigned xb_add(unsigned* p, unsigned v) { return __hip_atomic_fetch_add(p, v, __ATOMIC_RELAXED, __HIP_MEMORY_SCOPE_AGENT); }
__device__ __forceinline__ unsigned xb_xcc_id() { return (unsigned)__builtin_amdgcn_s_getreg((3 << 11) | 20) & 0xFu; }
#define XB_SPIN(cond, bar) do { unsigned _sp = 0; while (cond) { __builtin_amdgcn_s_sleep(1); \
    if ((++_sp & 255u) == 0u) { if (xb_ld(&(bar)[XB_TMO])) break; if (_sp > XB_SPIN_CAP) { atomicAdd(&(bar)[XB_TMO], 1u); break; } } } } while (0)
struct XcdBarrier { unsigned* bar; unsigned x; volatile LAS unsigned* st; };
__device__ __forceinline__ XcdBarrier xcd_barrier_post(unsigned* bar, volatile LAS unsigned* st) {
    XcdBarrier b; b.bar = bar; b.x = xb_xcc_id(); b.st = st;
    if (threadIdx.x == 0) (void)xb_add(&bar[XB_XCNT(b.x)], 1u);
    return b;
}
__device__ __forceinline__ void xcd_barrier_complete(unsigned* bar, unsigned x, unsigned& nloc, unsigned& nx) {
    const unsigned G = gridDim.x * gridDim.y * gridDim.z;
    unsigned sum, cnt, mine, sp = 0u;
    for (;;) {
        sum = 0u; cnt = 0u; mine = 0u;
#pragma unroll
        for (unsigned j = 0; j < 16; ++j) { const unsigned c = xb_ld(&bar[XB_XCNT(j)]); sum += c; cnt += (c > 0u) ? 1u : 0u; mine = (j == x) ? c : mine; }
        if (sum == G) break;
        __builtin_amdgcn_s_sleep(1);
        if ((++sp & 255u) == 0u) { if (xb_ld(&bar[XB_TMO])) break; if (sp > XB_SPIN_CAP) { atomicAdd(&bar[XB_TMO], 1u); break; } }
    }
    nloc = mine > 0u ? mine : 1u; nx = cnt > 0u ? cnt : 1u;
}
__device__ __forceinline__ void xcd_barrier(const XcdBarrier& b) {
    asm volatile("s_waitcnt vmcnt(0)" ::: "memory");
    __syncthreads();
    const unsigned lane = (unsigned)lane_id_fresh();
    bool leader = false;
    if (lane == 0) { const unsigned t = __hip_atomic_fetch_add((LAS unsigned*)(b.st + 2), 1u, __ATOMIC_RELAXED, __HIP_MEMORY_SCOPE_WORKGROUP); leader = (t & 7u) == 0u; }
    if (leader) {
        unsigned* bar = b.bar; unsigned x = b.x; asm volatile("" : "+s"(x));
        __builtin_amdgcn_s_waitcnt(0);
        unsigned nloc = b.st[0], nx = b.st[1];
        if (nloc == 0u) { xcd_barrier_complete(bar, x, nloc, nx); b.st[0] = nloc; b.st[1] = nx; }
        const unsigned old = xb_add(&bar[XB_XSUB(x)], 1u);
        const unsigned gen = old / nloc;
        if (old + 1u == (gen + 1u) * nloc) {
            __builtin_amdgcn_fence(__ATOMIC_RELEASE, "agent");
            asm volatile("s_waitcnt vmcnt(0)" ::: "memory");
            const unsigned og = xb_add(&bar[XB_TOP], 1u);
            const unsigned tg = og / nx;
            if (og + 1u == (tg + 1u) * nx) xb_add(&bar[XB_TOPGEN], 1u);
            else XB_SPIN(xb_ld(&bar[XB_TOPGEN]) == tg, bar);
            __builtin_amdgcn_fence(__ATOMIC_ACQUIRE, "agent");
            xb_add(&bar[XB_XGEN(x)], 1u);
            asm volatile("s_waitcnt vmcnt(0)" ::: "memory");
        } else {
            XB_SPIN(xb_ld(&bar[XB_XGEN(x)]) == gen, bar);
            __builtin_amdgcn_fence(__ATOMIC_ACQUIRE, "agent");
            asm volatile("s_waitcnt vmcnt(0)" ::: "memory");
        }
    }
    __syncthreads();
}

#ifndef PROBE_SEL
#define PROBE_SEL 0
#endif
#if PROBE_SEL
#define TIC(sel) do { if (PROBE_SEL == (sel)) { asm volatile("s_waitcnt vmcnt(0) lgkmcnt(0)" ::: "memory"); probe_t0 = __builtin_amdgcn_s_memrealtime(); } } while (0)
#define TOC(sel) do { if (PROBE_SEL == (sel)) { asm volatile("s_waitcnt vmcnt(0) lgkmcnt(0)" ::: "memory"); probe_acc += __builtin_amdgcn_s_memrealtime() - probe_t0; } } while (0)
#else
#define TIC(sel) do {} while (0)
#define TOC(sel) do {} while (0)
#endif
typedef const __attribute__((address_space(4))) Args* ArgsP;
#define FRESH_ARGS() ArgsP ap = (ArgsP)__builtin_amdgcn_kernarg_segment_ptr(); asm volatile("" : "+s"(ap)); unsigned char* ws = ap->ws; const int G = gridDim.x, bx = blockIdx.x
__global__ void __launch_bounds__(512, 2) fwd_megakernel(Args a_unused) {
    extern __shared__ __attribute__((aligned(16))) unsigned char lds_raw[];
    LAS unsigned char* lds = (LAS unsigned char*)lds_raw;
    cg::grid_group grid = cg::this_grid();
#if PROBE_SEL
    unsigned long long probe_t0 = 0, probe_acc = 0;
#endif
    const int wv = __builtin_amdgcn_readfirstlane(threadIdx.x >> 6);
    volatile LAS unsigned* bst = (volatile LAS unsigned*)(lds + LDS_BYTES - 16);
    if (threadIdx.x < 4) bst[threadIdx.x] = 0u;
    __syncthreads();
    if (gridDim.y == 0xFFFFu) grid.sync();
    XcdBarrier xbar;
    { FRESH_ARGS(); xbar = xcd_barrier_post((unsigned*)(ws + OFF_CTL), bst); (void)G; (void)bx; }
    {
        FRESH_ARGS();
        Args a;
#pragma unroll
        for (int i = 0; i < 18; ++i) a.in[i] = ap->in[i];
        a.out = ap->out; a.ws = ws;
        TIC(9);
#ifndef NO_P0
        prologue(a, lds, G, wv);
#endif
        TOC(9);
    }
    TIC(1); xcd_barrier(xbar); TOC(1);

    for (int l = 0; l < DEPTH; ++l) {
        for (int part = 0; part < 2; ++part) {
            FRESH_ARGS();
            const bool split = (G == 256);
            if (part == 1 && !split) break;
            pg8::Gemm g{(const bf16_t*)(ws + OFF_XB), (const bf16_t*)(ws + OFF_WIN + l * SZ_WIN), T, NIN, DM}; pg8::StaticOrder S; S.init(T, NIN, G, bx);
            if (split) { S.Lbase = part ? 768 : 0; S.Lend = part ? 896 : 768; }
            EpiIn E{(const float*)(ws + OFF_XSS), ap->in[3] + l * 128, ap->in[4] + l * 128, (const float*)(ws + OFF_COS), (const float*)(ws + OFF_SIN),
                    (bf16_t*)(ws + OFF_Q), (bf16_t*)(ws + OFF_K), (bf16_t*)(ws + OFF_V), (bf16_t*)(ws + OFF_GU), (bf16_t*)(ws + OFF_GV),
                    (float*)(ws + OFF_QSS), (float*)(ws + OFF_KSS), (float*)(ws + OFF_GVS)};
            TIC(7);
#ifndef NO_IN
            pg8::gemm_phase(lds, g, S, E, wv);
#endif
            TOC(7);
            if (part == 0) { TIC(1); xcd_barrier(xbar); TOC(1); }
        }
        {
            FRESH_ARGS();
            TIC(2);
#ifndef NO_ATT
            if (G == 256) {
                const int heavy = bx >= 128;
                const int idx = (bx % 8) * 16 + (heavy ? (bx - 128) / 8 : bx / 8);
                const int u0 = heavy ? 3 * idx : 384 + idx, nu = heavy ? 3 : 1;
                for (int u = u0; u < u0 + nu; ++u) attn_unit(lds, u, ap->in[5] + l * 8, (const bf16_t*)(ws + OFF_Q), (const bf16_t*)(ws + OFF_K), (const bf16_t*)(ws + OFF_V),
                                                             (const float*)(ws + OFF_QSS), (const float*)(ws + OFF_KSS), (bf16_t*)(ws + OFF_MIX), wv);
            } else {
                for (int u = bx; u < 512; u += G) attn_unit(lds, u, ap->in[5] + l * 8, (const bf16_t*)(ws + OFF_Q), (const bf16_t*)(ws + OFF_K), (const bf16_t*)(ws + OFF_V),
                                                            (const float*)(ws + OFF_QSS), (const float*)(ws + OFF_KSS), (bf16_t*)(ws + OFF_MIX), wv);
            }
#endif
            TOC(2);
        }
        TIC(1); xcd_barrier(xbar); TOC(1);
        {
            FRESH_ARGS();
            TIC(3);
#ifndef NO_SGU
            for (int u = bx; u < 256; u += G) sgu_unit(lds, u, (const bf16_t*)(ws + OFF_GU), (const bf16_t*)(ws + OFF_GV), (const float*)(ws + OFF_GVS), ap->in[6] + l * 1024, ap->in[7] + l * 1024,
                                                       (const bf16_t*)(ws + OFF_WS) + (size_t)l * 8 * 128 * 128, (const float*)(ws + OFF_RSW) + l * 1024, ap->in[9] + l * 1024, (bf16_t*)(ws + OFF_MIX), wv);
#endif
            TOC(3);
        }
        TIC(1); xcd_barrier(xbar); TOC(1);
        {
            FRESH_ARGS();
            pg8::Gemm g{(const bf16_t*)(ws + OFF_MIX), (const bf16_t*)(ws + OFF_WO + l * SZ_WO), T, DM, DM}; pg8::StaticOrder S; S.init(T, DM, G, bx);
            EpiRes E{nullptr, (bf16_t*)(ws + OFF_XB), (float*)(ws + OFF_XSS)};
            TIC(5);
#ifndef NO_WO
            pg8::gemm_phase(lds, g, S, E, wv);
#endif
            TOC(5);
        }
        TIC(1); xcd_barrier(xbar); TOC(1);
        {
            FRESH_ARGS();
            pg8::Gemm g{(const bf16_t*)(ws + OFF_XB), (const bf16_t*)(ws + OFF_WUP + l * SZ_WUP), T, NUP, DM}; pg8::StaticOrder S; S.init(T, NUP, G, bx);
            EpiUp E{(const float*)(ws + OFF_XSS), ap->in[15] + (size_t)l * 3 * NUP, ap->in[16] + (size_t)l * NUP, (bf16_t*)(ws + OFF_ACT), (bf16_t*)(ws + OFF_HALO)};
            TIC(8);
#ifndef NO_UP
            pg8::gemm_phase(lds, g, S, E, wv);
#endif
            TOC(8);
        }
        TIC(1); xcd_barrier(xbar); TOC(1);
        {
            FRESH_ARGS();
            TIC(4);
#ifndef NO_FIX
            fixup_phase((const bf16_t*)(ws + OFF_HALO), ap->in[15] + (size_t)l * 3 * NUP, ap->in[16] + (size_t)l * NUP, (bf16_t*)(ws + OFF_ACT), G, wv);
#endif
            TOC(4);
        }
        TIC(1); xcd_barrier(xbar); TOC(1);
        {
            FRESH_ARGS();
            pg8::Gemm g{(const bf16_t*)(ws + OFF_ACT), (const bf16_t*)(ws + OFF_WDN + l * SZ_WDN), T, DM, DFF}; pg8::StaticOrder S; S.init(T, DM, G, bx);
            EpiRes E{l + 1 == DEPTH ? ap->out : nullptr, (bf16_t*)(ws + OFF_XB), (float*)(ws + OFF_XSS)};
            TIC(6);
#ifndef NO_DN
            pg8::gemm_phase(lds, g, S, E, wv);
#endif
            TOC(6);
        }
        if (l + 1 < DEPTH) { TIC(1); xcd_barrier(xbar); TOC(1); }
    }
#if PROBE_SEL
    { const unsigned long long until = __builtin_amdgcn_s_memrealtime() + 4ull * probe_acc; while (__builtin_amdgcn_s_memrealtime() < until) __builtin_amdgcn_s_sleep(16); }
#endif
}

extern "C" void kernel_launch(void* const* d_in, const int* in_sizes, int n_in, void* d_out, int out_size, void* d_ws, size_t ws_size, hipStream_t stream) {
    static int grid = 0;
    if (grid == 0) {
        if (n_in != 18 || out_size != T * DM || ws_size < WS_END) { fprintf(stderr, "kernel_launch: unexpected problem (n_in %d, out %d, ws %zu < %zu)\n", n_in, out_size, ws_size, (size_t)WS_END); grid = -1; return; }
        int dev = 0, cus = 0, per_cu = 0;
        hipGetDevice(&dev);
        hipDeviceGetAttribute(&cus, hipDeviceAttributeMultiprocessorCount, dev);
        hipFuncSetAttribute((const void*)fwd_megakernel, hipFuncAttributeMaxDynamicSharedMemorySize, LDS_BYTES);
        hipOccupancyMaxActiveBlocksPerMultiprocessor(&per_cu, (const void*)fwd_megakernel, 512, LDS_BYTES);
        if (per_cu < 1) per_cu = 1;
        grid = cus * per_cu;
        (void)hipGetLastError();
    }
    if (grid < 0) return;
    Args a{};
    for (int i = 0; i < 18; ++i) a.in[i] = (const float*)d_in[i];
    a.out = (float*)d_out; a.ws = (unsigned char*)d_ws;
    (void)hipMemsetAsync((unsigned char*)d_ws + OFF_CTL, 0, CTL_BYTES, stream);
    void* args[] = {&a};
    hipError_t e = hipLaunchCooperativeKernel((const void*)fwd_megakernel, dim3(grid), dim3(512), args, LDS_BYTES, stream);
    if (e != hipSuccess) fprintf(stderr, "cooperative launch failed: %s (grid %d)\n", hipGetErrorString(e), grid);
}
```

```cpp
#include <hip/hip_runtime.h>
#include <hip/hip_cooperative_groups.h>
#include <cstdio>
#include <cstdint>
namespace cg = cooperative_groups;

#define LAS __attribute__((address_space(3)))
typedef unsigned short bf16_t;
typedef short bf16x8 __attribute__((ext_vector_type(8)));
typedef short s16x4 __attribute__((ext_vector_type(4)));
typedef float f32x4 __attribute__((ext_vector_type(4)));
typedef float f32x2 __attribute__((ext_vector_type(2)));
typedef float f32x16 __attribute__((ext_vector_type(16)));
typedef unsigned u32x4 __attribute__((ext_vector_type(4)));
typedef unsigned u32x2 __attribute__((ext_vector_type(2)));
typedef __bf16 bf16x2_t __attribute__((ext_vector_type(2)));

constexpr int T = 16384, SEQ = 2048, DM = 2048, NIN = 3584, DFF = 5632, NUP = 11264, DEPTH = 2;
constexpr float EPS = 1e-6f;
constexpr float LOG2E = 1.4426950408889634f;

constexpr size_t SZ_WIN = (size_t)NIN * DM * 2, SZ_WO = (size_t)DM * DM * 2, SZ_WUP = (size_t)NUP * DM * 2, SZ_WDN = (size_t)DM * DFF * 2;
constexpr size_t OFF_WIN = 0;
constexpr size_t OFF_WO = OFF_WIN + DEPTH * SZ_WIN;
constexpr size_t OFF_WUP = OFF_WO + DEPTH * SZ_WO;
constexpr size_t OFF_WDN = OFF_WUP + DEPTH * SZ_WUP;
constexpr size_t OFF_WS = OFF_WDN + DEPTH * SZ_WDN;
constexpr size_t OFF_COS = OFF_WS + (size_t)DEPTH * 8 * 128 * 128 * 2;
constexpr size_t OFF_SIN = OFF_COS + (size_t)SEQ * 64 * 4;
constexpr size_t OFF_XB = OFF_SIN + (size_t)SEQ * 64 * 4;
constexpr size_t OFF_XSS = OFF_XB + (size_t)T * DM * 2;
constexpr size_t OFF_Q = OFF_XSS + (size_t)T * 32 * 4;
constexpr size_t OFF_K = OFF_Q + (size_t)T * 1024 * 2;
constexpr size_t OFF_V = OFF_K + (size_t)T * 256 * 2;
constexpr size_t OFF_GU = OFF_V + (size_t)T * 256 * 2;
constexpr size_t OFF_GV = OFF_GU + (size_t)T * 1024 * 2;
constexpr size_t OFF_MIX = OFF_GV + (size_t)T * 1024 * 2;
constexpr size_t OFF_QSS = OFF_MIX + (size_t)T * DM * 2;
constexpr size_t OFF_KSS = OFF_QSS + (size_t)T * 32 * 4;
constexpr size_t OFF_GVS = OFF_KSS + (size_t)T * 8 * 4;
constexpr size_t OFF_ACT = OFF_GVS + (size_t)T * 32 * 4;
constexpr size_t OFF_HALO = OFF_ACT + (size_t)T * DFF * 2;
constexpr size_t OFF_RSW = OFF_HALO + (size_t)(T / 64 * 4) * NUP * 2;
constexpr size_t OFF_CTL = OFF_RSW + (size_t)DEPTH * 8 * 128 * 4;
constexpr size_t CTL_BYTES = 16384;
constexpr size_t WS_END = OFF_CTL + CTL_BYTES;

constexpr int LDS_BYTES = 147456;

__device__ __forceinline__ unsigned cvt_pk_bf16(float lo, float hi) { f32x2 v = {lo, hi}; bf16x2_t b = __builtin_convertvector(v, bf16x2_t); return __builtin_bit_cast(unsigned, b); }
__device__ __forceinline__ float bf_lo(unsigned u) { return __uint_as_float(u << 16); }
__device__ __forceinline__ float bf_hi(unsigned u) { return __uint_as_float(u & 0xffff0000u); }
__device__ __forceinline__ float gelu_tanh(float x) {
    const float u = 0.7978845608028654f * (x + 0.044715f * x * x * x);
    const float e = __builtin_amdgcn_exp2f(-2.0f * LOG2E * u);
    return x * __builtin_amdgcn_rcpf(1.0f + e);
}
__device__ __forceinline__ float silu_f(float x) { const float e = __builtin_amdgcn_exp2f(-LOG2E * x); return x * __builtin_amdgcn_rcpf(1.0f + e); }
__device__ __forceinline__ float dot4(f32x4 a) { return (a.x * a.x + a.y * a.y) + (a.z * a.z + a.w * a.w); }
__device__ __forceinline__ float sum4(f32x4 a) { return (a.x + a.y) + (a.z + a.w); }
__device__ __forceinline__ int crow(int r, int hi) { return (r & 3) + 8 * (r >> 2) + 4 * hi; }
__device__ __forceinline__ float wave_sum(float v) {
#pragma unroll
    for (int o = 1; o < 64; o <<= 1) v += __shfl_xor(v, o);
    return v;
}

__device__ __forceinline__ float dpp_prev(float v) { return __int_as_float(__builtin_amdgcn_mov_dpp(__float_as_int(v), 0x121, 0xF, 0xF, false)); }
__device__ __forceinline__ float dpp_next(float v) { return __int_as_float(__builtin_amdgcn_mov_dpp(__float_as_int(v), 0x12F, 0xF, 0xF, false)); }

__device__ __forceinline__ int lane_id_fresh() { int l; asm volatile("v_mbcnt_lo_u32_b32 %0, -1, 0\n\tv_mbcnt_hi_u32_b32 %0, -1, %0" : "=v"(l)); return l; }
__device__ __forceinline__ int fresh_tid(int wv) { return wv * 64 + lane_id_fresh(); }

namespace pg8 {
constexpr int BM = 256, BK = 64, HALF = 128, HTB = HALF * BK * 2, STAGE_BYTES = 8 * HTB, NXCD = 8, WGM = 8;
__host__ __device__ __forceinline__ int lds_byte(int r, int c) { const int st = (r >> 4) * 2 + (c >> 5), rr = r & 15, cc = c & 31, ob = rr * 64 + cc * 2; return st * 1024 + (ob ^ (((ob >> 9) & 1) << 5)); }
__host__ __device__ __forceinline__ void stage_rc(int b, int& R, int& C) { const int st = b / 1024, sb = b % 1024, swz = sb ^ (((sb >> 9) & 1) << 5); R = (st >> 1) * 16 + swz / 64; C = (st & 1) * 32 + (swz % 64) / 2; }
__host__ __device__ __forceinline__ int perm32(int rho) { const int n = rho >> 4, i = rho & 15; return 8 * (i >> 2) + 4 * n + (i & 3); }
struct Unit { int pm, pn; };
struct Gemm { const bf16_t* A; const bf16_t* Bt; int M, N, K; };
struct StaticOrder {
    int nM, nN, nwg, G, c, Lbase, Lend;
    __host__ __device__ void init(int M, int N, int G_, int c_) { nM = M / BM; nN = N / BM; nwg = nM * nN; G = G_; c = c_; Lbase = 0; Lend = nwg; }
    __host__ __device__ bool next(int i, Unit& u) const {
        const long L = (long)Lbase + (long)i * G + c; if (L >= Lend) return false;
        int wgid = (int)L; { const int q = nwg / NXCD, r = nwg % NXCD, xcd = wgid % NXCD, off = wgid / NXCD; wgid = (xcd < r ? xcd * (q + 1) : r * (q + 1) + (xcd - r) * q) + off; }
        const int nig = WGM * nN, gid = wgid / nig, fm = gid * WGM, gsz = (nM - fm) < WGM ? (nM - fm) : WGM;
        u.pm = fm + ((wgid % nig) % gsz); u.pn = (wgid % nig) / gsz; return true;
    }
};

template <class Epi, class Sched>
__device__ __forceinline__ void gemm_phase(LAS unsigned char* lds, const Gemm g, const Sched& S, const Epi& E, int wv) {
    const int tid = fresh_tid(wv);
    const int wid = __builtin_amdgcn_readfirstlane(tid >> 6), lane = tid & 63, wr = wid >> 2, wc = wid & 3, fr = lane & 15, fq = lane >> 4;
    const int K = g.K, nt = K / BK;
    unsigned voffA[2], voffB[2];
#pragma unroll
    for (int i = 0; i < 2; ++i) { int R, C; stage_rc(tid * 16 + i * 8192, R, C); const int Rb = (R & ~31) + perm32(R & 31);
        voffA[i] = (unsigned)(R * K + C) * 2u; voffB[i] = (unsigned)(Rb * K + C) * 2u; }
    const size_t kstep = (size_t)(BK * 2);
    const size_t hstep = (size_t)HALF * K * 2;
    const size_t tstep = 2 * hstep;
    const unsigned ldsw = (unsigned)wid * 1024u;
    const int aoff = lds_byte(wr * 64 + fr, fq * 8), boff = lds_byte(wc * 32 + fr, fq * 8);
#define PG8_SA(b, h) (((b) * 2 + (h)) * HTB)
#define PG8_SB(b, h) ((4 + (b) * 2 + (h)) * HTB)
#define PG8_STAGE(bufoff, gbase, voff) do { _Pragma("unroll") for (int _i = 0; _i < 2; ++_i) \
        __builtin_amdgcn_global_load_lds((const unsigned*)((const char*)(gbase) + (voff)[_i]), (LAS unsigned*)(lds + (bufoff) + ldsw + _i * 8192), 16, 0, 0); } while (0)
#define PG8_LDA(dst, b, h) do { _Pragma("unroll") for (int m = 0; m < 4; ++m) _Pragma("unroll") for (int k = 0; k < 2; ++k) dst[m][k] = *(const LAS bf16x8*)(lds + PG8_SA(b, h) + aoff + m * 2048 + k * 1024); } while (0)
#define PG8_LDB(dst, b, h) do { _Pragma("unroll") for (int n = 0; n < 2; ++n) _Pragma("unroll") for (int k = 0; k < 2; ++k) dst[n][k] = *(const LAS bf16x8*)(lds + PG8_SB(b, h) + boff + n * 2048 + k * 1024); } while (0)
#define PG8_MMA(ai, bj, At, Bt) do { __builtin_amdgcn_s_setprio(1); _Pragma("unroll") for (int m = 0; m < 4; ++m) _Pragma("unroll") for (int n = 0; n < 2; ++n) _Pragma("unroll") for (int k = 0; k < 2; ++k) \
        acc[ai][bj][m][n] = __builtin_amdgcn_mfma_f32_16x16x32_bf16(Bt[n][k], At[m][k], acc[ai][bj][m][n], 0, 0, 0); __builtin_amdgcn_s_setprio(0); } while (0)
#define PG8_WAIT_V(n) asm volatile("s_waitcnt vmcnt(" #n ")" ::: "memory")
#define PG8_WAIT_L(n) asm volatile("s_waitcnt lgkmcnt(" #n ")" ::: "memory")
#define PG8_BAR __builtin_amdgcn_s_barrier()
#define PG8_SCHED __builtin_amdgcn_sched_barrier(0)
    Unit cur, nxt; int ui = 0;
    if (!S.next(0, cur)) return;
    f32x4 acc[2][2][4][2];
#pragma unroll
    for (int a = 0; a < 2; ++a)
#pragma unroll
        for (int b = 0; b < 2; ++b)
#pragma unroll
            for (int m = 0; m < 4; ++m)
#pragma unroll
                for (int n = 0; n < 2; ++n) acc[a][b][m][n] = (f32x4){0.f, 0.f, 0.f, 0.f};
    bf16x8 At[4][2], B0[2][2], B1[2][2];
    const char* cA = (const char*)g.A + (size_t)cur.pm * tstep; const char* cB = (const char*)g.Bt + (size_t)cur.pn * tstep;
    PG8_STAGE(PG8_SB(0, 0), cB, voffB); PG8_STAGE(PG8_SB(0, 1), cB + hstep, voffB); PG8_STAGE(PG8_SA(0, 0), cA, voffA); PG8_STAGE(PG8_SA(0, 1), cA + hstep, voffA);
    if (wr == 1) PG8_BAR;
    PG8_WAIT_V(2); PG8_BAR;
    PG8_STAGE(PG8_SB(1, 0), cB + kstep, voffB); PG8_STAGE(PG8_SA(1, 0), cA + kstep, voffA); PG8_STAGE(PG8_SB(1, 1), cB + hstep + kstep, voffB);
    PG8_WAIT_V(6); PG8_BAR;
    for (;;) {
        const bool has_next = S.next(ui + 1, nxt);
        const char* nA = has_next ? (const char*)g.A + (size_t)nxt.pm * tstep : cA; const char* nB = has_next ? (const char*)g.Bt + (size_t)nxt.pn * tstep : cB;
        for (int t = 0; t < nt; t += 2) {
            const bool last = (t == nt - 2);
            const char* a1 = cA + (size_t)(t + 1) * kstep;
            const char* a2 = last ? nA : cA + (size_t)(t + 2) * kstep; const char* b2 = last ? nB : cB + (size_t)(t + 2) * kstep;
            const char* a3 = a2 + kstep; const char* b3 = b2 + kstep;
            PG8_LDB(B0, 0, 0); PG8_LDB(B1, 0, 1); PG8_SCHED; PG8_LDA(At, 0, 0); PG8_STAGE(PG8_SA(1, 1), a1 + hstep, voffA);
            PG8_WAIT_V(8); PG8_WAIT_L(0); PG8_BAR; PG8_MMA(0, 0, At, B0); PG8_MMA(0, 1, At, B1); PG8_BAR; PG8_SCHED;
            PG8_LDA(At, 0, 1); PG8_STAGE(PG8_SB(0, 0), b2, voffB); PG8_STAGE(PG8_SB(0, 1), b2 + hstep, voffB); PG8_STAGE(PG8_SA(0, 0), a2, voffA);
            PG8_WAIT_V(8); PG8_WAIT_L(0); PG8_BAR; PG8_MMA(1, 0, At, B0); PG8_MMA(1, 1, At, B1); PG8_BAR; PG8_SCHED;
            PG8_LDB(B0, 1, 0); PG8_LDB(B1, 1, 1); PG8_SCHED; PG8_LDA(At, 1, 0); PG8_STAGE(PG8_SA(0, 1), a2 + hstep, voffA);
            PG8_WAIT_V(8); PG8_WAIT_L(0); PG8_BAR; PG8_MMA(0, 0, At, B0); PG8_MMA(0, 1, At, B1); PG8_BAR; PG8_SCHED;
            PG8_LDA(At, 1, 1); PG8_STAGE(PG8_SB(1, 0), b3, voffB); PG8_STAGE(PG8_SB(1, 1), b3 + hstep, voffB); PG8_STAGE(PG8_SA(1, 0), a3, voffA);
            PG8_WAIT_V(8); PG8_WAIT_L(0); PG8_BAR; PG8_MMA(1, 0, At, B0); PG8_MMA(1, 1, At, B1); PG8_BAR; PG8_SCHED;
        }
        if (wr == 0) PG8_BAR;
        E(acc, cur, wr, wc, fr, fq);
        if (!has_next) break;
#pragma unroll
        for (int a = 0; a < 2; ++a)
#pragma unroll
            for (int b = 0; b < 2; ++b)
#pragma unroll
                for (int m = 0; m < 4; ++m)
#pragma unroll
                    for (int n = 0; n < 2; ++n) acc[a][b][m][n] = (f32x4){0.f, 0.f, 0.f, 0.f};
        cur = nxt; cA = nA; cB = nB; ++ui;
        if (wr == 1) PG8_BAR;
    }
    PG8_WAIT_V(0);
    PG8_BAR;
#undef PG8_SA
#undef PG8_SB
#undef PG8_STAGE
#undef PG8_LDA
#undef PG8_LDB
#undef PG8_MMA
#undef PG8_WAIT_V
#undef PG8_WAIT_L
#undef PG8_BAR
#undef PG8_SCHED
}
}
using pg8::Unit;

__device__ __forceinline__ void row_rstd(const float* xss, int row0, int fq, float (&r)[2][4]) {
    f32x4 a[8], b[8];
#pragma unroll
    for (int i = 0; i < 8; ++i) { const f32x4* p = (const f32x4*)(xss + (size_t)(row0 + 128 * (i >> 2) + 16 * (i & 3)) * 32 + 8 * fq); a[i] = p[0]; b[i] = p[1]; }
#pragma unroll
    for (int i = 0; i < 8; ++i) {
        float s = sum4(a[i]) + sum4(b[i]);
        s += __shfl_xor(s, 16); s += __shfl_xor(s, 32);
        r[i >> 2][i & 3] = rsqrtf(s * (1.0f / DM) + EPS);
    }
    asm volatile("" ::: "memory");
}

struct EpiIn {
    const float* xss; const float* qg; const float* kg; const float* cosT; const float* sinT;
    bf16_t *Q, *K, *V, *GU, *GV; float *qss, *kss, *gvs;
    __device__ __forceinline__ void operator()(const f32x4 (&acc)[2][2][4][2], const Unit& u, int wr, int wc, int fr, int fq) const {
        asm volatile("" : "+v"(fr), "+v"(fq));
        const int row0 = u.pm * 256 + wr * 64 + fr;
        float rr[2][4]; row_rstd(xss, row0, fq, rr);
        const int pn = u.pn;
        if (pn < 5) {
            const bool isq = pn < 4;
            const float* gn = isq ? qg : kg;
            const int gg = 4 * wc + fq;
            const f32x4 glo = *(const f32x4*)(gn + 4 * gg), ghi = *(const f32x4*)(gn + 64 + 4 * gg);
#pragma unroll
            for (int ai = 0; ai < 2; ++ai) {
                f32x4 cs[4], sn[4];
#pragma unroll
                for (int i = 0; i < 4; ++i) { const int pos = (row0 + 128 * ai + 16 * i) & (SEQ - 1); cs[i] = *(const f32x4*)(cosT + pos * 64 + 4 * gg); sn[i] = *(const f32x4*)(sinT + pos * 64 + 4 * gg); }
#pragma unroll
                for (int m = 0; m < 4; ++m) {
                    const int row = row0 + 128 * ai + 16 * m;
                    const f32x4 c = cs[m], s = sn[m];
                    const float r = rr[ai][m];
#pragma unroll
                    for (int bj = 0; bj < 2; ++bj) {
                        const f32x4 v0 = acc[ai][bj][m][0] * r, v1 = acc[ai][bj][m][1] * r;
                        float ss = dot4(v0) + dot4(v1);
                        ss += __shfl_xor(ss, 16); ss += __shfl_xor(ss, 32);
                        const int head = isq ? 2 * pn + bj : bj;
                        if (fq == 0) { if (isq) qss[((size_t)row * 8 + head) * 4 + wc] = ss; else kss[((size_t)row * 2 + head) * 4 + wc] = ss; }
                        const f32x4 y0 = v0 * glo, y1 = v1 * ghi;
                        const f32x4 lo = y0 * c - y1 * s, hi = y1 * c + y0 * s;
                        bf16_t* dst = (isq ? Q + (size_t)row * 1024 : K + (size_t)row * 256) + head * 128;
                        u32x2 wl, wh; wl.x = cvt_pk_bf16(lo.x, lo.y); wl.y = cvt_pk_bf16(lo.z, lo.w); wh.x = cvt_pk_bf16(hi.x, hi.y); wh.y = cvt_pk_bf16(hi.z, hi.w);
                        *(u32x2*)(dst + 4 * gg) = wl; *(u32x2*)(dst + 64 + 4 * gg) = wh;
                    }
                }
                asm volatile("" ::: "memory");
            }
        } else if (pn == 5) {
#pragma unroll
            for (int ai = 0; ai < 2; ++ai)
#pragma unroll
                for (int m = 0; m < 4; ++m) {
                    const int row = row0 + 128 * ai + 16 * m; const float r = rr[ai][m];
#pragma unroll
                    for (int bj = 0; bj < 2; ++bj) {
                        const f32x4 v0 = acc[ai][bj][m][0] * r, v1 = acc[ai][bj][m][1] * r;
                        u32x4 w; w.x = cvt_pk_bf16(v0.x, v0.y); w.y = cvt_pk_bf16(v0.z, v0.w); w.z = cvt_pk_bf16(v1.x, v1.y); w.w = cvt_pk_bf16(v1.z, v1.w);
                        *(u32x4*)(V + (size_t)row * 256 + bj * 128 + 32 * wc + 8 * fq) = w;
                    }
                }
        } else {
            const bool isgv = pn >= 10;
            const int ct = isgv ? pn - 10 : pn - 6;
            bf16_t* dstb = (isgv ? GV : GU) + ct * 256 + 32 * wc + 8 * fq;
#pragma unroll
            for (int ai = 0; ai < 2; ++ai)
#pragma unroll
                for (int m = 0; m < 4; ++m) {
                    const int row = row0 + 128 * ai + 16 * m; const float r = rr[ai][m];
                    float s1 = 0.f, s2 = 0.f;
#pragma unroll
                    for (int bj = 0; bj < 2; ++bj) {
                        f32x4 v0 = acc[ai][bj][m][0] * r, v1 = acc[ai][bj][m][1] * r;
                        v0.x = gelu_tanh(v0.x); v0.y = gelu_tanh(v0.y); v0.z = gelu_tanh(v0.z); v0.w = gelu_tanh(v0.w);
                        v1.x = gelu_tanh(v1.x); v1.y = gelu_tanh(v1.y); v1.z = gelu_tanh(v1.z); v1.w = gelu_tanh(v1.w);
                        s1 += sum4(v0) + sum4(v1); s2 += dot4(v0) + dot4(v1);
                        u32x4 w; w.x = cvt_pk_bf16(v0.x, v0.y); w.y = cvt_pk_bf16(v0.z, v0.w); w.z = cvt_pk_bf16(v1.x, v1.y); w.w = cvt_pk_bf16(v1.z, v1.w);
                        *(u32x4*)(dstb + (size_t)row * 1024 + bj * 128) = w;
                    }
                    if (isgv) {
                        s1 += __shfl_xor(s1, 16); s1 += __shfl_xor(s1, 32);
                        s2 += __shfl_xor(s2, 16); s2 += __shfl_xor(s2, 32);
                        if (fq == 0) *(f32x2*)(gvs + ((size_t)row * 16 + ct * 4 + wc) * 2) = (f32x2){s1, s2};
                    }
                    asm volatile("" ::: "memory");
                }
        }
    }
};

struct EpiRes {
    float* out; bf16_t* xb; float* xss;
    __device__ __forceinline__ void operator()(const f32x4 (&acc)[2][2][4][2], const Unit& u, int wr, int wc, int fr, int fq) const {
        asm volatile("" : "+v"(fr), "+v"(fq));
        const int row0 = u.pm * 256 + wr * 64 + fr, col0 = u.pn * 256 + 32 * wc + 8 * fq;
#pragma unroll
        for (int ai = 0; ai < 2; ++ai) {
            u32x4 bv[2][4][2];
#pragma unroll
            for (int m = 0; m < 4; ++m)
#pragma unroll
                for (int bj = 0; bj < 2; ++bj) bv[ai][m][bj] = *(const u32x4*)(xb + (size_t)(row0 + 128 * ai + 16 * m) * DM + col0 + bj * 128);
#pragma unroll
            for (int m = 0; m < 4; ++m) {
                const int row = row0 + 128 * ai + 16 * m; float ss = 0.f;
#pragma unroll
                for (int bj = 0; bj < 2; ++bj) {
                    const size_t off = (size_t)row * DM + col0 + bj * 128;
                    const u32x4 b = bv[ai][m][bj];
                    const f32x4 o0 = (f32x4){bf_lo(b.x), bf_hi(b.x), bf_lo(b.y), bf_hi(b.y)} + acc[ai][bj][m][0];
                    const f32x4 o1 = (f32x4){bf_lo(b.z), bf_hi(b.z), bf_lo(b.w), bf_hi(b.w)} + acc[ai][bj][m][1];
                    if (out) { *(f32x4*)(out + off) = o0; *(f32x4*)(out + off + 4) = o1; }
                    else {
                        u32x4 w; w.x = cvt_pk_bf16(o0.x, o0.y); w.y = cvt_pk_bf16(o0.z, o0.w); w.z = cvt_pk_bf16(o1.x, o1.y); w.w = cvt_pk_bf16(o1.z, o1.w);
                        *(u32x4*)(xb + off) = w;
                        ss += dot4(o0) + dot4(o1);
                    }
                }
                if (!out) {
                    ss += __shfl_xor(ss, 16); ss += __shfl_xor(ss, 32);
                    if (fq == 0) xss[(size_t)row * 32 + u.pn * 4 + wc] = ss;
                }
            }
            asm volatile("" ::: "memory");
        }
    }
};

struct EpiUp {
    const float* xss; const float* cw; const float* cb; bf16_t* ACT; bf16_t* HALO;
    __device__ __forceinline__ void operator()(f32x4 (&acc)[2][2][4][2], const Unit& u, int wr, int wc, int fr, int fq) const {
        asm volatile("" : "+v"(fr), "+v"(fq));
        const int row0 = u.pm * 256 + wr * 64 + fr;
        float rr[2][4]; row_rstd(xss, row0, fq, rr);
        const int jg = u.pn * 128 + 32 * wc + 8 * fq;
#pragma unroll
        for (int ai = 0; ai < 2; ++ai)
#pragma unroll
            for (int m = 0; m < 4; ++m) {
                const float r = rr[ai][m];
#pragma unroll
                for (int bj = 0; bj < 2; ++bj) { acc[ai][bj][m][0] *= r; acc[ai][bj][m][1] *= r; }
                if (m == 0 || m == 3) {
                    const bool hal = (m == 0) ? (fr < 2) : (fr >= 14);
                    if (hal) {
                        const int row = row0 + 128 * ai + 16 * m;
                        const int hr = (row >> 6) * 4 + (m == 0 ? fr : fr - 12);
#pragma unroll
                        for (int bj = 0; bj < 2; ++bj) {
                            const f32x4 v0 = acc[ai][bj][m][0], v1 = acc[ai][bj][m][1];
                            u32x4 w; w.x = cvt_pk_bf16(v0.x, v0.y); w.y = cvt_pk_bf16(v0.z, v0.w); w.z = cvt_pk_bf16(v1.x, v1.y); w.w = cvt_pk_bf16(v1.z, v1.w);
                            *(u32x4*)(HALO + (size_t)hr * NUP + (bj ? DFF : 0) + jg) = w;
                        }
                    }
                }
            }
        __builtin_amdgcn_sched_barrier(0);
#pragma unroll
        for (int n = 0; n < 2; ++n) {
            f32x4 wv[2][2][4];
#pragma unroll
            for (int bj = 0; bj < 2; ++bj) {
                const int col = (bj ? DFF : 0) + jg + 4 * n;
                const float ksc = bj ? -0.6931471805599453f : -LOG2E;
                wv[n][bj][0] = *(const f32x4*)(cw + col) * ksc; wv[n][bj][1] = *(const f32x4*)(cw + NUP + col) * ksc; wv[n][bj][2] = *(const f32x4*)(cw + 2 * NUP + col) * ksc; wv[n][bj][3] = *(const f32x4*)(cb + col) * ksc;
            }
#pragma unroll
            for (int e = 0; e < 4; ++e) {
#pragma unroll
                for (int ai = 0; ai < 2; ++ai) {
                    float a[2][4];
#pragma unroll
                    for (int bj = 0; bj < 2; ++bj) {
                        float raw[4], P[4], N[4];
#pragma unroll
                        for (int m = 0; m < 4; ++m) raw[m] = acc[ai][bj][m][n][e];
                        asm volatile("" : "+v"(raw[0]), "+v"(raw[1]), "+v"(raw[2]), "+v"(raw[3]));
#pragma unroll
                        for (int m = 0; m < 4; ++m) { P[m] = dpp_prev(raw[m]); N[m] = dpp_next(raw[m]); }
#pragma unroll
                        for (int m = 0; m < 4; ++m) {
                            const float prev = fr > 0 ? P[m] : (m > 0 ? P[m > 0 ? m - 1 : 0] : 0.f);
                            const float next = fr < 15 ? N[m] : (m < 3 ? N[m < 3 ? m + 1 : 3] : 0.f);
                            a[bj][m] = __builtin_fmaf(wv[n][bj][0][e], prev, __builtin_fmaf(wv[n][bj][1][e], raw[m], __builtin_fmaf(wv[n][bj][2][e], next, wv[n][bj][3][e])));
                        }
                        asm volatile("" : "+v"(a[bj][0]), "+v"(a[bj][1]), "+v"(a[bj][2]), "+v"(a[bj][3]));
                    }
#pragma unroll
                    for (int m = 0; m < 4; ++m) acc[ai][0][m][n][e] = (a[0][m] * a[1][m]) * __builtin_amdgcn_rcpf(1.0f + __builtin_amdgcn_exp2f(a[0][m]));
                }
            }
        }
#pragma unroll
        for (int ai = 0; ai < 2; ++ai)
#pragma unroll
            for (int m = 0; m < 4; ++m) {
                const int row = row0 + 128 * ai + 16 * m;
                const bool edge = (m == 0 && fr == 0) || (m == 3 && fr == 15);
                if (!edge) {
                    const f32x4 v0 = acc[ai][0][m][0], v1 = acc[ai][0][m][1];
                    u32x4 w; w.x = cvt_pk_bf16(v0.x, v0.y); w.y = cvt_pk_bf16(v0.z, v0.w); w.z = cvt_pk_bf16(v1.x, v1.y); w.w = cvt_pk_bf16(v1.z, v1.w);
                    *(u32x4*)(ACT + (size_t)row * DFF + jg) = w;
                }
            }
    }
};

struct Args { const float* in[18]; float* out; unsigned char* ws; };

__device__ __forceinline__ int cmap_in(int n) {
    if (n >= 1280) return n;
    const int head = n >> 7, c = n & 127, g = c >> 3, j = c & 7;
    return head * 128 + ((j < 4) ? 4 * g + j : 64 + 4 * g + (j - 4));
}
__device__ __forceinline__ int cmap_up(int n) { const int pn = n >> 8, c = n & 255; return (c < 128) ? 128 * pn + c : DFF + 128 * pn + (c - 128); }

template <int MODE>
__device__ __forceinline__ void transpose_item(const float* W, int K, int N, bf16_t* WT, const float* gk, LAS float* scr, int item, int lane) {
    const int nblk = N / 64, kb = item / nblk, nb = item % nblk, k0 = 64 * kb, n0 = 64 * nb;
    const int c4 = lane & 15, r4 = lane >> 4;
    const int nn = n0 + 4 * c4;
    const int sc = MODE == 1 ? cmap_in(nn) : (MODE == 2 ? cmap_up(nn) : nn);
    f32x4 v[16];
    const float* src = W + (size_t)(k0 + r4) * N + sc;
#pragma unroll
    for (int i = 0; i < 16; ++i) v[i] = __builtin_nontemporal_load((const f32x4*)(src + (size_t)(4 * i) * N));
    if (gk) {
#pragma unroll
        for (int i = 0; i < 16; ++i) v[i] *= gk[k0 + 4 * i + r4];
    }
#pragma unroll
    for (int i = 0; i < 16; ++i) { LAS float* d = scr + (4 * i + r4) * 65 + 4 * c4; d[0] = v[i].x; d[1] = v[i].y; d[2] = v[i].z; d[3] = v[i].w; }
    asm volatile("s_waitcnt lgkmcnt(0)" ::: "memory");
    const int c = lane & 7;
#pragma unroll
    for (int j = 0; j < 8; ++j) { const int n = (lane >> 3) + 8 * j; const LAS float* p = scr + (8 * c) * 65 + n;
        u32x4 o; o.x = cvt_pk_bf16(p[0 * 65], p[1 * 65]); o.y = cvt_pk_bf16(p[2 * 65], p[3 * 65]); o.z = cvt_pk_bf16(p[4 * 65], p[5 * 65]); o.w = cvt_pk_bf16(p[6 * 65], p[7 * 65]);
        __builtin_nontemporal_store(o, (u32x4*)(WT + (size_t)(n0 + n) * K + k0 + 8 * c)); }
    asm volatile("s_waitcnt lgkmcnt(0)" ::: "memory");
}

__device__ __forceinline__ void prologue(const Args& a, LAS unsigned char* lds, int G, int wv) {
    const int tid = fresh_tid(wv);
    const int lane = tid & 63, wave = tid >> 6;
    LAS float* scr = (LAS float*)(lds + wave * 16640);
    const int gw = blockIdx.x * 8 + wave, NGW = G * 8;
    unsigned char* ws = a.ws;
    constexpr int I_IN = (DM / 64) * (NIN / 64), I_O = (DM / 64) * (DM / 64), I_UP = (DM / 64) * (NUP / 64), I_DN = (DFF / 64) * (DM / 64);
    constexpr int I_L = I_IN + I_O + I_UP + I_DN;
    for (int it = gw; it < DEPTH * I_L; it += NGW) {
        const int l = it / I_L; int r = it % I_L;
        if (r < I_IN) { transpose_item<1>(a.in[2] + (size_t)l * DM * NIN, DM, NIN, (bf16_t*)(ws + OFF_WIN + l * SZ_WIN), a.in[1] + l * DM, scr, r, lane); continue; } r -= I_IN;
        if (r < I_O) {
            const int kb = r / (DM / 64); const float* gk = (kb < 16) ? (a.in[10] + l * 1024) : (a.in[11] + l * 1024 - 1024);
            transpose_item<0>(a.in[12] + (size_t)l * DM * DM, DM, DM, (bf16_t*)(ws + OFF_WO + l * SZ_WO), gk, scr, r, lane); continue; } r -= I_O;
        if (r < I_UP) { transpose_item<2>(a.in[14] + (size_t)l * DM * NUP, DM, NUP, (bf16_t*)(ws + OFF_WUP + l * SZ_WUP), a.in[13] + l * DM, scr, r, lane); continue; } r -= I_UP;
        transpose_item<0>(a.in[17] + (size_t)l * DFF * DM, DFF, DM, (bf16_t*)(ws + OFF_WDN + l * SZ_WDN), nullptr, scr, r, lane);
    }
    {
        const float* x = a.in[0]; bf16_t* xb = (bf16_t*)(ws + OFF_XB); float* xss = (float*)(ws + OFF_XSS);
        for (int m = gw; m < T; m += 2 * NGW) {
            const int m2 = m + NGW;
            const bool has2 = m2 < T;
            const f32x4* xr = (const f32x4*)(x + (size_t)m * DM) + lane; const f32x4* xr2 = (const f32x4*)(x + (size_t)(has2 ? m2 : m) * DM) + lane;
            f32x4 va[8], vb[8];
#pragma unroll
            for (int j = 0; j < 8; ++j) { va[j] = __builtin_nontemporal_load(xr + 64 * j); vb[j] = __builtin_nontemporal_load(xr2 + 64 * j); }
            float s = 0.f, s2 = 0.f;
            u32x2* o8 = (u32x2*)(xb + (size_t)m * DM) + lane; u32x2* o82 = (u32x2*)(xb + (size_t)(has2 ? m2 : m) * DM) + lane;
#pragma unroll
            for (int j = 0; j < 8; ++j) { s += dot4(va[j]); s2 += dot4(vb[j]);
                u32x2 w; w.x = cvt_pk_bf16(va[j].x, va[j].y); w.y = cvt_pk_bf16(va[j].z, va[j].w); o8[64 * j] = w;
                u32x2 w2; w2.x = cvt_pk_bf16(vb[j].x, vb[j].y); w2.y = cvt_pk_bf16(vb[j].z, vb[j].w); if (has2) o82[64 * j] = w2; }
            s = wave_sum(s); s2 = wave_sum(s2);
            if (lane < 32) { xss[(size_t)m * 32 + lane] = (lane == 0) ? s : 0.f; if (has2) xss[(size_t)m2 * 32 + lane] = (lane == 0) ? s2 : 0.f; }
        }
    }
    {
        float* cosT = (float*)(ws + OFF_COS); float* sinT = (float*)(ws + OFF_SIN);
        for (int i = blockIdx.x * 512 + tid; i < SEQ * 64; i += G * 512) {
            const int pos = i >> 6, k = i & 63;
            const float inv = (float)exp2(-(double)k * (13.287712379549449 / 64.0));
            const float ang = (float)pos * inv;
            double rev = (double)ang * 0.15915494309189535; rev -= rint(rev);
            const float fr = (float)rev;
            cosT[i] = __builtin_amdgcn_cosf(fr); sinT[i] = __builtin_amdgcn_sinf(fr);
        }
    }
    {
        const float* wsrc = a.in[8]; float* rsw = (float*)(ws + OFF_RSW);
        for (int r = gw; r < DEPTH * 8 * 128; r += NGW) {
            const f32x2 v = *((const f32x2*)(wsrc + (size_t)r * 128) + lane);
            const float t = wave_sum(v.x + v.y);
            if (lane == 0) rsw[r] = t;
        }
    }
    {
        const float* wsrc = a.in[8]; bf16_t* wd = (bf16_t*)(ws + OFF_WS);
        for (int i = blockIdx.x * 512 + tid; i < DEPTH * 8 * 128 * 128 / 4; i += G * 512) {
            const f32x4 v = *((const f32x4*)wsrc + i); u32x2 w; w.x = cvt_pk_bf16(v.x, v.y); w.y = cvt_pk_bf16(v.z, v.w); *((u32x2*)wd + i) = w;
        }
    }
}

#define LDS_BARRIER() do { asm volatile("s_waitcnt lgkmcnt(0)" ::: "memory"); __builtin_amdgcn_s_barrier(); asm volatile("" ::: "memory"); } while (0)

__device__ __forceinline__ s16x4 vtr(const LAS unsigned char* p) { typedef short v4i16_t __attribute__((ext_vector_type(4))); return __builtin_bit_cast(s16x4, __builtin_amdgcn_ds_read_tr16_b64_v4i16((LAS v4i16_t*)p)); }
#define MFMA32(a, b, c) __builtin_amdgcn_mfma_f32_32x32x16_bf16((a), (b), (c), 0, 0, 0)

constexpr int AT_KROW = 272, AT_VROW = 288, AT_KSZ = 32 * AT_KROW, AT_VSZ = 32 * AT_VROW, AT_BUF = 2 * AT_KSZ + 2 * AT_VSZ;
constexpr int AT_RED = 2 * AT_BUF;

__device__ __forceinline__ void attn_unit(LAS unsigned char* lds, int unit, const float* sinkl, const bf16_t* Q, const bf16_t* K, const bf16_t* V, const float* qss, const float* kss, bf16_t* MIX, int wv) {
    const int tid = fresh_tid(wv);
    const int lane = tid & 63, wid = __builtin_amdgcn_readfirstlane(tid >> 6), qi = lane & 31, hh = lane >> 5;
    const int b = unit >> 6, qb = unit & 63, q0 = qb * 32;
    const size_t rowbase = (size_t)b * SEQ;
    const int hq = wid, kvh = wid >> 2;
    const size_t qrow = rowbase + q0 + qi;
    bf16x8 qf[8];
    { const bf16_t* qp = Q + qrow * 1024 + hq * 128 + 8 * hh;
#pragma unroll
      for (int s = 0; s < 8; ++s) qf[s] = *(const bf16x8*)(qp + 16 * s); }
    const f32x4 qs = *(const f32x4*)(qss + (qrow * 8 + hq) * 4);
    const float rq = rsqrtf(sum4(qs) * (1.0f / 128.0f) + EPS);
    const float sc = rq * 0.08838834764831845f * LOG2E;
    const float sk = sinkl[hq] * LOG2E;
    float m_run = sk, l_run = (hh == 0) ? 1.f : 0.f;
    f32x16 o[4];
#pragma unroll
    for (int c = 0; c < 4; ++c)
#pragma unroll
        for (int i = 0; i < 16; ++i) o[c][i] = 0.f;
    int kb_lo = 0, kb_hi = 8;
    if (qb < 4) kb_lo = 4 - qb;
    if (qb > 59) kb_hi = 67 - qb;
    const int skey = tid >> 4, spart = tid & 15;
    u32x4 pk0A, pk1A, pv0A, pv1A, pk0B, pk1B, pv0B, pv1B; f32x4 ks0A, ks1A, ks0B, ks1B;
#define AT_LOAD(S, kb) do { const size_t r_ = rowbase + (size_t)(q0 - 128 + 32 * (kb) + skey); \
        pk0##S = *(const u32x4*)(K + r_ * 256 + 8 * spart); pk1##S = *(const u32x4*)(K + r_ * 256 + 128 + 8 * spart); \
        pv0##S = *(const u32x4*)(V + r_ * 256 + 8 * spart); pv1##S = *(const u32x4*)(V + r_ * 256 + 128 + 8 * spart); \
        ks0##S = *(const f32x4*)(kss + r_ * 8); ks1##S = *(const f32x4*)(kss + r_ * 8 + 4); } while (0)
#define AT_SCALE(p, r) do { u32x4 t_; \
        t_.x = cvt_pk_bf16(bf_lo(p.x) * r, bf_hi(p.x) * r); t_.y = cvt_pk_bf16(bf_lo(p.y) * r, bf_hi(p.y) * r); \
        t_.z = cvt_pk_bf16(bf_lo(p.z) * r, bf_hi(p.z) * r); t_.w = cvt_pk_bf16(bf_lo(p.w) * r, bf_hi(p.w) * r); p = t_; } while (0)
#define AT_WRITE(S, buf) do { const float r0_ = rsqrtf(sum4(ks0##S) * (1.0f / 128.0f) + EPS), r1_ = rsqrtf(sum4(ks1##S) * (1.0f / 128.0f) + EPS); \
        AT_SCALE(pk0##S, r0_); AT_SCALE(pk1##S, r1_); \
        LAS unsigned char* b_ = lds + (buf) * AT_BUF; \
        *(LAS u32x4*)(b_ + skey * AT_KROW + spart * 16) = pk0##S; *(LAS u32x4*)(b_ + AT_KSZ + skey * AT_KROW + spart * 16) = pk1##S; \
        *(LAS u32x4*)(b_ + 2 * AT_KSZ + skey * AT_VROW + spart * 16) = pv0##S; *(LAS u32x4*)(b_ + 2 * AT_KSZ + AT_VSZ + skey * AT_VROW + spart * 16) = pv1##S; } while (0)
    const int trq = (lane & 15) >> 2, trp = lane & 3, blk = (lane >> 4) & 1;
#define AT_COMPUTE(kb, cur) do { \
        const LAS unsigned char* Kb = lds + (cur) * AT_BUF + kvh * AT_KSZ; \
        const LAS unsigned char* Vb = lds + (cur) * AT_BUF + 2 * AT_KSZ + kvh * AT_VSZ; \
        f32x16 st; \
        _Pragma("unroll") for (int i = 0; i < 16; ++i) st[i] = 0.f; \
        _Pragma("unroll") for (int s_ = 0; s_ < 8; ++s_) { const bf16x8 kf = *(const LAS bf16x8*)(Kb + qi * AT_KROW + (16 * s_ + 8 * hh) * 2); st = MFMA32(kf, qf[s_], st); } \
        float tt[16]; \
        _Pragma("unroll") for (int i = 0; i < 16; ++i) tt[i] = st[i] * sc; \
        if ((kb) == 0) { _Pragma("unroll") for (int i = 0; i < 16; ++i) if (crow(i, hh) < qi) tt[i] = -INFINITY; } \
        if ((kb) == 8) { _Pragma("unroll") for (int i = 0; i < 16; ++i) if (crow(i, hh) > qi) tt[i] = -INFINITY; } \
        float mx = tt[0]; \
        _Pragma("unroll") for (int i = 1; i < 16; ++i) mx = fmaxf(mx, tt[i]); \
        mx = fmaxf(mx, __shfl_xor(mx, 32)); \
        const float m_new = fmaxf(m_run, mx); \
        const float alpha = __builtin_amdgcn_exp2f(m_run - m_new); \
        float ps = 0.f; \
        _Pragma("unroll") for (int i = 0; i < 16; ++i) { tt[i] = __builtin_amdgcn_exp2f(tt[i] - m_new); ps += tt[i]; } \
        l_run = l_run * alpha + ps; m_run = m_new; \
        _Pragma("unroll") for (int c = 0; c < 4; ++c) _Pragma("unroll") for (int i = 0; i < 16; ++i) o[c][i] *= alpha; \
        _Pragma("unroll") for (int s2 = 0; s2 < 2; ++s2) { \
            u32x4 pw; pw.x = cvt_pk_bf16(tt[8 * s2 + 0], tt[8 * s2 + 1]); pw.y = cvt_pk_bf16(tt[8 * s2 + 2], tt[8 * s2 + 3]); pw.z = cvt_pk_bf16(tt[8 * s2 + 4], tt[8 * s2 + 5]); pw.w = cvt_pk_bf16(tt[8 * s2 + 6], tt[8 * s2 + 7]); \
            const bf16x8 pb = __builtin_bit_cast(bf16x8, pw); \
            _Pragma("unroll") for (int c = 0; c < 4; ++c) { \
                const LAS unsigned char* vp = Vb + (16 * s2 + 4 * hh + trq) * AT_VROW + (32 * c + 16 * blk) * 2 + 8 * trp; \
                const s16x4 lo = vtr(vp), hi = vtr(vp + 8 * AT_VROW); \
                const bf16x8 vf = {lo[0], lo[1], lo[2], lo[3], hi[0], hi[1], hi[2], hi[3]}; \
                o[c] = MFMA32(vf, pb, o[c]); } } } while (0)
    AT_LOAD(A, kb_lo);
    if (kb_lo + 1 <= kb_hi) AT_LOAD(B, kb_lo + 1);
    AT_WRITE(A, 0);
    LDS_BARRIER();
    if (kb_lo + 2 <= kb_hi) AT_LOAD(A, kb_lo + 2);
    for (int kb = kb_lo; ; kb += 2) {
        AT_COMPUTE(kb, 0);
        if (kb + 1 <= kb_hi) AT_WRITE(B, 1);
        LDS_BARRIER();
        if (kb + 1 > kb_hi) break;
        if (kb + 3 <= kb_hi) AT_LOAD(B, kb + 3);
        AT_COMPUTE(kb + 1, 1);
        if (kb + 2 <= kb_hi) AT_WRITE(A, 0);
        LDS_BARRIER();
        if (kb + 2 > kb_hi) break;
        if (kb + 4 <= kb_hi) AT_LOAD(A, kb + 4);
    }
#undef AT_LOAD
#undef AT_SCALE
#undef AT_WRITE
#undef AT_COMPUTE
    const float lt = l_run + __shfl_xor(l_run, 32);
    const float inv = 1.0f / lt;
    float ss = 0.f;
#pragma unroll
    for (int c = 0; c < 4; ++c)
#pragma unroll
        for (int i = 0; i < 16; ++i) { o[c][i] *= inv; ss += o[c][i] * o[c][i]; }
    ss += __shfl_xor(ss, 32);
    LAS float* red = (LAS float*)(lds + AT_RED);
    if (hh == 0) red[hq * 32 + qi] = ss;
    LDS_BARRIER();
    float tot = 0.f;
#pragma unroll
    for (int h = 0; h < 8; ++h) tot += red[h * 32 + qi];
    const float ra = rsqrtf(tot * (1.0f / 1024.0f) + EPS);
    bf16_t* op = MIX + qrow * DM + hq * 128;
#pragma unroll
    for (int c = 0; c < 4; ++c)
#pragma unroll
        for (int g = 0; g < 4; ++g) {
            u32x2 w; w.x = cvt_pk_bf16(o[c][4 * g] * ra, o[c][4 * g + 1] * ra); w.y = cvt_pk_bf16(o[c][4 * g + 2] * ra, o[c][4 * g + 3] * ra);
            *(u32x2*)(op + 32 * c + 8 * g + 4 * hh) = w;
        }
    LDS_BARRIER();
}

constexpr int SG_ROW = 288, SG_BUF = 128 * SG_ROW, SG_STAT = 2 * SG_BUF, SG_RED = SG_STAT + 128 * 8, SG_LN = SG_RED + 1024;
__device__ __forceinline__ void sgu_unit(LAS unsigned char* lds, int unit, const bf16_t* GU, const bf16_t* GV, const float* gvs, const float* lng, const float* lnb,
                                         const bf16_t* WS, const float* rsw, const float* bs, bf16_t* MIX, int wv) {
    const int tid = fresh_tid(wv);
    const int lane = tid & 63, wid = __builtin_amdgcn_readfirstlane(tid >> 6), pi = lane & 31, hh = lane >> 5;
    const int bc = unit >> 1, ph = unit & 1;
    const size_t rowbase = (size_t)bc * 128;
    LAS f32x2* stat = (LAS f32x2*)(lds + SG_STAT);
    const int spart = tid & 15, sq = tid >> 4;
    const bf16_t* gvp = GV + (rowbase + sq) * 1024 + 8 * spart;
    u32x4 gvr[4];
#define SG_LOADGV(h) do { _Pragma("unroll") for (int i = 0; i < 4; ++i) gvr[i] = *(const u32x4*)(gvp + (size_t)(32 * i) * 1024 + (h) * 128); } while (0)
    SG_LOADGV(0);
    {
        const f32x4 t4 = (tid < 256) ? *(const f32x4*)(lng + 4 * tid) : *(const f32x4*)(lnb + 4 * (tid - 256));
        *(LAS f32x4*)(lds + SG_LN + 16 * tid) = t4;
    }
    if (tid < 128) {
        const f32x4* p = (const f32x4*)(gvs + (rowbase + tid) * 32);
        float s1 = 0.f, s2 = 0.f;
#pragma unroll
        for (int i = 0; i < 8; ++i) { const f32x4 v = p[i]; s1 += v.x + v.z; s2 += v.y + v.w; }
        const float mu = s1 * (1.0f / 1024.0f);
        const float var = s2 * (1.0f / 1024.0f) - mu * mu;
        stat[tid] = (f32x2){mu, rsqrtf(fmaxf(var, 0.f) + EPS)};
    }
    LDS_BARRIER();
    const int psub = wid & 1, dsub = wid >> 1;
    const int prow = ph * 64 + psub * 32 + pi;
    const int trq = (lane & 15) >> 2, trp = lane & 3, blk = (lane >> 4) & 1;
    const bf16_t* wp = WS + (size_t)prow * 128 + 8 * hh;
    unsigned accp[8][8];
#pragma unroll
    for (int h = 0; h < 8; ++h) {
        f32x16 acch;
#pragma unroll
        for (int i = 0; i < 16; ++i) acch[i] = 0.f;
        bf16x8 wf[8];
#pragma unroll
        for (int s_ = 0; s_ < 8; ++s_) wf[s_] = *(const bf16x8*)(wp + (size_t)h * 128 * 128 + 16 * s_);
        LAS unsigned char* buf = lds + (h & 1) * SG_BUF;
#pragma unroll
        for (int i = 0; i < 4; ++i) {
            const int q = sq + 32 * i;
            const u32x4 v = gvr[i];
            const f32x2 st = stat[q];
            const float nm = -st.x * st.y;
            u32x4 w;
            w.x = cvt_pk_bf16(__builtin_fmaf(bf_lo(v.x), st.y, nm), __builtin_fmaf(bf_hi(v.x), st.y, nm));
            w.y = cvt_pk_bf16(__builtin_fmaf(bf_lo(v.y), st.y, nm), __builtin_fmaf(bf_hi(v.y), st.y, nm));
            w.z = cvt_pk_bf16(__builtin_fmaf(bf_lo(v.z), st.y, nm), __builtin_fmaf(bf_hi(v.z), st.y, nm));
            w.w = cvt_pk_bf16(__builtin_fmaf(bf_lo(v.w), st.y, nm), __builtin_fmaf(bf_hi(v.w), st.y, nm));
            *(LAS u32x4*)(buf + q * SG_ROW + spart * 16) = w;
        }
        if (h + 1 < 8) SG_LOADGV(h + 1);
        LDS_BARRIER();
#pragma unroll
        for (int s_ = 0; s_ < 8; ++s_) {
            const LAS unsigned char* vp = buf + (16 * s_ + 8 * hh + trq) * SG_ROW + (32 * dsub + 16 * blk) * 2 + 8 * trp;
            const s16x4 lo = vtr(vp), hi = vtr(vp + 4 * SG_ROW);
            const bf16x8 vf = {lo[0], lo[1], lo[2], lo[3], hi[0], hi[1], hi[2], hi[3]};
            acch = MFMA32(vf, wf[s_], acch);
            if (s_ & 1) __builtin_amdgcn_sched_barrier(0);
        }
#pragma unroll
        for (int k = 0; k < 8; ++k) accp[h][k] = cvt_pk_bf16(acch[2 * k], acch[2 * k + 1]);
    }
#undef SG_LOADGV
    const size_t orow = rowbase + prow;
    float ss = 0.f;
    u32x2 guv[8][4]; float bbv[8], rwv[8];
#pragma unroll
    for (int h = 0; h < 8; ++h) {
        bbv[h] = bs[h * 128 + prow]; rwv[h] = rsw[h * 128 + prow];
#pragma unroll
        for (int g = 0; g < 4; ++g) guv[h][g] = *(const u32x2*)(GU + orow * 1024 + h * 128 + 32 * dsub + 8 * g + 4 * hh);
    }
    const LAS float* lnl = (const LAS float*)(lds + SG_LN);
#pragma unroll
    for (int h = 0; h < 8; ++h) {
        const float bb = bbv[h], rw = rwv[h];
#pragma unroll
        for (int g = 0; g < 4; ++g) {
            const int d0 = h * 128 + 32 * dsub + 8 * g + 4 * hh;
            const u32x2 gu = guv[h][g];
            const f32x4 lg = *(const LAS f32x4*)(lnl + d0), lb = *(const LAS f32x4*)(lnl + 1024 + d0);
            const float o0 = bf_lo(gu.x) * (__builtin_fmaf(lg.x, bf_lo(accp[h][2 * g]), __builtin_fmaf(lb.x, rw, bb)));
            const float o1 = bf_hi(gu.x) * (__builtin_fmaf(lg.y, bf_hi(accp[h][2 * g]), __builtin_fmaf(lb.y, rw, bb)));
            const float o2 = bf_lo(gu.y) * (__builtin_fmaf(lg.z, bf_lo(accp[h][2 * g + 1]), __builtin_fmaf(lb.z, rw, bb)));
            const float o3 = bf_hi(gu.y) * (__builtin_fmaf(lg.w, bf_hi(accp[h][2 * g + 1]), __builtin_fmaf(lb.w, rw, bb)));
            ss += (o0 * o0 + o1 * o1) + (o2 * o2 + o3 * o3);
            accp[h][2 * g] = cvt_pk_bf16(o0, o1); accp[h][2 * g + 1] = cvt_pk_bf16(o2, o3);
        }
        __builtin_amdgcn_sched_barrier(0);
    }
    ss += __shfl_xor(ss, 32);
    LAS float* red = (LAS float*)(lds + SG_RED);
    if (hh == 0) red[dsub * 64 + psub * 32 + pi] = ss;
    LDS_BARRIER();
    const float tot = (red[psub * 32 + pi] + red[64 + psub * 32 + pi]) + (red[128 + psub * 32 + pi] + red[192 + psub * 32 + pi]);
    const float rs = rsqrtf(tot * (1.0f / 1024.0f) + EPS);
    bf16_t* op = MIX + orow * DM + 1024 + 32 * dsub;
#pragma unroll
    for (int h = 0; h < 8; ++h)
#pragma unroll
        for (int g = 0; g < 4; ++g) {
            u32x2 w; w.x = cvt_pk_bf16(bf_lo(accp[h][2 * g]) * rs, bf_hi(accp[h][2 * g]) * rs); w.y = cvt_pk_bf16(bf_lo(accp[h][2 * g + 1]) * rs, bf_hi(accp[h][2 * g + 1]) * rs);
            *(u32x2*)(op + h * 128 + 8 * g + 4 * hh) = w;
        }
    LDS_BARRIER();
}

__device__ __forceinline__ void fixup_phase(const bf16_t* HALO, const float* cw, const float* cb, bf16_t* ACT, int G, int wv) {
    constexpr int CH = DFF / 8;
    const int total = (T / 64) * 2 * CH;
    const int tid = fresh_tid(wv);
    for (int it = blockIdx.x * 512 + tid; it < total; it += G * 512) {
        const int ch = it % CH, br = it / CH, sl = br >> 1, side = br & 1;
        const int row = sl * 64 + (side ? 63 : 0), pos = row & (SEQ - 1);
        const int j = ch * 8;
        const bf16_t* hc = HALO + (size_t)(4 * sl + (side ? 3 : 0)) * NUP;
        const bf16_t* hp = side ? HALO + (size_t)(4 * sl + 2) * NUP : (pos == 0 ? nullptr : HALO + (size_t)(4 * (sl - 1) + 3) * NUP);
        const bf16_t* hn = side ? (pos == SEQ - 1 ? nullptr : HALO + (size_t)(4 * (sl + 1)) * NUP) : HALO + (size_t)(4 * sl + 1) * NUP;
        float a[2][8];
#pragma unroll
        for (int gu = 0; gu < 2; ++gu) {
            const int col = gu * DFF + j;
            const u32x4 z = {0u, 0u, 0u, 0u};
            const u32x4 vc = *(const u32x4*)(hc + col), vp = hp ? *(const u32x4*)(hp + col) : z, vn = hn ? *(const u32x4*)(hn + col) : z;
#pragma unroll
            for (int e = 0; e < 4; ++e) {
                const int c0 = col + 2 * e;
                a[gu][2 * e] = cb[c0] + cw[c0] * bf_lo(vp[e]) + cw[NUP + c0] * bf_lo(vc[e]) + cw[2 * NUP + c0] * bf_lo(vn[e]);
                a[gu][2 * e + 1] = cb[c0 + 1] + cw[c0 + 1] * bf_hi(vp[e]) + cw[NUP + c0 + 1] * bf_hi(vc[e]) + cw[2 * NUP + c0 + 1] * bf_hi(vn[e]);
            }
        }
        u32x4 w;
        w.x = cvt_pk_bf16(silu_f(a[0][0]) * a[1][0], silu_f(a[0][1]) * a[1][1]); w.y = cvt_pk_bf16(silu_f(a[0][2]) * a[1][2], silu_f(a[0][3]) * a[1][3]);
        w.z = cvt_pk_bf16(silu_f(a[0][4]) * a[1][4], silu_f(a[0][5]) * a[1][5]); w.w = cvt_pk_bf16(silu_f(a[0][6]) * a[1][6], silu_f(a[0][7]) * a[1][7]);
        *(u32x4*)(ACT + (size_t)row * DFF + j) = w;
    }
}


#define XB_TMO      128
#define XB_XCNT(j)  (256  + 64 * (j))
#define XB_XSUB(j)  (1280 + 64 * (j))
#define XB_XGEN(j)  (2304 + 64 * (j))
#define XB_TOP      3328
#define XB_TOPGEN   3392
#define XCD_BAR_WORDS 3456
#define XB_SPIN_CAP (1u << 18)
__device__ __forceinline__ unsigned xb_ld(unsigned* p)              { return __hip_atomic_load(p, __ATOMIC_RELAXED, __HIP_MEMORY_SCOPE_AGENT); }
__device__ __forceinline__ unsigned xb_add(unsigned* p, unsigned v) { return __hip_atomic_fetch_add(p, v, __ATOMIC_RELAXED, __HIP_MEMORY_SCOPE_AGENT); }
__device__ __forceinline__ unsigned xb_xcc_id() { return (unsigned)__builtin_amdgcn_s_getreg((3 << 11) | 20) & 0xFu; }
#define XB_SPIN(cond, bar) do { unsigned _sp = 0; while (cond) { __builtin_amdgcn_s_sleep(1); \
    if ((++_sp & 255u) == 0u) { if (xb_ld(&(bar)[XB_TMO])) break; if (_sp > XB_SPIN_CAP) { atomicAdd(&(bar)[XB_TMO], 1u); break; } } } } while (0)
struct XcdBarrier { unsigned* bar; unsigned x; volatile LAS unsigned* st; };
__device__ __forceinline__ XcdBarrier xcd_barrier_post(unsigned* bar, volatile LAS unsigned* st) {
    XcdBarrier b; b.bar = bar; b.x = xb_xcc_id(); b.st = st;
    if (threadIdx.x == 0) (void)xb_add(&bar[XB_XCNT(b.x)], 1u);
    return b;
}
__device__ __forceinline__ void xcd_barrier_complete(unsigned* bar, unsigned x, unsigned& nloc, unsigned& nx) {
    const unsigned G = gridDim.x * gridDim.y * gridDim.z;
    unsigned sum, cnt, mine, sp = 0u;
    for (;;) {
        sum = 0u; cnt = 0u; mine = 0u;
#pragma unroll
        for (unsigned j = 0; j < 16; ++j) { const unsigned c = xb_ld(&bar[XB_XCNT(j)]); sum += c; cnt += (c > 0u) ? 1u : 0u; mine = (j == x) ? c : mine; }
        if (sum == G) break;
        __builtin_amdgcn_s_sleep(1);
        if ((++sp & 255u) == 0u) { if (xb_ld(&bar[XB_TMO])) break; if (sp > XB_SPIN_CAP) { atomicAdd(&bar[XB_TMO], 1u); break; } }
    }
    nloc = mine > 0u ? mine : 1u; nx = cnt > 0u ? cnt : 1u;
}
__device__ __forceinline__ void xcd_barrier(const XcdBarrier& b) {
    asm volatile("s_waitcnt vmcnt(0)" ::: "memory");
    __syncthreads();
    const unsigned lane = (unsigned)lane_id_fresh();
    bool leader = false;
    if (lane == 0) { const unsigned t = __hip_atomic_fetch_add((LAS unsigned*)(b.st + 2), 1u, __ATOMIC_RELAXED, __HIP_MEMORY_SCOPE_WORKGROUP); leader = (t & 7u) == 0u; }
    if (leader) {
        unsigned* bar = b.bar; unsigned x = b.x; asm volatile("" : "+s"(x));
        __builtin_amdgcn_s_waitcnt(0);
        unsigned nloc = b.st[0], nx = b.st[1];
        if (nloc == 0u) { xcd_barrier_complete(bar, x, nloc, nx); b.st[0] = nloc; b.st[1] = nx; }
        const unsigned old = xb_add(&bar[XB_XSUB(x)], 1u);
        const unsigned gen = old / nloc;
        if (old + 1u == (gen + 1u) * nloc) {
            __builtin_amdgcn_fence(__ATOMIC_RELEASE, "agent");
            asm volatile("s_waitcnt vmcnt(0)" ::: "memory");
            const unsigned og = xb_add(&bar[XB_TOP], 1u);
            const unsigned tg = og / nx;
            if (og + 1u == (tg + 1u) * nx) xb_add(&bar[XB_TOPGEN], 1u);
            else XB_SPIN(xb_ld(&bar[XB_TOPGEN]) == tg, bar);
            __builtin_amdgcn_fence(__ATOMIC_ACQUIRE, "agent");
            xb_add(&bar[XB_XGEN(x)], 1u);
            asm volatile("s_waitcnt vmcnt(0)" ::: "memory");
        } else {
            XB_SPIN(xb_ld(&bar[XB_XGEN(x)]) == gen, bar);
            __builtin_amdgcn_fence(__ATOMIC_ACQUIRE, "agent");
            asm volatile("s_waitcnt vmcnt(0)" ::: "memory");
        }
    }
    __syncthreads();
}

#ifndef PROBE_SEL
#define PROBE_SEL 0
#endif
#if PROBE_SEL
#define TIC(sel) do { if (PROBE_SEL == (sel)) { asm volatile("s_waitcnt vmcnt(0) lgkmcnt(0)" ::: "memory"); probe_t0 = __builtin_amdgcn_s_memrealtime(); } } while (0)
#define TOC(sel) do { if (PROBE_SEL == (sel)) { asm volatile("s_waitcnt vmcnt(0) lgkmcnt(0)" ::: "memory"); probe_acc += __builtin_amdgcn_s_memrealtime() - probe_t0; } } while (0)
#else
#define TIC(sel) do {} while (0)
#define TOC(sel) do {} while (0)
#endif
typedef const __attribute__((address_space(4))) Args* ArgsP;
#define FRESH_ARGS() ArgsP ap = (ArgsP)__builtin_amdgcn_kernarg_segment_ptr(); asm volatile("" : "+s"(ap)); unsigned char* ws = ap->ws; const int G = gridDim.x, bx = blockIdx.x
__global__ void __launch_bounds__(512, 2) fwd_megakernel(Args a_unused) {
    extern __shared__ __attribute__((aligned(16))) unsigned char lds_raw[];
    LAS unsigned char* lds = (LAS unsigned char*)lds_raw;
    cg::grid_group grid = cg::this_grid();
#if PROBE_SEL
    unsigned long long probe_t0 = 0, probe_acc = 0;
#endif
    const int wv = __builtin_amdgcn_readfirstlane(threadIdx.x >> 6);
    volatile LAS unsigned* bst = (volatile LAS unsigned*)(lds + LDS_BYTES - 16);
    if (threadIdx.x < 4) bst[threadIdx.x] = 0u;
    __syncthreads();
    if (gridDim.y == 0xFFFFu) grid.sync();
    XcdBarrier xbar;
    { FRESH_ARGS(); xbar = xcd_barrier_post((unsigned*)(ws + OFF_CTL), bst); (void)G; (void)bx; }
    {
        FRESH_ARGS();
        Args a;
#pragma unroll
        for (int i = 0; i < 18; ++i) a.in[i] = ap->in[i];
        a.out = ap->out; a.ws = ws;
        TIC(9);
#ifndef NO_P0
        prologue(a, lds, G, wv);
#endif
        TOC(9);
    }
    TIC(1); xcd_barrier(xbar); TOC(1);

    for (int l = 0; l < DEPTH; ++l) {
        for (int part = 0; part < 2; ++part) {
            FRESH_ARGS();
            const bool split = (G == 256);
            if (part == 1 && !split) break;
            pg8::Gemm g{(const bf16_t*)(ws + OFF_XB), (const bf16_t*)(ws + OFF_WIN + l * SZ_WIN), T, NIN, DM}; pg8::StaticOrder S; S.init(T, NIN, G, bx);
            if (split) { S.Lbase = part ? 768 : 0; S.Lend = part ? 896 : 768; }
            EpiIn E{(const float*)(ws + OFF_XSS), ap->in[3] + l * 128, ap->in[4] + l * 128, (const float*)(ws + OFF_COS), (const float*)(ws + OFF_SIN),
                    (bf16_t*)(ws + OFF_Q), (bf16_t*)(ws + OFF_K), (bf16_t*)(ws + OFF_V), (bf16_t*)(ws + OFF_GU), (bf16_t*)(ws + OFF_GV),
                    (float*)(ws + OFF_QSS), (float*)(ws + OFF_KSS), (float*)(ws + OFF_GVS)};
            TIC(7);
#ifndef NO_IN
            pg8::gemm_phase(lds, g, S, E, wv);
#endif
            TOC(7);
            if (part == 0) { TIC(1); xcd_barrier(xbar); TOC(1); }
        }
        {
            FRESH_ARGS();
            TIC(2);
#ifndef NO_ATT
            if (G == 256) {
                const int heavy = bx >= 128;
                const int idx = (bx % 8) * 16 + (heavy ? (bx - 128) / 8 : bx / 8);
                const int u0 = heavy ? 3 * idx : 384 + idx, nu = heavy ? 3 : 1;
                for (int u = u0; u < u0 + nu; ++u) attn_unit(lds, u, ap->in[5] + l * 8, (const bf16_t*)(ws + OFF_Q), (const bf16_t*)(ws + OFF_K), (const bf16_t*)(ws + OFF_V),
                                                             (const float*)(ws + OFF_QSS), (const float*)(ws + OFF_KSS), (bf16_t*)(ws + OFF_MIX), wv);
            } else {
                for (int u = bx; u < 512; u += G) attn_unit(lds, u, ap->in[5] + l * 8, (const bf16_t*)(ws + OFF_Q), (const bf16_t*)(ws + OFF_K), (const bf16_t*)(ws + OFF_V),
                                                            (const float*)(ws + OFF_QSS), (const float*)(ws + OFF_KSS), (bf16_t*)(ws + OFF_MIX), wv);
            }
#endif
            TOC(2);
        }
        TIC(1); xcd_barrier(xbar); TOC(1);
        {
            FRESH_ARGS();
            TIC(3);
#ifndef NO_SGU
            for (int u = bx; u < 256; u += G) sgu_unit(lds, u, (const bf16_t*)(ws + OFF_GU), (const bf16_t*)(ws + OFF_GV), (const float*)(ws + OFF_GVS), ap->in[6] + l * 1024, ap->in[7] + l * 1024,
                                                       (const bf16_t*)(ws + OFF_WS) + (size_t)l * 8 * 128 * 128, (const float*)(ws + OFF_RSW) + l * 1024, ap->in[9] + l * 1024, (bf16_t*)(ws + OFF_MIX), wv);
#endif
            TOC(3);
        }
        TIC(1); xcd_barrier(xbar); TOC(1);
        {
            FRESH_ARGS();
            pg8::Gemm g{(const bf16_t*)(ws + OFF_MIX), (const bf16_t*)(ws + OFF_WO + l * SZ_WO), T, DM, DM}; pg8::StaticOrder S; S.init(T, DM, G, bx);
            EpiRes E{nullptr, (bf16_t*)(ws + OFF_XB), (float*)(ws + OFF_XSS)};
            TIC(5);
#ifndef NO_WO
            pg8::gemm_phase(lds, g, S, E, wv);
#endif
            TOC(5);
        }
        TIC(1); xcd_barrier(xbar); TOC(1);
        {
            FRESH_ARGS();
            pg8::Gemm g{(const bf16_t*)(ws + OFF_XB), (const bf16_t*)(ws + OFF_WUP + l * SZ_WUP), T, NUP, DM}; pg8::StaticOrder S; S.init(T, NUP, G, bx);
            EpiUp E{(const float*)(ws + OFF_XSS), ap->in[15] + (size_t)l * 3 * NUP, ap->in[16] + (size_t)l * NUP, (bf16_t*)(ws + OFF_ACT), (bf16_t*)(ws + OFF_HALO)};
            TIC(8);
#ifndef NO_UP
            pg8::gemm_phase(lds, g, S, E, wv);
#endif
            TOC(8);
        }
        TIC(1); xcd_barrier(xbar); TOC(1);
        {
            FRESH_ARGS();
            TIC(4);
#ifndef NO_FIX
            fixup_phase((const bf16_t*)(ws + OFF_HALO), ap->in[15] + (size_t)l * 3 * NUP, ap->in[16] + (size_t)l * NUP, (bf16_t*)(ws + OFF_ACT), G, wv);
#endif
            TOC(4);
        }
        TIC(1); xcd_barrier(xbar); TOC(1);
        {
            FRESH_ARGS();
            pg8::Gemm g{(const bf16_t*)(ws + OFF_ACT), (const bf16_t*)(ws + OFF_WDN + l * SZ_WDN), T, DM, DFF}; pg8::StaticOrder S; S.init(T, DM, G, bx);
            EpiRes E{l + 1 == DEPTH ? ap->out : nullptr, (bf16_t*)(ws + OFF_XB), (float*)(ws + OFF_XSS)};
            TIC(6);
#ifndef NO_DN
            pg8::gemm_phase(lds, g, S, E, wv);
#endif
            TOC(6);
        }
        if (l + 1 < DEPTH) { TIC(1); xcd_barrier(xbar); TOC(1); }
    }
#if PROBE_SEL
    { const unsigned long long until = __builtin_amdgcn_s_memrealtime() + 4ull * probe_acc; while (__builtin_amdgcn_s_memrealtime() < until) __builtin_amdgcn_s_sleep(16); }
#endif
}

extern "C" void kernel_launch(void* const* d_in, const int* in_sizes, int n_in, void* d_out, int out_size, void* d_ws, size_t ws_size, hipStream_t stream) {
    static int grid = 0;
    if (grid == 0) {
        if (n_in != 18 || out_size != T * DM || ws_size < WS_END) { fprintf(stderr, "kernel_launch: unexpected problem (n_in %d, out %d, ws %zu < %zu)\n", n_in, out_size, ws_size, (size_t)WS_END); grid = -1; return; }
        int dev = 0, cus = 0, per_cu = 0;
        hipGetDevice(&dev);
        hipDeviceGetAttribute(&cus, hipDeviceAttributeMultiprocessorCount, dev);
        hipFuncSetAttribute((const void*)fwd_megakernel, hipFuncAttributeMaxDynamicSharedMemorySize, LDS_BYTES);
        hipOccupancyMaxActiveBlocksPerMultiprocessor(&per_cu, (const void*)fwd_megakernel, 512, LDS_BYTES);
        if (per_cu < 1) per_cu = 1;
        grid = cus * per_cu;
        (void)hipGetLastError();
    }
    if (grid < 0) return;
    Args a{};
    for (int i = 0; i < 18; ++i) a.in[i] = (const float*)d_in[i];
    a.out = (float*)d_out; a.ws = (unsigned char*)d_ws;
    (void)hipMemsetAsync((unsigned char*)d_ws + OFF_CTL, 0, CTL_BYTES, stream);
    void* args[] = {&a};
    hipError_t e = hipLaunchCooperativeKernel((const void*)fwd_megakernel, dim3(grid), dim3(512), args, LDS_BYTES, stream);
    if (e != hipSuccess) fprintf(stderr, "cooperative launch failed: %s (grid %d)\n", hipGetErrorString(e), grid);
}
```

```cpp
#include <hip/hip_runtime.h>
#include <hip/hip_cooperative_groups.h>
#include <cstdio>
#include <cstdint>
namespace cg = cooperative_groups;

#define LAS __attribute__((address_space(3)))
typedef unsigned short bf16_t;
typedef short bf16x8 __attribute__((ext_vector_type(8)));
typedef short s16x4 __attribute__((ext_vector_type(4)));
typedef float f32x4 __attribute__((ext_vector_type(4)));
typedef float f32x2 __attribute__((ext_vector_type(2)));
typedef float f32x16 __attribute__((ext_vector_type(16)));
typedef unsigned u32x4 __attribute__((ext_vector_type(4)));
typedef unsigned u32x2 __attribute__((ext_vector_type(2)));
typedef __bf16 bf16x2_t __attribute__((ext_vector_type(2)));

constexpr int T = 16384, SEQ = 2048, DM = 2048, NIN = 3584, DFF = 5632, NUP = 11264, DEPTH = 2;
constexpr float EPS = 1e-6f;
constexpr float LOG2E = 1.4426950408889634f;

constexpr size_t SZ_WIN = (size_t)NIN * DM * 2, SZ_WO = (size_t)DM * DM * 2, SZ_WUP = (size_t)NUP * DM * 2, SZ_WDN = (size_t)DM * DFF * 2;
constexpr size_t OFF_WIN = 0;
constexpr size_t OFF_WO = OFF_WIN + DEPTH * SZ_WIN;
constexpr size_t OFF_WUP = OFF_WO + DEPTH * SZ_WO;
constexpr size_t OFF_WDN = OFF_WUP + DEPTH * SZ_WUP;
constexpr size_t OFF_WS = OFF_WDN + DEPTH * SZ_WDN;
constexpr size_t OFF_COS = OFF_WS + (size_t)DEPTH * 8 * 128 * 128 * 2;
constexpr size_t OFF_SIN = OFF_COS + (size_t)SEQ * 64 * 4;
constexpr size_t OFF_XB = OFF_SIN + (size_t)SEQ * 64 * 4;
constexpr size_t OFF_XSS = OFF_XB + (size_t)T * DM * 2;
constexpr size_t OFF_Q = OFF_XSS + (size_t)T * 32 * 4;
constexpr size_t OFF_K = OFF_Q + (size_t)T * 1024 * 2;
constexpr size_t OFF_V = OFF_K + (size_t)T * 256 * 2;
constexpr size_t OFF_GU = OFF_V + (size_t)T * 256 * 2;
constexpr size_t OFF_GV = OFF_GU + (size_t)T * 1024 * 2;
constexpr size_t OFF_MIX = OFF_GV + (size_t)T * 1024 * 2;
constexpr size_t OFF_QSS = OFF_MIX + (size_t)T * DM * 2;
constexpr size_t OFF_KSS = OFF_QSS + (size_t)T * 32 * 4;
constexpr size_t OFF_GVS = OFF_KSS + (size_t)T * 8 * 4;
constexpr size_t OFF_ACT = OFF_GVS + (size_t)T * 32 * 4;
constexpr size_t OFF_HALO = OFF_ACT + (size_t)T * DFF * 2;
constexpr size_t OFF_RSW = OFF_HALO + (size_t)(T / 64 * 4) * NUP * 2;
constexpr size_t OFF_CTL = OFF_RSW + (size_t)DEPTH * 8 * 128 * 4;
constexpr size_t CTL_BYTES = 16384;
constexpr size_t WS_END = OFF_CTL + CTL_BYTES;

constexpr int LDS_BYTES = 147456;

__device__ __forceinline__ unsigned cvt_pk_bf16(float lo, float hi) { f32x2 v = {lo, hi}; bf16x2_t b = __builtin_convertvector(v, bf16x2_t); return __builtin_bit_cast(unsigned, b); }
__device__ __forceinline__ float bf_lo(unsigned u) { return __uint_as_float(u << 16); }
__device__ __forceinline__ float bf_hi(unsigned u) { return __uint_as_float(u & 0xffff0000u); }
__device__ __forceinline__ float gelu_tanh(float x) {
    const float u = 0.7978845608028654f * (x + 0.044715f * x * x * x);
    const float e = __builtin_amdgcn_exp2f(-2.0f * LOG2E * u);
    return x * __builtin_amdgcn_rcpf(1.0f + e);
}
__device__ __forceinline__ float silu_f(float x) { const float e = __builtin_amdgcn_exp2f(-LOG2E * x); return x * __builtin_amdgcn_rcpf(1.0f + e); }
__device__ __forceinline__ float dot4(f32x4 a) { return (a.x * a.x + a.y * a.y) + (a.z * a.z + a.w * a.w); }
__device__ __forceinline__ float sum4(f32x4 a) { return (a.x + a.y) + (a.z + a.w); }
__device__ __forceinline__ int crow(int r, int hi) { return (r & 3) + 8 * (r >> 2) + 4 * hi; }
__device__ __forceinline__ float wave_sum(float v) {
#pragma unroll
    for (int o = 1; o < 64; o <<= 1) v += __shfl_xor(v, o);
    return v;
}

__device__ __forceinline__ float dpp_prev(float v) { return __int_as_float(__builtin_amdgcn_mov_dpp(__float_as_int(v), 0x121, 0xF, 0xF, false)); }
__device__ __forceinline__ float dpp_next(float v) { return __int_as_float(__builtin_amdgcn_mov_dpp(__float_as_int(v), 0x12F, 0xF, 0xF, false)); }

__device__ __forceinline__ int lane_id_fresh() { int l; asm volatile("v_mbcnt_lo_u32_b32 %0, -1, 0\n\tv_mbcnt_hi_u32_b32 %0, -1, %0" : "=v"(l)); return l; }
__device__ __forceinline__ int fresh_tid(int wv) { return wv * 64 + lane_id_fresh(); }

namespace pg8 {
constexpr int BM = 256, BK = 64, HALF = 128, HTB = HALF * BK * 2, STAGE_BYTES = 8 * HTB, NXCD = 8, WGM = 8;
__host__ __device__ __forceinline__ int lds_byte(int r, int c) { const int st = (r >> 4) * 2 + (c >> 5), rr = r & 15, cc = c & 31, ob = rr * 64 + cc * 2; return st * 1024 + (ob ^ (((ob >> 9) & 1) << 5)); }
__host__ __device__ __forceinline__ void stage_rc(int b, int& R, int& C) { const int st = b / 1024, sb = b % 1024, swz = sb ^ (((sb >> 9) & 1) << 5); R = (st >> 1) * 16 + swz / 64; C = (st & 1) * 32 + (swz % 64) / 2; }
__host__ __device__ __forceinline__ int perm32(int rho) { const int n = rho >> 4, i = rho & 15; return 8 * (i >> 2) + 4 * n + (i & 3); }
struct Unit { int pm, pn; };
struct Gemm { const bf16_t* A; const bf16_t* Bt; int M, N, K; };
struct StaticOrder {
    int nM, nN, nwg, G, c, Lbase, Lend;
    __host__ __device__ void init(int M, int N, int G_, int c_) { nM = M / BM; nN = N / BM; nwg = nM * nN; G = G_; c = c_; Lbase = 0; Lend = nwg; }
    __host__ __device__ bool next(int i, Unit& u) const {
        const long L = (long)Lbase + (long)i * G + c; if (L >= Lend) return false;
        int wgid = (int)L; { const int q = nwg / NXCD, r = nwg % NXCD, xcd = wgid % NXCD, off = wgid / NXCD; wgid = (xcd < r ? xcd * (q + 1) : r * (q + 1) + (xcd - r) * q) + off; }
        const int nig = WGM * nN, gid = wgid / nig, fm = gid * WGM, gsz = (nM - fm) < WGM ? (nM - fm) : WGM;
        u.pm = fm + ((wgid % nig) % gsz); u.pn = (wgid % nig) / gsz; return true;
    }
};

template <class Epi, class Sched>
__device__ __forceinline__ void gemm_phase(LAS unsigned char* lds, const Gemm g, const Sched& S, const Epi& E, int wv) {
    const int tid = fresh_tid(wv);
    const int wid = __builtin_amdgcn_readfirstlane(tid >> 6), lane = tid & 63, wr = wid >> 2, wc = wid & 3, fr = lane & 15, fq = lane >> 4;
    const int K = g.K, nt = K / BK;
    unsigned voffA[2], voffB[2];
#pragma unroll
    for (int i = 0; i < 2; ++i) { int R, C; stage_rc(tid * 16 + i * 8192, R, C); const int Rb = (R & ~31) + perm32(R & 31);
        voffA[i] = (unsigned)(R * K + C) * 2u; voffB[i] = (unsigned)(Rb * K + C) * 2u; }
    const size_t kstep = (size_t)(BK * 2);
    const size_t hstep = (size_t)HALF * K * 2;
    const size_t tstep = 2 * hstep;
    const unsigned ldsw = (unsigned)wid * 1024u;
    const int aoff = lds_byte(wr * 64 + fr, fq * 8), boff = lds_byte(wc * 32 + fr, fq * 8);
#define PG8_SA(b, h) (((b) * 2 + (h)) * HTB)
#define PG8_SB(b, h) ((4 + (b) * 2 + (h)) * HTB)
#define PG8_STAGE(bufoff, gbase, voff) do { _Pragma("unroll") for (int _i = 0; _i < 2; ++_i) \
        __builtin_amdgcn_global_load_lds((const unsigned*)((const char*)(gbase) + (voff)[_i]), (LAS unsigned*)(lds + (bufoff) + ldsw + _i * 8192), 16, 0, 0); } while (0)
#define PG8_LDA(dst, b, h) do { _Pragma("unroll") for (int m = 0; m < 4; ++m) _Pragma("unroll") for (int k = 0; k < 2; ++k) dst[m][k] = *(const LAS bf16x8*)(lds + PG8_SA(b, h) + aoff + m * 2048 + k * 1024); } while (0)
#define PG8_LDB(dst, b, h) do { _Pragma("unroll") for (int n = 0; n < 2; ++n) _Pragma("unroll") for (int k = 0; k < 2; ++k) dst[n][k] = *(const LAS bf16x8*)(lds + PG8_SB(b, h) + boff + n * 2048 + k * 1024); } while (0)
#define PG8_MMA(ai, bj, At, Bt) do { __builtin_amdgcn_s_setprio(1); _Pragma("unroll") for (int m = 0; m < 4; ++m) _Pragma("unroll") for (int n = 0; n < 2; ++n) _Pragma("unroll") for (int k = 0; k < 2; ++k) \
        acc[ai][bj][m][n] = __builtin_amdgcn_mfma_f32_16x16x32_bf16(Bt[n][k], At[m][k], acc[ai][bj][m][n], 0, 0, 0); __builtin_amdgcn_s_setprio(0); } while (0)
#define PG8_WAIT_V(n) asm volatile("s_waitcnt vmcnt(" #n ")" ::: "memory")
#define PG8_WAIT_L(n) asm volatile("s_waitcnt lgkmcnt(" #n ")" ::: "memory")
#define PG8_BAR __builtin_amdgcn_s_barrier()
#define PG8_SCHED __builtin_amdgcn_sched_barrier(0)
    Unit cur, nxt; int ui = 0;
    if (!S.next(0, cur)) return;
    f32x4 acc[2][2][4][2];
#pragma unroll
    for (int a = 0; a < 2; ++a)
#pragma unroll
        for (int b = 0; b < 2; ++b)
#pragma unroll
            for (int m = 0; m < 4; ++m)
#pragma unroll
                for (int n = 0; n < 2; ++n) acc[a][b][m][n] = (f32x4){0.f, 0.f, 0.f, 0.f};
    bf16x8 At[4][2], B0[2][2], B1[2][2];
    const char* cA = (const char*)g.A + (size_t)cur.pm * tstep; const char* cB = (const char*)g.Bt + (size_t)cur.pn * tstep;
    PG8_STAGE(PG8_SB(0, 0), cB, voffB); PG8_STAGE(PG8_SB(0, 1), cB + hstep, voffB); PG8_STAGE(PG8_SA(0, 0), cA, voffA); PG8_STAGE(PG8_SA(0, 1), cA + hstep, voffA);
    if (wr == 1) PG8_BAR;
    PG8_WAIT_V(2); PG8_BAR;
    PG8_STAGE(PG8_SB(1, 0), cB + kstep, voffB); PG8_STAGE(PG8_SA(1, 0), cA + kstep, voffA); PG8_STAGE(PG8_SB(1, 1), cB + hstep + kstep, voffB);
    PG8_WAIT_V(6); PG8_BAR;
    for (;;) {
        const bool has_next = S.next(ui + 1, nxt);
        const char* nA = has_next ? (const char*)g.A + (size_t)nxt.pm * tstep : cA; const char* nB = has_next ? (const char*)g.Bt + (size_t)nxt.pn * tstep : cB;
        for (int t = 0; t < nt; t += 2) {
            const bool last = (t == nt - 2);
            const char* a1 = cA + (size_t)(t + 1) * kstep;
            const char* a2 = last ? nA : cA + (size_t)(t + 2) * kstep; const char* b2 = last ? nB : cB + (size_t)(t + 2) * kstep;
            const char* a3 = a2 + kstep; const char* b3 = b2 + kstep;
            PG8_LDB(B0, 0, 0); PG8_LDB(B1, 0, 1); PG8_SCHED; PG8_LDA(At, 0, 0); PG8_STAGE(PG8_SA(1, 1), a1 + hstep, voffA);
            PG8_WAIT_V(8); PG8_WAIT_L(0); PG8_BAR; PG8_MMA(0, 0, At, B0); PG8_MMA(0, 1, At, B1); PG8_BAR; PG8_SCHED;
            PG8_LDA(At, 0, 1); PG8_STAGE(PG8_SB(0, 0), b2, voffB); PG8_STAGE(PG8_SB(0, 1), b2 + hstep, voffB); PG8_STAGE(PG8_SA(0, 0), a2, voffA);
            PG8_WAIT_V(8); PG8_WAIT_L(0); PG8_BAR; PG8_MMA(1, 0, At, B0); PG8_MMA(1, 1, At, B1); PG8_BAR; PG8_SCHED;
            PG8_LDB(B0, 1, 0); PG8_LDB(B1, 1, 1); PG8_SCHED; PG8_LDA(At, 1, 0); PG8_STAGE(PG8_SA(0, 1), a2 + hstep, voffA);
            PG8_WAIT_V(8); PG8_WAIT_L(0); PG8_BAR; PG8_MMA(0, 0, At, B0); PG8_MMA(0, 1, At, B1); PG8_BAR; PG8_SCHED;
            PG8_LDA(At, 1, 1); PG8_STAGE(PG8_SB(1, 0), b3, voffB); PG8_STAGE(PG8_SB(1, 1), b3 + hstep, voffB); PG8_STAGE(PG8_SA(1, 0), a3, voffA);
            PG8_WAIT_V(8); PG8_WAIT_L(0); PG8_BAR; PG8_MMA(1, 0, At, B0); PG8_MMA(1, 1, At, B1); PG8_BAR; PG8_SCHED;
        }
        if (wr == 0) PG8_BAR;
        E(acc, cur, wr, wc, fr, fq);
        if (!has_next) break;
#pragma unroll
        for (int a = 0; a < 2; ++a)
#pragma unroll
            for (int b = 0; b < 2; ++b)
#pragma unroll
                for (int m = 0; m < 4; ++m)
#pragma unroll
                    for (int n = 0; n < 2; ++n) acc[a][b][m][n] = (f32x4){0.f, 0.f, 0.f, 0.f};
        cur = nxt; cA = nA; cB = nB; ++ui;
        if (wr == 1) PG8_BAR;
    }
    PG8_WAIT_V(0);
    PG8_BAR;
#undef PG8_SA
#undef PG8_SB
#undef PG8_STAGE
#undef PG8_LDA
#undef PG8_LDB
#undef PG8_MMA
#undef PG8_WAIT_V
#undef PG8_WAIT_L
#undef PG8_BAR
#undef PG8_SCHED
}
}
using pg8::Unit;

__device__ __forceinline__ void row_rstd(const float* xss, int row0, int fq, float (&r)[2][4]) {
    f32x4 a[8], b[8];
#pragma unroll
    for (int i = 0; i < 8; ++i) { const f32x4* p = (const f32x4*)(xss + (size_t)(row0 + 128 * (i >> 2) + 16 * (i & 3)) * 32 + 8 * fq); a[i] = p[0]; b[i] = p[1]; }
#pragma unroll
    for (int i = 0; i < 8; ++i) {
        float s = sum4(a[i]) + sum4(b[i]);
        s += __shfl_xor(s, 16); s += __shfl_xor(s, 32);
        r[i >> 2][i & 3] = rsqrtf(s * (1.0f / DM) + EPS);
    }
    asm volatile("" ::: "memory");
}

struct EpiIn {
    const float* xss; const float* qg; const float* kg; const float* cosT; const float* sinT;
    bf16_t *Q, *K, *V, *GU, *GV; float *qss, *kss, *gvs;
    __device__ __forceinline__ void operator()(const f32x4 (&acc)[2][2][4][2], const Unit& u, int wr, int wc, int fr, int fq) const {
        asm volatile("" : "+v"(fr), "+v"(fq));
        const int row0 = u.pm * 256 + wr * 64 + fr;
        float rr[2][4]; row_rstd(xss, row0, fq, rr);
        const int pn = u.pn;
        if (pn < 5) {
            const bool isq = pn < 4;
            const float* gn = isq ? qg : kg;
            const int gg = 4 * wc + fq;
            const f32x4 glo = *(const f32x4*)(gn + 4 * gg), ghi = *(const f32x4*)(gn + 64 + 4 * gg);
#pragma unroll
            for (int ai = 0; ai < 2; ++ai) {
                f32x4 cs[4], sn[4];
#pragma unroll
                for (int i = 0; i < 4; ++i) { const int pos = (row0 + 128 * ai + 16 * i) & (SEQ - 1); cs[i] = *(const f32x4*)(cosT + pos * 64 + 4 * gg); sn[i] = *(const f32x4*)(sinT + pos * 64 + 4 * gg); }
#pragma unroll
                for (int m = 0; m < 4; ++m) {
                    const int row = row0 + 128 * ai + 16 * m;
                    const f32x4 c = cs[m], s = sn[m];
                    const float r = rr[ai][m];
#pragma unroll
                    for (int bj = 0; bj < 2; ++bj) {
                        const f32x4 v0 = acc[ai][bj][m][0] * r, v1 = acc[ai][bj][m][1] * r;
                        float ss = dot4(v0) + dot4(v1);
                        ss += __shfl_xor(ss, 16); ss += __shfl_xor(ss, 32);
                        const int head = isq ? 2 * pn + bj : bj;
                        if (fq == 0) { if (isq) qss[((size_t)row * 8 + head) * 4 + wc] = ss; else kss[((size_t)row * 2 + head) * 4 + wc] = ss; }
                        const f32x4 y0 = v0 * glo, y1 = v1 * ghi;
                        const f32x4 lo = y0 * c - y1 * s, hi = y1 * c + y0 * s;
                        bf16_t* dst = (isq ? Q + (size_t)row * 1024 : K + (size_t)row * 256) + head * 128;
                        u32x2 wl, wh; wl.x = cvt_pk_bf16(lo.x, lo.y); wl.y = cvt_pk_bf16(lo.z, lo.w); wh.x = cvt_pk_bf16(hi.x, hi.y); wh.y = cvt_pk_bf16(hi.z, hi.w);
                        *(u32x2*)(dst + 4 * gg) = wl; *(u32x2*)(dst + 64 + 4 * gg) = wh;
                    }
                }
                asm volatile("" ::: "memory");
            }
        } else if (pn == 5) {
#pragma unroll
            for (int ai = 0; ai < 2; ++ai)
#pragma unroll
                for (int m = 0; m < 4; ++m) {
                    const int row = row0 + 128 * ai + 16 * m; const float r = rr[ai][m];
#pragma unroll
                    for (int bj = 0; bj < 2; ++bj) {
                        const f32x4 v0 = acc[ai][bj][m][0] * r, v1 = acc[ai][bj][m][1] * r;
                        u32x4 w; w.x = cvt_pk_bf16(v0.x, v0.y); w.y = cvt_pk_bf16(v0.z, v0.w); w.z = cvt_pk_bf16(v1.x, v1.y); w.w = cvt_pk_bf16(v1.z, v1.w);
                        *(u32x4*)(V + (size_t)row * 256 + bj * 128 + 32 * wc + 8 * fq) = w;
                    }
                }
        } else {
            const bool isgv = pn >= 10;
            const int ct = isgv ? pn - 10 : pn - 6;
            bf16_t* dstb = (isgv ? GV : GU) + ct * 256 + 32 * wc + 8 * fq;
#pragma unroll
            for (int ai = 0; ai < 2; ++ai)
#pragma unroll
                for (int m = 0; m < 4; ++m) {
                    const int row = row0 + 128 * ai + 16 * m; const float r = rr[ai][m];
                    float s1 = 0.f, s2 = 0.f;
#pragma unroll
                    for (int bj = 0; bj < 2; ++bj) {
                        f32x4 v0 = acc[ai][bj][m][0] * r, v1 = acc[ai][bj][m][1] * r;
                        v0.x = gelu_tanh(v0.x); v0.y = gelu_tanh(v0.y); v0.z = gelu_tanh(v0.z); v0.w = gelu_tanh(v0.w);
                        v1.x = gelu_tanh(v1.x); v1.y = gelu_tanh(v1.y); v1.z = gelu_tanh(v1.z); v1.w = gelu_tanh(v1.w);
                        s1 += sum4(v0) + sum4(v1); s2 += dot4(v0) + dot4(v1);
                        u32x4 w; w.x = cvt_pk_bf16(v0.x, v0.y); w.y = cvt_pk_bf16(v0.z, v0.w); w.z = cvt_pk_bf16(v1.x, v1.y); w.w = cvt_pk_bf16(v1.z, v1.w);
                        *(u32x4*)(dstb + (size_t)row * 1024 + bj * 128) = w;
                    }
                    if (isgv) {
                        s1 += __shfl_xor(s1, 16); s1 += __shfl_xor(s1, 32);
                        s2 += __shfl_xor(s2, 16); s2 += __shfl_xor(s2, 32);
                        if (fq == 0) *(f32x2*)(gvs + ((size_t)row * 16 + ct * 4 + wc) * 2) = (f32x2){s1, s2};
                    }
                    asm volatile("" ::: "memory");
                }
        }
    }
};

struct EpiRes {
    float* out; bf16_t* xb; float* xss;
    __device__ __forceinline__ void operator()(const f32x4 (&acc)[2][2][4][2], const Unit& u, int wr, int wc, int fr, int fq) const {
        asm volatile("" : "+v"(fr), "+v"(fq));
        const int row0 = u.pm * 256 + wr * 64 + fr, col0 = u.pn * 256 + 32 * wc + 8 * fq;
#pragma unroll
        for (int ai = 0; ai < 2; ++ai) {
            u32x4 bv[2][4][2];
#pragma unroll
            for (int m = 0; m < 4; ++m)
#pragma unroll
                for (int bj = 0; bj < 2; ++bj) bv[ai][m][bj] = *(const u32x4*)(xb + (size_t)(row0 + 128 * ai + 16 * m) * DM + col0 + bj * 128);
#pragma unroll
            for (int m = 0; m < 4; ++m) {
                const int row = row0 + 128 * ai + 16 * m; float ss = 0.f;
#pragma unroll
                for (int bj = 0; bj < 2; ++bj) {
                    const size_t off = (size_t)row * DM + col0 + bj * 128;
                    const u32x4 b = bv[ai][m][bj];
                    const f32x4 o0 = (f32x4){bf_lo(b.x), bf_hi(b.x), bf_lo(b.y), bf_hi(b.y)} + acc[ai][bj][m][0];
                    const f32x4 o1 = (f32x4){bf_lo(b.z), bf_hi(b.z), bf_lo(b.w), bf_hi(b.w)} + acc[ai][bj][m][1];
                    if (out) { *(f32x4*)(out + off) = o0; *(f32x4*)(out + off + 4) = o1; }
                    else {
                        u32x4 w; w.x = cvt_pk_bf16(o0.x, o0.y); w.y = cvt_pk_bf16(o0.z, o0.w); w.z = cvt_pk_bf16(o1.x, o1.y); w.w = cvt_pk_bf16(o1.z, o1.w);
                        *(u32x4*)(xb + off) = w;
                        ss += dot4(o0) + dot4(o1);
                    }
                }
                if (!out) {
                    ss += __shfl_xor(ss, 16); ss += __shfl_xor(ss, 32);
                    if (fq == 0) xss[(size_t)row * 32 + u.pn * 4 + wc] = ss;
                }
            }
            asm volatile("" ::: "memory");
        }
    }
};

struct EpiUp {
    const float* xss; const float* cw; const float* cb; bf16_t* ACT; bf16_t* HALO;
    __device__ __forceinline__ void operator()(f32x4 (&acc)[2][2][4][2], const Unit& u, int wr, int wc, int fr, int fq) const {
        asm volatile("" : "+v"(fr), "+v"(fq));
        const int row0 = u.pm * 256 + wr * 64 + fr;
        float rr[2][4]; row_rstd(xss, row0, fq, rr);
        const int jg = u.pn * 128 + 32 * wc + 8 * fq;
#pragma unroll
        for (int ai = 0; ai < 2; ++ai)
#pragma unroll
            for (int m = 0; m < 4; ++m) {
                const float r = rr[ai][m];
#pragma unroll
                for (int bj = 0; bj < 2; ++bj) { acc[ai][bj][m][0] *= r; acc[ai][bj][m][1] *= r; }
                if (m == 0 || m == 3) {
                    const bool hal = (m == 0) ? (fr < 2) : (fr >= 14);
                    if (hal) {
                        const int row = row0 + 128 * ai + 16 * m;
                        const int hr = (row >> 6) * 4 + (m == 0 ? fr : fr - 12);
#pragma unroll
                        for (int bj = 0; bj < 2; ++bj) {
                            const f32x4 v0 = acc[ai][bj][m][0], v1 = acc[ai][bj][m][1];
                            u32x4 w; w.x = cvt_pk_bf16(v0.x, v0.y); w.y = cvt_pk_bf16(v0.z, v0.w); w.z = cvt_pk_bf16(v1.x, v1.y); w.w = cvt_pk_bf16(v1.z, v1.w);
                            *(u32x4*)(HALO + (size_t)hr * NUP + (bj ? DFF : 0) + jg) = w;
                        }
                    }
                }
            }
        __builtin_amdgcn_sched_barrier(0);
#pragma unroll
        for (int n = 0; n < 2; ++n) {
            f32x4 wv[2][2][4];
#pragma unroll
            for (int bj = 0; bj < 2; ++bj) {
                const int col = (bj ? DFF : 0) + jg + 4 * n;
                const float ksc = bj ? -0.6931471805599453f : -LOG2E;
                wv[n][bj][0] = *(const f32x4*)(cw + col) * ksc; wv[n][bj][1] = *(const f32x4*)(cw + NUP + col) * ksc; wv[n][bj][2] = *(const f32x4*)(cw + 2 * NUP + col) * ksc; wv[n][bj][3] = *(const f32x4*)(cb + col) * ksc;
            }
#pragma unroll
            for (int e = 0; e < 4; ++e) {
#pragma unroll
                for (int ai = 0; ai < 2; ++ai) {
                    float a[2][4];
#pragma unroll
                    for (int bj = 0; bj < 2; ++bj) {
                        float raw[4], P[4], N[4];
#pragma unroll
                        for (int m = 0; m < 4; ++m) raw[m] = acc[ai][bj][m][n][e];
                        asm volatile("" : "+v"(raw[0]), "+v"(raw[1]), "+v"(raw[2]), "+v"(raw[3]));
#pragma unroll
                        for (int m = 0; m < 4; ++m) { P[m] = dpp_prev(raw[m]); N[m] = dpp_next(raw[m]); }
#pragma unroll
                        for (int m = 0; m < 4; ++m) {
                            const float prev = fr > 0 ? P[m] : (m > 0 ? P[m > 0 ? m - 1 : 0] : 0.f);
                            const float next = fr < 15 ? N[m] : (m < 3 ? N[m < 3 ? m + 1 : 3] : 0.f);
                            a[bj][m] = __builtin_fmaf(wv[n][bj][0][e], prev, __builtin_fmaf(wv[n][bj][1][e], raw[m], __builtin_fmaf(wv[n][bj][2][e], next, wv[n][bj][3][e])));
                        }
                        asm volatile("" : "+v"(a[bj][0]), "+v"(a[bj][1]), "+v"(a[bj][2]), "+v"(a[bj][3]));
                    }
#pragma unroll
                    for (int m = 0; m < 4; ++m) acc[ai][0][m][n][e] = (a[0][m] * a[1][m]) * __builtin_amdgcn_rcpf(1.0f + __builtin_amdgcn_exp2f(a[0][m]));
                }
            }
        }
#pragma unroll
        for (int ai = 0; ai < 2; ++ai)
#pragma unroll
            for (int m = 0; m < 4; ++m) {
                const int row = row0 + 128 * ai + 16 * m;
                const bool edge = (m == 0 && fr == 0) || (m == 3 && fr == 15);
                if (!edge) {
                    const f32x4 v0 = acc[ai][0][m][0], v1 = acc[ai][0][m][1];
                    u32x4 w; w.x = cvt_pk_bf16(v0.x, v0.y); w.y = cvt_pk_bf16(v0.z, v0.w); w.z = cvt_pk_bf16(v1.x, v1.y); w.w = cvt_pk_bf16(v1.z, v1.w);
                    *(u32x4*)(ACT + (size_t)row * DFF + jg) = w;
                }
            }
    }
};

struct Args { const float* in[18]; float* out; unsigned char* ws; };

__device__ __forceinline__ int cmap_in(int n) {
    if (n >= 1280) return n;
    const int head = n >> 7, c = n & 127, g = c >> 3, j = c & 7;
    return head * 128 + ((j < 4) ? 4 * g + j : 64 + 4 * g + (j - 4));
}
__device__ __forceinline__ int cmap_up(int n) { const int pn = n >> 8, c = n & 255; return (c < 128) ? 128 * pn + c : DFF + 128 * pn + (c - 128); }

template <int MODE>
__device__ __forceinline__ void transpose_item(const float* W, int K, int N, bf16_t* WT, const float* gk, LAS float* scr, int item, int lane) {
    const int nblk = N / 64, kb = item / nblk, nb = item % nblk, k0 = 64 * kb, n0 = 64 * nb;
    const int c4 = lane & 15, r4 = lane >> 4;
    const int nn = n0 + 4 * c4;
    const int sc = MODE == 1 ? cmap_in(nn) : (MODE == 2 ? cmap_up(nn) : nn);
    f32x4 v[16];
    const float* src = W + (size_t)(k0 + r4) * N + sc;
#pragma unroll
    for (int i = 0; i < 16; ++i) v[i] = __builtin_nontemporal_load((const f32x4*)(src + (size_t)(4 * i) * N));
    if (gk) {
#pragma unroll
        for (int i = 0; i < 16; ++i) v[i] *= gk[k0 + 4 * i + r4];
    }
#pragma unroll
    for (int i = 0; i < 16; ++i) { LAS float* d = scr + (4 * i + r4) * 65 + 4 * c4; d[0] = v[i].x; d[1] = v[i].y; d[2] = v[i].z; d[3] = v[i].w; }
    asm volatile("s_waitcnt lgkmcnt(0)" ::: "memory");
    const int c = lane & 7;
#pragma unroll
    for (int j = 0; j < 8; ++j) { const int n = (lane >> 3) + 8 * j; const LAS float* p = scr + (8 * c) * 65 + n;
        u32x4 o; o.x = cvt_pk_bf16(p[0 * 65], p[1 * 65]); o.y = cvt_pk_bf16(p[2 * 65], p[3 * 65]); o.z = cvt_pk_bf16(p[4 * 65], p[5 * 65]); o.w = cvt_pk_bf16(p[6 * 65], p[7 * 65]);
        *(u32x4*)(WT + (size_t)(n0 + n) * K + k0 + 8 * c) = o; }
    asm volatile("s_waitcnt lgkmcnt(0)" ::: "memory");
}

__device__ __forceinline__ void prologue(const Args& a, LAS unsigned char* lds, int G, int wv) {
    const int tid = fresh_tid(wv);
    const int lane = tid & 63, wave = tid >> 6;
    LAS float* scr = (LAS float*)(lds + wave * 16640);
    const int gw = blockIdx.x * 8 + wave, NGW = G * 8;
    unsigned char* ws = a.ws;
    constexpr int I_IN = (DM / 64) * (NIN / 64), I_O = (DM / 64) * (DM / 64), I_UP = (DM / 64) * (NUP / 64), I_DN = (DFF / 64) * (DM / 64);
    constexpr int I_L = I_IN + I_O + I_UP + I_DN;
    for (int it = gw; it < DEPTH * I_L; it += NGW) {
        const int l = it / I_L; int r = it % I_L;
        if (r < I_IN) { transpose_item<1>(a.in[2] + (size_t)l * DM * NIN, DM, NIN, (bf16_t*)(ws + OFF_WIN + l * SZ_WIN), a.in[1] + l * DM, scr, r, lane); continue; } r -= I_IN;
        if (r < I_O) {
            const int kb = r / (DM / 64); const float* gk = (kb < 16) ? (a.in[10] + l * 1024) : (a.in[11] + l * 1024 - 1024);
            transpose_item<0>(a.in[12] + (size_t)l * DM * DM, DM, DM, (bf16_t*)(ws + OFF_WO + l * SZ_WO), gk, scr, r, lane); continue; } r -= I_O;
        if (r < I_UP) { transpose_item<2>(a.in[14] + (size_t)l * DM * NUP, DM, NUP, (bf16_t*)(ws + OFF_WUP + l * SZ_WUP), a.in[13] + l * DM, scr, r, lane); continue; } r -= I_UP;
        transpose_item<0>(a.in[17] + (size_t)l * DFF * DM, DFF, DM, (bf16_t*)(ws + OFF_WDN + l * SZ_WDN), nullptr, scr, r, lane);
    }
    {
        const float* x = a.in[0]; bf16_t* xb = (bf16_t*)(ws + OFF_XB); float* xss = (float*)(ws + OFF_XSS);
        for (int m = gw; m < T; m += 2 * NGW) {
            const int m2 = m + NGW;
            const bool has2 = m2 < T;
            const f32x4* xr = (const f32x4*)(x + (size_t)m * DM) + lane; const f32x4* xr2 = (const f32x4*)(x + (size_t)(has2 ? m2 : m) * DM) + lane;
            f32x4 va[8], vb[8];
#pragma unroll
            for (int j = 0; j < 8; ++j) { va[j] = __builtin_nontemporal_load(xr + 64 * j); vb[j] = __builtin_nontemporal_load(xr2 + 64 * j); }
            float s = 0.f, s2 = 0.f;
            u32x2* o8 = (u32x2*)(xb + (size_t)m * DM) + lane; u32x2* o82 = (u32x2*)(xb + (size_t)(has2 ? m2 : m) * DM) + lane;
#pragma unroll
            for (int j = 0; j < 8; ++j) { s += dot4(va[j]); s2 += dot4(vb[j]);
                u32x2 w; w.x = cvt_pk_bf16(va[j].x, va[j].y); w.y = cvt_pk_bf16(va[j].z, va[j].w); o8[64 * j] = w;
                u32x2 w2; w2.x = cvt_pk_bf16(vb[j].x, vb[j].y); w2.y = cvt_pk_bf16(vb[j].z, vb[j].w); if (has2) o82[64 * j] = w2; }
            s = wave_sum(s); s2 = wave_sum(s2);
            if (lane < 32) { xss[(size_t)m * 32 + lane] = (lane == 0) ? s : 0.f; if (has2) xss[(size_t)m2 * 32 + lane] = (lane == 0) ? s2 : 0.f; }
        }
    }
    {
        float* cosT = (float*)(ws + OFF_COS); float* sinT = (float*)(ws + OFF_SIN);
        for (int i = blockIdx.x * 512 + tid; i < SEQ * 64; i += G * 512) {
            const int pos = i >> 6, k = i & 63;
            const float inv = (float)exp2(-(double)k * (13.287712379549449 / 64.0));
            const float ang = (float)pos * inv;
            double rev = (double)ang * 0.15915494309189535; rev -= rint(rev);
            const float fr = (float)rev;
            cosT[i] = __builtin_amdgcn_cosf(fr); sinT[i] = __builtin_amdgcn_sinf(fr);
        }
    }
    {
        const float* wsrc = a.in[8]; float* rsw = (float*)(ws + OFF_RSW);
        for (int r = gw; r < DEPTH * 8 * 128; r += NGW) {
            const f32x2 v = *((const f32x2*)(wsrc + (size_t)r * 128) + lane);
            const float t = wave_sum(v.x + v.y);
            if (lane == 0) rsw[r] = t;
        }
    }
    {
        const float* wsrc = a.in[8]; bf16_t* wd = (bf16_t*)(ws + OFF_WS);
        for (int i = blockIdx.x * 512 + tid; i < DEPTH * 8 * 128 * 128 / 4; i += G * 512) {
            const f32x4 v = *((const f32x4*)wsrc + i); u32x2 w; w.x = cvt_pk_bf16(v.x, v.y); w.y = cvt_pk_bf16(v.z, v.w); *((u32x2*)wd + i) = w;
        }
    }
}

#define LDS_BARRIER() do { asm volatile("s_waitcnt lgkmcnt(0)" ::: "memory"); __builtin_amdgcn_s_barrier(); asm volatile("" ::: "memory"); } while (0)

__device__ __forceinline__ s16x4 vtr(const LAS unsigned char* p) { typedef short v4i16_t __attribute__((ext_vector_type(4))); return __builtin_bit_cast(s16x4, __builtin_amdgcn_ds_read_tr16_b64_v4i16((LAS v4i16_t*)p)); }
#define MFMA32(a, b, c) __builtin_amdgcn_mfma_f32_32x32x16_bf16((a), (b), (c), 0, 0, 0)

constexpr int AT_KROW = 272, AT_VROW = 288, AT_KSZ = 32 * AT_KROW, AT_VSZ = 32 * AT_VROW, AT_BUF = 2 * AT_KSZ + 2 * AT_VSZ;
constexpr int AT_RED = 2 * AT_BUF;

__device__ __forceinline__ void attn_unit(LAS unsigned char* lds, int unit, const float* sinkl, const bf16_t* Q, const bf16_t* K, const bf16_t* V, const float* qss, const float* kss, bf16_t* MIX, int wv) {
    const int tid = fresh_tid(wv);
    const int lane = tid & 63, wid = __builtin_amdgcn_readfirstlane(tid >> 6), qi = lane & 31, hh = lane >> 5;
    const int b = unit >> 6, qb = unit & 63, q0 = qb * 32;
    const size_t rowbase = (size_t)b * SEQ;
    const int hq = wid, kvh = wid >> 2;
    const size_t qrow = rowbase + q0 + qi;
    bf16x8 qf[8];
    { const bf16_t* qp = Q + qrow * 1024 + hq * 128 + 8 * hh;
#pragma unroll
      for (int s = 0; s < 8; ++s) qf[s] = *(const bf16x8*)(qp + 16 * s); }
    const f32x4 qs = *(const f32x4*)(qss + (qrow * 8 + hq) * 4);
    const float rq = rsqrtf(sum4(qs) * (1.0f / 128.0f) + EPS);
    const float sc = rq * 0.08838834764831845f * LOG2E;
    const float sk = sinkl[hq] * LOG2E;
    float m_run = sk, l_run = (hh == 0) ? 1.f : 0.f;
    f32x16 o[4];
#pragma unroll
    for (int c = 0; c < 4; ++c)
#pragma unroll
        for (int i = 0; i < 16; ++i) o[c][i] = 0.f;
    int kb_lo = 0, kb_hi = 8;
    if (qb < 4) kb_lo = 4 - qb;
    if (qb > 59) kb_hi = 67 - qb;
    const int skey = tid >> 4, spart = tid & 15;
    u32x4 pk0A, pk1A, pv0A, pv1A, pk0B, pk1B, pv0B, pv1B; f32x4 ks0A, ks1A, ks0B, ks1B;
#define AT_LOAD(S, kb) do { const size_t r_ = rowbase + (size_t)(q0 - 128 + 32 * (kb) + skey); \
        pk0##S = *(const u32x4*)(K + r_ * 256 + 8 * spart); pk1##S = *(const u32x4*)(K + r_ * 256 + 128 + 8 * spart); \
        pv0##S = *(const u32x4*)(V + r_ * 256 + 8 * spart); pv1##S = *(const u32x4*)(V + r_ * 256 + 128 + 8 * spart); \
        ks0##S = *(const f32x4*)(kss + r_ * 8); ks1##S = *(const f32x4*)(kss + r_ * 8 + 4); } while (0)
#define AT_SCALE(p, r) do { u32x4 t_; \
        t_.x = cvt_pk_bf16(bf_lo(p.x) * r, bf_hi(p.x) * r); t_.y = cvt_pk_bf16(bf_lo(p.y) * r, bf_hi(p.y) * r); \
        t_.z = cvt_pk_bf16(bf_lo(p.z) * r, bf_hi(p.z) * r); t_.w = cvt_pk_bf16(bf_lo(p.w) * r, bf_hi(p.w) * r); p = t_; } while (0)
#define AT_WRITE(S, buf) do { const float r0_ = rsqrtf(sum4(ks0##S) * (1.0f / 128.0f) + EPS), r1_ = rsqrtf(sum4(ks1##S) * (1.0f / 128.0f) + EPS); \
        AT_SCALE(pk0##S, r0_); AT_SCALE(pk1##S, r1_); \
        LAS unsigned char* b_ = lds + (buf) * AT_BUF; \
        *(LAS u32x4*)(b_ + skey * AT_KROW + spart * 16) = pk0##S; *(LAS u32x4*)(b_ + AT_KSZ + skey * AT_KROW + spart * 16) = pk1##S; \
        *(LAS u32x4*)(b_ + 2 * AT_KSZ + skey * AT_VROW + spart * 16) = pv0##S; *(LAS u32x4*)(b_ + 2 * AT_KSZ + AT_VSZ + skey * AT_VROW + spart * 16) = pv1##S; } while (0)
    const int trq = (lane & 15) >> 2, trp = lane & 3, blk = (lane >> 4) & 1;
#define AT_COMPUTE(kb, cur) do { \
        const LAS unsigned char* Kb = lds + (cur) * AT_BUF + kvh * AT_KSZ; \
        const LAS unsigned char* Vb = lds + (cur) * AT_BUF + 2 * AT_KSZ + kvh * AT_VSZ; \
        f32x16 st; \
        _Pragma("unroll") for (int i = 0; i < 16; ++i) st[i] = 0.f; \
        _Pragma("unroll") for (int s_ = 0; s_ < 8; ++s_) { const bf16x8 kf = *(const LAS bf16x8*)(Kb + qi * AT_KROW + (16 * s_ + 8 * hh) * 2); st = MFMA32(kf, qf[s_], st); } \
        float tt[16]; \
        _Pragma("unroll") for (int i = 0; i < 16; ++i) tt[i] = st[i] * sc; \
        if ((kb) == 0) { _Pragma("unroll") for (int i = 0; i < 16; ++i) if (crow(i, hh) < qi) tt[i] = -INFINITY; } \
        if ((kb) == 8) { _Pragma("unroll") for (int i = 0; i < 16; ++i) if (crow(i, hh) > qi) tt[i] = -INFINITY; } \
        float mx = tt[0]; \
        _Pragma("unroll") for (int i = 1; i < 16; ++i) mx = fmaxf(mx, tt[i]); \
        mx = fmaxf(mx, __shfl_xor(mx, 32)); \
        const float m_new = fmaxf(m_run, mx); \
        const float alpha = __builtin_amdgcn_exp2f(m_run - m_new); \
        float ps = 0.f; \
        _Pragma("unroll") for (int i = 0; i < 16; ++i) { tt[i] = __builtin_amdgcn_exp2f(tt[i] - m_new); ps += tt[i]; } \
        l_run = l_run * alpha + ps; m_run = m_new; \
        _Pragma("unroll") for (int c = 0; c < 4; ++c) _Pragma("unroll") for (int i = 0; i < 16; ++i) o[c][i] *= alpha; \
        _Pragma("unroll") for (int s2 = 0; s2 < 2; ++s2) { \
            u32x4 pw; pw.x = cvt_pk_bf16(tt[8 * s2 + 0], tt[8 * s2 + 1]); pw.y = cvt_pk_bf16(tt[8 * s2 + 2], tt[8 * s2 + 3]); pw.z = cvt_pk_bf16(tt[8 * s2 + 4], tt[8 * s2 + 5]); pw.w = cvt_pk_bf16(tt[8 * s2 + 6], tt[8 * s2 + 7]); \
            const bf16x8 pb = __builtin_bit_cast(bf16x8, pw); \
            _Pragma("unroll") for (int c = 0; c < 4; ++c) { \
                const LAS unsigned char* vp = Vb + (16 * s2 + 4 * hh + trq) * AT_VROW + (32 * c + 16 * blk) * 2 + 8 * trp; \
                const s16x4 lo = vtr(vp), hi = vtr(vp + 8 * AT_VROW); \
                const bf16x8 vf = {lo[0], lo[1], lo[2], lo[3], hi[0], hi[1], hi[2], hi[3]}; \
                o[c] = MFMA32(vf, pb, o[c]); } } } while (0)
    AT_LOAD(A, kb_lo);
    if (kb_lo + 1 <= kb_hi) AT_LOAD(B, kb_lo + 1);
    AT_WRITE(A, 0);
    LDS_BARRIER();
    if (kb_lo + 2 <= kb_hi) AT_LOAD(A, kb_lo + 2);
    for (int kb = kb_lo; ; kb += 2) {
        AT_COMPUTE(kb, 0);
        if (kb + 1 <= kb_hi) AT_WRITE(B, 1);
        LDS_BARRIER();
        if (kb + 1 > kb_hi) break;
        if (kb + 3 <= kb_hi) AT_LOAD(B, kb + 3);
        AT_COMPUTE(kb + 1, 1);
        if (kb + 2 <= kb_hi) AT_WRITE(A, 0);
        LDS_BARRIER();
        if (kb + 2 > kb_hi) break;
        if (kb + 4 <= kb_hi) AT_LOAD(A, kb + 4);
    }
#undef AT_LOAD
#undef AT_SCALE
#undef AT_WRITE
#undef AT_COMPUTE
    const float lt = l_run + __shfl_xor(l_run, 32);
    const float inv = 1.0f / lt;
    float ss = 0.f;
#pragma unroll
    for (int c = 0; c < 4; ++c)
#pragma unroll
        for (int i = 0; i < 16; ++i) { o[c][i] *= inv; ss += o[c][i] * o[c][i]; }
    ss += __shfl_xor(ss, 32);
    LAS float* red = (LAS float*)(lds + AT_RED);
    if (hh == 0) red[hq * 32 + qi] = ss;
    LDS_BARRIER();
    float tot = 0.f;
#pragma unroll
    for (int h = 0; h < 8; ++h) tot += red[h * 32 + qi];
    const float ra = rsqrtf(tot * (1.0f / 1024.0f) + EPS);
    bf16_t* op = MIX + qrow * DM + hq * 128;
#pragma unroll
    for (int c = 0; c < 4; ++c)
#pragma unroll
        for (int g = 0; g < 4; ++g) {
            u32x2 w; w.x = cvt_pk_bf16(o[c][4 * g] * ra, o[c][4 * g + 1] * ra); w.y = cvt_pk_bf16(o[c][4 * g + 2] * ra, o[c][4 * g + 3] * ra);
            *(u32x2*)(op + 32 * c + 8 * g + 4 * hh) = w;
        }
    LDS_BARRIER();
}

constexpr int SG_ROW = 288, SG_BUF = 128 * SG_ROW, SG_STAT = 2 * SG_BUF, SG_RED = SG_STAT + 128 * 8, SG_LN = SG_RED + 1024;
__device__ __forceinline__ void sgu_unit(LAS unsigned char* lds, int unit, const bf16_t* GU, const bf16_t* GV, const float* gvs, const float* lng, const float* lnb,
                                         const bf16_t* WS, const float* rsw, const float* bs, bf16_t* MIX, int wv) {
    const int tid = fresh_tid(wv);
    const int lane = tid & 63, wid = __builtin_amdgcn_readfirstlane(tid >> 6), pi = lane & 31, hh = lane >> 5;
    const int bc = unit >> 1, ph = unit & 1;
    const size_t rowbase = (size_t)bc * 128;
    LAS f32x2* stat = (LAS f32x2*)(lds + SG_STAT);
    const int spart = tid & 15, sq = tid >> 4;
    const bf16_t* gvp = GV + (rowbase + sq) * 1024 + 8 * spart;
    u32x4 gvr[4];
#define SG_LOADGV(h) do { _Pragma("unroll") for (int i = 0; i < 4; ++i) gvr[i] = *(const u32x4*)(gvp + (size_t)(32 * i) * 1024 + (h) * 128); } while (0)
    SG_LOADGV(0);
    {
        const f32x4 t4 = (tid < 256) ? *(const f32x4*)(lng + 4 * tid) : *(const f32x4*)(lnb + 4 * (tid - 256));
        *(LAS f32x4*)(lds + SG_LN + 16 * tid) = t4;
    }
    if (tid < 128) {
        const f32x4* p = (const f32x4*)(gvs + (rowbase + tid) * 32);
        float s1 = 0.f, s2 = 0.f;
#pragma unroll
        for (int i = 0; i < 8; ++i) { const f32x4 v = p[i]; s1 += v.x + v.z; s2 += v.y + v.w; }
        const float mu = s1 * (1.0f / 1024.0f);
        const float var = s2 * (1.0f / 1024.0f) - mu * mu;
        stat[tid] = (f32x2){mu, rsqrtf(fmaxf(var, 0.f) + EPS)};
    }
    LDS_BARRIER();
    const int psub = wid & 1, dsub = wid >> 1;
    const int prow = ph * 64 + psub * 32 + pi;
    const int trq = (lane & 15) >> 2, trp = lane & 3, blk = (lane >> 4) & 1;
    const bf16_t* wp = WS + (size_t)prow * 128 + 8 * hh;
    unsigned accp[8][8];
#pragma unroll
    for (int h = 0; h < 8; ++h) {
        f32x16 acch;
#pragma unroll
        for (int i = 0; i < 16; ++i) acch[i] = 0.f;
        bf16x8 wf[8];
#pragma unroll
        for (int s_ = 0; s_ < 8; ++s_) wf[s_] = *(const bf16x8*)(wp + (size_t)h * 128 * 128 + 16 * s_);
        LAS unsigned char* buf = lds + (h & 1) * SG_BUF;
#pragma unroll
        for (int i = 0; i < 4; ++i) {
            const int q = sq + 32 * i;
            const u32x4 v = gvr[i];
            const f32x2 st = stat[q];
            const float nm = -st.x * st.y;
            u32x4 w;
            w.x = cvt_pk_bf16(__builtin_fmaf(bf_lo(v.x), st.y, nm), __builtin_fmaf(bf_hi(v.x), st.y, nm));
            w.y = cvt_pk_bf16(__builtin_fmaf(bf_lo(v.y), st.y, nm), __builtin_fmaf(bf_hi(v.y), st.y, nm));
            w.z = cvt_pk_bf16(__builtin_fmaf(bf_lo(v.z), st.y, nm), __builtin_fmaf(bf_hi(v.z), st.y, nm));
            w.w = cvt_pk_bf16(__builtin_fmaf(bf_lo(v.w), st.y, nm), __builtin_fmaf(bf_hi(v.w), st.y, nm));
            *(LAS u32x4*)(buf + q * SG_ROW + spart * 16) = w;
        }
        if (h + 1 < 8) SG_LOADGV(h + 1);
        LDS_BARRIER();
#pragma unroll
        for (int s_ = 0; s_ < 8; ++s_) {
            const LAS unsigned char* vp = buf + (16 * s_ + 8 * hh + trq) * SG_ROW + (32 * dsub + 16 * blk) * 2 + 8 * trp;
            const s16x4 lo = vtr(vp), hi = vtr(vp + 4 * SG_ROW);
            const bf16x8 vf = {lo[0], lo[1], lo[2], lo[3], hi[0], hi[1], hi[2], hi[3]};
            acch = MFMA32(vf, wf[s_], acch);
            if (s_ & 1) __builtin_amdgcn_sched_barrier(0);
        }
#pragma unroll
        for (int k = 0; k < 8; ++k) accp[h][k] = cvt_pk_bf16(acch[2 * k], acch[2 * k + 1]);
    }
#undef SG_LOADGV
    const size_t orow = rowbase + prow;
    float ss = 0.f;
    u32x2 guv[8][4]; float bbv[8], rwv[8];
#pragma unroll
    for (int h = 0; h < 8; ++h) {
        bbv[h] = bs[h * 128 + prow]; rwv[h] = rsw[h * 128 + prow];
#pragma unroll
        for (int g = 0; g < 4; ++g) guv[h][g] = *(const u32x2*)(GU + orow * 1024 + h * 128 + 32 * dsub + 8 * g + 4 * hh);
    }
    const LAS float* lnl = (const LAS float*)(lds + SG_LN);
#pragma unroll
    for (int h = 0; h < 8; ++h) {
        const float bb = bbv[h], rw = rwv[h];
#pragma unroll
        for (int g = 0; g < 4; ++g) {
            const int d0 = h * 128 + 32 * dsub + 8 * g + 4 * hh;
            const u32x2 gu = guv[h][g];
            const f32x4 lg = *(const LAS f32x4*)(lnl + d0), lb = *(const LAS f32x4*)(lnl + 1024 + d0);
            const float o0 = bf_lo(gu.x) * (__builtin_fmaf(lg.x, bf_lo(accp[h][2 * g]), __builtin_fmaf(lb.x, rw, bb)));
            const float o1 = bf_hi(gu.x) * (__builtin_fmaf(lg.y, bf_hi(accp[h][2 * g]), __builtin_fmaf(lb.y, rw, bb)));
            const float o2 = bf_lo(gu.y) * (__builtin_fmaf(lg.z, bf_lo(accp[h][2 * g + 1]), __builtin_fmaf(lb.z, rw, bb)));
            const float o3 = bf_hi(gu.y) * (__builtin_fmaf(lg.w, bf_hi(accp[h][2 * g + 1]), __builtin_fmaf(lb.w, rw, bb)));
            ss += (o0 * o0 + o1 * o1) + (o2 * o2 + o3 * o3);
            accp[h][2 * g] = cvt_pk_bf16(o0, o1); accp[h][2 * g + 1] = cvt_pk_bf16(o2, o3);
        }
        __builtin_amdgcn_sched_barrier(0);
    }
    ss += __shfl_xor(ss, 32);
    LAS float* red = (LAS float*)(lds + SG_RED);
    if (hh == 0) red[dsub * 64 + psub * 32 + pi] = ss;
    LDS_BARRIER();
    const float tot = (red[psub * 32 + pi] + red[64 + psub * 32 + pi]) + (red[128 + psub * 32 + pi] + red[192 + psub * 32 + pi]);
    const float rs = rsqrtf(tot * (1.0f / 1024.0f) + EPS);
    bf16_t* op = MIX + orow * DM + 1024 + 32 * dsub;
#pragma unroll
    for (int h = 0; h < 8; ++h)
#pragma unroll
        for (int g = 0; g < 4; ++g) {
            u32x2 w; w.x = cvt_pk_bf16(bf_lo(accp[h][2 * g]) * rs, bf_hi(accp[h][2 * g]) * rs); w.y = cvt_pk_bf16(bf_lo(accp[h][2 * g + 1]) * rs, bf_hi(accp[h][2 * g + 1]) * rs);
            *(u32x2*)(op + h * 128 + 8 * g + 4 * hh) = w;
        }
    LDS_BARRIER();
}

__device__ __forceinline__ void fixup_phase(const bf16_t* HALO, const float* cw, const float* cb, bf16_t* ACT, int G, int wv) {
    constexpr int CH = DFF / 8;
    const int total = (T / 64) * 2 * CH;
    const int tid = fresh_tid(wv);
    for (int it = blockIdx.x * 512 + tid; it < total; it += G * 512) {
        const int ch = it % CH, br = it / CH, sl = br >> 1, side = br & 1;
        const int row = sl * 64 + (side ? 63 : 0), pos = row & (SEQ - 1);
        const int j = ch * 8;
        const bf16_t* hc = HALO + (size_t)(4 * sl + (side ? 3 : 0)) * NUP;
        const bf16_t* hp = side ? HALO + (size_t)(4 * sl + 2) * NUP : (pos == 0 ? nullptr : HALO + (size_t)(4 * (sl - 1) + 3) * NUP);
        const bf16_t* hn = side ? (pos == SEQ - 1 ? nullptr : HALO + (size_t)(4 * (sl + 1)) * NUP) : HALO + (size_t)(4 * sl + 1) * NUP;
        float a[2][8];
#pragma unroll
        for (int gu = 0; gu < 2; ++gu) {
            const int col = gu * DFF + j;
            const u32x4 z = {0u, 0u, 0u, 0u};
            const u32x4 vc = *(const u32x4*)(hc + col), vp = hp ? *(const u32x4*)(hp + col) : z, vn = hn ? *(const u32x4*)(hn + col) : z;
#pragma unroll
            for (int e = 0; e < 4; ++e) {
                const int c0 = col + 2 * e;
                a[gu][2 * e] = cb[c0] + cw[c0] * bf_lo(vp[e]) + cw[NUP + c0] * bf_lo(vc[e]) + cw[2 * NUP + c0] * bf_lo(vn[e]);
                a[gu][2 * e + 1] = cb[c0 + 1] + cw[c0 + 1] * bf_hi(vp[e]) + cw[NUP + c0 + 1] * bf_hi(vc[e]) + cw[2 * NUP + c0 + 1] * bf_hi(vn[e]);
            }
        }
        u32x4 w;
        w.x = cvt_pk_bf16(silu_f(a[0][0]) * a[1][0], silu_f(a[0][1]) * a[1][1]); w.y = cvt_pk_bf16(silu_f(a[0][2]) * a[1][2], silu_f(a[0][3]) * a[1][3]);
        w.z = cvt_pk_bf16(silu_f(a[0][4]) * a[1][4], silu_f(a[0][5]) * a[1][5]); w.w = cvt_pk_bf16(silu_f(a[0][6]) * a[1][6], silu_f(a[0][7]) * a[1][7]);
        *(u32x4*)(ACT + (size_t)row * DFF + j) = w;
    }
}


#define XB_TMO      128
#define XB_XCNT(j)  (256  + 64 * (j))
#define XB_XSUB(j)  (1280 + 64 * (j))
#define XB_XGEN(j)  (2304 + 64 * (j))
#define XB_TOP      3328
#define XB_TOPGEN   3392
#define XCD_BAR_WORDS 3456
#define XB_SPIN_CAP (1u << 18)
__device__ __forceinline__ unsigned xb_ld(unsigned* p)              { return __hip_atomic_load(p, __ATOMIC_RELAXED, __HIP_MEMORY_SCOPE_AGENT); }
__device__ __forceinline__ unsigned xb_add(unsigned* p, unsigned v) { return __hip_atomic_fetch_add(p, v, __ATOMIC_RELAXED, __HIP_MEMORY_SCOPE_AGENT); }
__device__ __forceinline__ unsigned xb_xcc_id() { return (unsigned)__builtin_amdgcn_s_getreg((3 << 11) | 20) & 0xFu; }
#define XB_SPIN(cond, bar) do { unsigned _sp = 0; while (cond) { __builtin_amdgcn_s_sleep(1); \
    if ((++_sp & 255u) == 0u) { if (xb_ld(&(bar)[XB_TMO])) break; if (_sp > XB_SPIN_CAP) { atomicAdd(&(bar)[XB_TMO], 1u); break; } } } } while (0)
struct XcdBarrier { unsigned* bar; unsigned x; volatile LAS unsigned* st; };
__device__ __forceinline__ XcdBarrier xcd_barrier_post(unsigned* bar, volatile LAS unsigned* st) {
    XcdBarrier b; b.bar = bar; b.x = xb_xcc_id(); b.st = st;
    if (threadIdx.x == 0) (void)xb_add(&bar[XB_XCNT(b.x)], 1u);
    return b;
}
__device__ __forceinline__ void xcd_barrier_complete(unsigned* bar, unsigned x, unsigned& nloc, unsigned& nx) {
    const unsigned G = gridDim.x * gridDim.y * gridDim.z;
    unsigned sum, cnt, mine, sp = 0u;
    for (;;) {
        sum = 0u; cnt = 0u; mine = 0u;
#pragma unroll
        for (unsigned j = 0; j < 16; ++j) { const unsigned c = xb_ld(&bar[XB_XCNT(j)]); sum += c; cnt += (c > 0u) ? 1u : 0u; mine = (j == x) ? c : mine; }
        if (sum == G) break;
        __builtin_amdgcn_s_sleep(1);
        if ((++sp & 255u) == 0u) { if (xb_ld(&bar[XB_TMO])) break; if (sp > XB_SPIN_CAP) { atomicAdd(&bar[XB_TMO], 1u); break; } }
    }
    nloc = mine > 0u ? mine : 1u; nx = cnt > 0u ? cnt : 1u;
}
__device__ __forceinline__ void xcd_barrier(const XcdBarrier& b) {
    asm volatile("s_waitcnt vmcnt(0)" ::: "memory");
    __syncthreads();
    const unsigned lane = (unsigned)lane_id_fresh();
    bool leader = false;
    if (lane == 0) { const unsigned t = __hip_atomic_fetch_add((LAS unsigned*)(b.st + 2), 1u, __ATOMIC_RELAXED, __HIP_MEMORY_SCOPE_WORKGROUP); leader = (t & 7u) == 0u; }
    if (leader) {
        unsigned* bar = b.bar; unsigned x = b.x; asm volatile("" : "+s"(x));
        __builtin_amdgcn_s_waitcnt(0);
        unsigned nloc = b.st[0], nx = b.st[1];
        if (nloc == 0u) { xcd_barrier_complete(bar, x, nloc, nx); b.st[0] = nloc; b.st[1] = nx; }
        const unsigned old = xb_add(&bar[XB_XSUB(x)], 1u);
        const unsigned gen = old / nloc;
        if (old + 1u == (gen + 1u) * nloc) {
            __builtin_amdgcn_fence(__ATOMIC_RELEASE, "agent");
            asm volatile("s_waitcnt vmcnt(0)" ::: "memory");
            const unsigned og = xb_add(&bar[XB_TOP], 1u);
            const unsigned tg = og / nx;
            if (og + 1u == (tg + 1u) * nx) xb_add(&bar[XB_TOPGEN], 1u);
            else XB_SPIN(xb_ld(&bar[XB_TOPGEN]) == tg, bar);
            __builtin_amdgcn_fence(__ATOMIC_ACQUIRE, "agent");
            xb_add(&bar[XB_XGEN(x)], 1u);
            asm volatile("s_waitcnt vmcnt(0)" ::: "memory");
        } else {
            XB_SPIN(xb_ld(&bar[XB_XGEN(x)]) == gen, bar);
            __builtin_amdgcn_fence(__ATOMIC_ACQUIRE, "agent");
            asm volatile("s_waitcnt vmcnt(0)" ::: "memory");
        }
    }
    __syncthreads();
}

#ifndef PROBE_SEL
#define PROBE_SEL 0
#endif
#if PROBE_SEL
#define TIC(sel) do { if (PROBE_SEL == (sel)) { asm volatile("s_waitcnt vmcnt(0) lgkmcnt(0)" ::: "memory"); probe_t0 = __builtin_amdgcn_s_memrealtime(); } } while (0)
#define TOC(sel) do { if (PROBE_SEL == (sel)) { asm volatile("s_waitcnt vmcnt(0) lgkmcnt(0)" ::: "memory"); probe_acc += __builtin_amdgcn_s_memrealtime() - probe_t0; } } while (0)
#else
#define TIC(sel) do {} while (0)
#define TOC(sel) do {} while (0)
#endif
typedef const __attribute__((address_space(4))) Args* ArgsP;
#define FRESH_ARGS() ArgsP ap = (ArgsP)__builtin_amdgcn_kernarg_segment_ptr(); asm volatile("" : "+s"(ap)); unsigned char* ws = ap->ws; const int G = gridDim.x, bx = blockIdx.x
__global__ void __launch_bounds__(512, 2) fwd_megakernel(Args a_unused) {
    extern __shared__ __attribute__((aligned(16))) unsigned char lds_raw[];
    LAS unsigned char* lds = (LAS unsigned char*)lds_raw;
    cg::grid_group grid = cg::this_grid();
#if PROBE_SEL
    unsigned long long probe_t0 = 0, probe_acc = 0;
#endif
    const int wv = __builtin_amdgcn_readfirstlane(threadIdx.x >> 6);
    volatile LAS unsigned* bst = (volatile LAS unsigned*)(lds + LDS_BYTES - 16);
    if (threadIdx.x < 4) bst[threadIdx.x] = 0u;
    __syncthreads();
    if (gridDim.y == 0xFFFFu) grid.sync();
    XcdBarrier xbar;
    { FRESH_ARGS(); xbar = xcd_barrier_post((unsigned*)(ws + OFF_CTL), bst); (void)G; (void)bx; }
    {
        FRESH_ARGS();
        Args a;
#pragma unroll
        for (int i = 0; i < 18; ++i) a.in[i] = ap->in[i];
        a.out = ap->out; a.ws = ws;
        TIC(9);
#ifndef NO_P0
        prologue(a, lds, G, wv);
#endif
        TOC(9);
    }
    TIC(1); xcd_barrier(xbar); TOC(1);

    for (int l = 0; l < DEPTH; ++l) {
        for (int part = 0; part < 2; ++part) {
            FRESH_ARGS();
            const bool split = (G == 256);
            if (part == 1 && !split) break;
            pg8::Gemm g{(const bf16_t*)(ws + OFF_XB), (const bf16_t*)(ws + OFF_WIN + l * SZ_WIN), T, NIN, DM}; pg8::StaticOrder S; S.init(T, NIN, G, bx);
            if (split) { S.Lbase = part ? 768 : 0; S.Lend = part ? 896 : 768; }
            EpiIn E{(const float*)(ws + OFF_XSS), ap->in[3] + l * 128, ap->in[4] + l * 128, (const float*)(ws + OFF_COS), (const float*)(ws + OFF_SIN),
                    (bf16_t*)(ws + OFF_Q), (bf16_t*)(ws + OFF_K), (bf16_t*)(ws + OFF_V), (bf16_t*)(ws + OFF_GU), (bf16_t*)(ws + OFF_GV),
                    (float*)(ws + OFF_QSS), (float*)(ws + OFF_KSS), (float*)(ws + OFF_GVS)};
            TIC(7);
#ifndef NO_IN
            pg8::gemm_phase(lds, g, S, E, wv);
#endif
            TOC(7);
            if (part == 0) { TIC(1); xcd_barrier(xbar); TOC(1); }
        }
        {
            FRESH_ARGS();
            TIC(2);
#ifndef NO_ATT
            if (G == 256) {
                const int heavy = bx >= 128;
                const int idx = (bx % 8) * 16 + (heavy ? (bx - 128) / 8 : bx / 8);
                const int u0 = heavy ? 3 * idx : 384 + idx, nu = heavy ? 3 : 1;
                for (int u = u0; u < u0 + nu; ++u) attn_unit(lds, u, ap->in[5] + l * 8, (const bf16_t*)(ws + OFF_Q), (const bf16_t*)(ws + OFF_K), (const bf16_t*)(ws + OFF_V),
                                                             (const float*)(ws + OFF_QSS), (const float*)(ws + OFF_KSS), (bf16_t*)(ws + OFF_MIX), wv);
            } else {
                for (int u = bx; u < 512; u += G) attn_unit(lds, u, ap->in[5] + l * 8, (const bf16_t*)(ws + OFF_Q), (const bf16_t*)(ws + OFF_K), (const bf16_t*)(ws + OFF_V),
                                                            (const float*)(ws + OFF_QSS), (const float*)(ws + OFF_KSS), (bf16_t*)(ws + OFF_MIX), wv);
            }
#endif
            TOC(2);
        }
        TIC(1); xcd_barrier(xbar); TOC(1);
        {
            FRESH_ARGS();
            TIC(3);
#ifndef NO_SGU
            for (int u = bx; u < 256; u += G) sgu_unit(lds, u, (const bf16_t*)(ws + OFF_GU), (const bf16_t*)(ws + OFF_GV), (const float*)(ws + OFF_GVS), ap->in[6] + l * 1024, ap->in[7] + l * 1024,
                                                       (const bf16_t*)(ws + OFF_WS) + (size_t)l * 8 * 128 * 128, (const float*)(ws + OFF_RSW) + l * 1024, ap->in[9] + l * 1024, (bf16_t*)(ws + OFF_MIX), wv);
#endif
            TOC(3);
        }
        TIC(1); xcd_barrier(xbar); TOC(1);
        {
            FRESH_ARGS();
            pg8::Gemm g{(const bf16_t*)(ws + OFF_MIX), (const bf16_t*)(ws + OFF_WO + l * SZ_WO), T, DM, DM}; pg8::StaticOrder S; S.init(T, DM, G, bx);
            EpiRes E{nullptr, (bf16_t*)(ws + OFF_XB), (float*)(ws + OFF_XSS)};
            TIC(5);
#ifndef NO_WO
            pg8::gemm_phase(lds, g, S, E, wv);
#endif
            TOC(5);
        }
        TIC(1); xcd_barrier(xbar); TOC(1);
        {
            FRESH_ARGS();
            pg8::Gemm g{(const bf16_t*)(ws + OFF_XB), (const bf16_t*)(ws + OFF_WUP + l * SZ_WUP), T, NUP, DM}; pg8::StaticOrder S; S.init(T, NUP, G, bx);
            EpiUp E{(const float*)(ws + OFF_XSS), ap->in[15] + (size_t)l * 3 * NUP, ap->in[16] + (size_t)l * NUP, (bf16_t*)(ws + OFF_ACT), (bf16_t*)(ws + OFF_HALO)};
            TIC(8);
#ifndef NO_UP
            pg8::gemm_phase(lds, g, S, E, wv);
#endif
            TOC(8);
        }
        TIC(1); xcd_barrier(xbar); TOC(1);
        {
            FRESH_ARGS();
            TIC(4);
#ifndef NO_FIX
            fixup_phase((const bf16_t*)(ws + OFF_HALO), ap->in[15] + (size_t)l * 3 * NUP, ap->in[16] + (size_t)l * NUP, (bf16_t*)(ws + OFF_ACT), G, wv);
#endif
            TOC(4);
        }
        TIC(1); xcd_barrier(xbar); TOC(1);
        {
            FRESH_ARGS();
            pg8::Gemm g{(const bf16_t*)(ws + OFF_ACT), (const bf16_t*)(ws + OFF_WDN + l * SZ_WDN), T, DM, DFF}; pg8::StaticOrder S; S.init(T, DM, G, bx);
            EpiRes E{l + 1 == DEPTH ? ap->out : nullptr, (bf16_t*)(ws + OFF_XB), (float*)(ws + OFF_XSS)};
            TIC(6);
#ifndef NO_DN
            pg8::gemm_phase(lds, g, S, E, wv);
#endif
            TOC(6);
        }
        if (l + 1 < DEPTH) { TIC(1); xcd_barrier(xbar); TOC(1); }
    }
#if PROBE_SEL
    { const unsigned long long until = __builtin_amdgcn_s_memrealtime() + 4ull * probe_acc; while (__builtin_amdgcn_s_memrealtime() < until) __builtin_amdgcn_s_sleep(16); }
#endif
}

extern "C" void kernel_launch(void* const* d_in, const int* in_sizes, int n_in, void* d_out, int out_size, void* d_ws, size_t ws_size, hipStream_t stream) {
    static int grid = 0;
    if (grid == 0) {
        if (n_in != 18 || out_size != T * DM || ws_size < WS_END) { fprintf(stderr, "kernel_launch: unexpected problem (n_in %d, out %d, ws %zu < %zu)\n", n_in, out_size, ws_size, (size_t)WS_END); grid = -1; return; }
        int dev = 0, cus = 0, per_cu = 0;
        hipGetDevice(&dev);
        hipDeviceGetAttribute(&cus, hipDeviceAttributeMultiprocessorCount, dev);
        hipFuncSetAttribute((const void*)fwd_megakernel, hipFuncAttributeMaxDynamicSharedMemorySize, LDS_BYTES);
        hipOccupancyMaxActiveBlocksPerMultiprocessor(&per_cu, (const void*)fwd_megakernel, 512, LDS_BYTES);
        if (per_cu < 1) per_cu = 1;
        grid = cus * per_cu;
        (void)hipGetLastError();
    }
    if (grid < 0) return;
    Args a{};
    for (int i = 0; i < 18; ++i) a.in[i] = (const float*)d_in[i];
    a.out = (float*)d_out; a.ws = (unsigned char*)d_ws;
    (void)hipMemsetAsync((unsigned char*)d_ws + OFF_CTL, 0, CTL_BYTES, stream);
    void* args[] = {&a};
    hipError_t e = hipLaunchCooperativeKernel((const void*)fwd_megakernel, dim3(grid), dim3(512), args, LDS_BYTES, stream);
    if (e != hipSuccess) fprintf(stderr, "cooperative launch failed: %s (grid %d)\n", hipGetErrorString(e), grid);
}
```
